# Optimizing an MI355X kernel written in HIP

```python
import jax, jax.numpy as jnp
from jax import lax
import numpy as np

D_MODEL = 2048
BATCH = 4
SEQ = 4096
DEPTH = 1

D_INNER = D_MODEL
GLA_WIDTH = D_INNER // 2
GLA_HEADS = 4
GLA_HEAD_V = GLA_WIDTH // GLA_HEADS
GLA_HEAD_K = GLA_HEAD_V // 2
GLA_KEY_WIDTH = GLA_HEADS * GLA_HEAD_K
GLA_LOWRANK = 16
GLA_TAU = 16.0
HGRN_WIDTH = D_INNER - GLA_WIDTH
HGRN_EXPAND = 128
HGRN_HEADS = HGRN_WIDTH // HGRN_EXPAND
HGRN_HEAD_V = HGRN_WIDTH // HGRN_HEADS
CHUNK = 64
EPS = 1e-6

SPLIT_SIZES = (GLA_KEY_WIDTH, GLA_KEY_WIDTH, GLA_WIDTH, GLA_WIDTH, GLA_LOWRANK,
               HGRN_WIDTH, HGRN_WIDTH, HGRN_WIDTH, HGRN_WIDTH)
D_PROJ = sum(SPLIT_SIZES)

kernel_name = "hymba_gla_hgrn2_parallel_layer"


def rmsnorm(x, g):
    x32 = x.astype(jnp.float32)
    y = x32 * lax.rsqrt(jnp.mean(x32 * x32, axis=-1, keepdims=True) + EPS)
    return (y * g.astype(jnp.float32)).astype(x.dtype)


def head_rmsnorm(o, g):
    B, T, H, dv = o.shape
    o32 = o.astype(jnp.float32)
    y = o32 * lax.rsqrt(jnp.mean(o32 * o32, axis=-1, keepdims=True) + EPS)
    return y.reshape(B, T, H * dv) * g.astype(jnp.float32)


def split_heads(a, n_heads):
    B, T, D = a.shape
    return a.reshape(B, T, n_heads, D // n_heads)


def chunked_gated_linear_attention(q, k, v, log_g, scale):
    B, T, H, dk = q.shape
    dv = v.shape[-1]
    n_chunks = T // CHUNK

    def to_chunks(a):
        a = a.astype(jnp.float32)
        return a.reshape(B, n_chunks, CHUNK, H, a.shape[-1]).transpose(1, 0, 3, 2, 4)

    qc = to_chunks(q) * scale
    kc, vc, gc = to_chunks(k), to_chunks(v), to_chunks(log_g)
    causal = jnp.tril(jnp.ones((CHUNK, CHUNK), dtype=bool))[:, :, None]

    def step(S, inp):
        q_, k_, v_, g_ = inp
        b = jnp.cumsum(g_, axis=-2)
        diff = b[..., :, None, :] - b[..., None, :, :]
        decay = jnp.exp(jnp.where(causal, diff, -jnp.inf))
        A = jnp.einsum('bhid,bhjd,bhijd->bhij', q_, k_, decay)
        o_intra = jnp.einsum('bhij,bhje->bhie', A, v_)
        o_inter = jnp.einsum('bhid,bhde->bhie', q_ * jnp.exp(b), S)
        b_last = b[..., -1:, :]
        k_dec = k_ * jnp.exp(b_last - b)
        S_new = jnp.exp(b_last)[..., 0, :, None] * S + jnp.einsum('bhjd,bhje->bhde', k_dec, v_)
        return S_new, o_intra + o_inter

    S0 = jnp.zeros((B, H, dk, dv), jnp.float32)
    _, out = lax.scan(step, S0, (qc, kc, vc, gc))
    return out.transpose(1, 0, 3, 2, 4).reshape(B, T, H, dv)


def setup_inputs(seed: int = 0) -> dict:
    key = jax.random.key(seed)
    ks = jax.random.split(key, 12)
    f32 = jnp.float32
    x = jax.random.normal(ks[0], (BATCH, SEQ, D_MODEL), f32)
    norm_w = 1.0 + 0.02 * jax.random.normal(ks[1], (DEPTH, D_MODEL), f32)
    w_in = jax.random.normal(ks[2], (DEPTH, D_MODEL, D_PROJ), f32) * D_MODEL ** -0.5
    gla_w_up = jax.random.normal(ks[3], (DEPTH, GLA_LOWRANK, GLA_KEY_WIDTH), f32) * GLA_LOWRANK ** -0.5
    gla_b_up = 0.1 * jax.random.normal(ks[4], (DEPTH, GLA_KEY_WIDTH), f32)
    gla_norm_w = 1.0 + 0.02 * jax.random.normal(ks[5], (DEPTH, GLA_WIDTH), f32)
    hgrn_lb_logits = 0.5 * jax.random.normal(ks[6], (DEPTH + 1, HGRN_WIDTH), f32)
    hgrn_norm_w = 1.0 + 0.02 * jax.random.normal(ks[7], (DEPTH, HGRN_WIDTH), f32)
    w_out = jax.random.normal(ks[8], (DEPTH, D_INNER, D_MODEL), f32) * D_INNER ** -0.5
    final_norm_w = 1.0 + 0.02 * jax.random.normal(ks[9], (D_MODEL,), f32)
    return {"x": x, "norm_w": norm_w, "w_in": w_in, "gla_w_up": gla_w_up,
            "gla_b_up": gla_b_up, "gla_norm_w": gla_norm_w,
            "hgrn_lb_logits": hgrn_lb_logits, "hgrn_norm_w": hgrn_norm_w,
            "w_out": w_out, "final_norm_w": final_norm_w}


def reference(x, norm_w, w_in, gla_w_up, gla_b_up, gla_norm_w, hgrn_lb_logits,
              hgrn_norm_w, w_out, final_norm_w):
    offsets = [int(o) for o in np.cumsum(SPLIT_SIZES)[:-1]]
    lb_all = jnp.cumsum(jax.nn.softmax(hgrn_lb_logits.astype(jnp.float32), axis=0), axis=0)
    for l in range(DEPTH):
        h = rmsnorm(x, norm_w[l])
        proj = h @ w_in[l]
        gq, gk, gv, gg, glr, hq, hf, hi, hg = jnp.split(proj, offsets, axis=-1)

        log_a = jax.nn.log_sigmoid((glr @ gla_w_up[l] + gla_b_up[l]).astype(jnp.float32)) / GLA_TAU
        o_a = chunked_gated_linear_attention(
            split_heads(gq, GLA_HEADS), split_heads(gk, GLA_HEADS),
            split_heads(gv, GLA_HEADS), split_heads(log_a, GLA_HEADS),
            GLA_HEAD_K ** -0.5)
        o_a = head_rmsnorm(o_a, gla_norm_w[l]) * jax.nn.silu(gg.astype(jnp.float32))

        lb = lb_all[l]
        f = lb + (1.0 - lb) * jax.nn.sigmoid(hf.astype(jnp.float32))
        o_b = chunked_gated_linear_attention(
            split_heads(hq, HGRN_HEADS), split_heads(1.0 - f, HGRN_HEADS),
            split_heads(hi, HGRN_HEADS), split_heads(jnp.log(f), HGRN_HEADS),
            HGRN_EXPAND ** -0.5)
        o_b = head_rmsnorm(o_b, hgrn_norm_w[l]) * jax.nn.silu(hg.astype(jnp.float32))

        mixed = jnp.concatenate([o_a, o_b], axis=-1).astype(x.dtype)
        x = x + mixed @ w_out[l]
    return rmsnorm(x, final_norm_w)
```

```cpp
#include <hip/hip_runtime.h>
#include <hip/hip_cooperative_groups.h>
#include <cstdio>
#include <cstdint>
namespace cg = cooperative_groups;
#ifndef MK_ONE_LAUNCH
#define MK_ONE_LAUNCH 0
#endif
namespace pg8 {
#define PG8_LAS __attribute__((address_space(3)))
typedef unsigned short bf16_t;
typedef short bf16x8 __attribute__((ext_vector_type(8)));
typedef float f32x4 __attribute__((ext_vector_type(4)));
typedef unsigned u32x4 __attribute__((ext_vector_type(4)));
constexpr int BM = 256, BK = 64, HALF = 128, HTB = HALF * BK * 2  , STAGE_BYTES = 8 * HTB, NXCD = 8, WGM = 8;

__host__ __device__ __forceinline__ int lds_byte(int r, int c) { const int st = (r >> 4) * 2 + (c >> 5), rr = r & 15, cc = c & 31, ob = rr * 64 + cc * 2; return st * 1024 + (ob ^ (((ob >> 9) & 1) << 5)); }
__host__ __device__ __forceinline__ void stage_rc(int b, int& R, int& C) { const int st = b / 1024, sb = b % 1024, swz = sb ^ (((sb >> 9) & 1) << 5); R = (st >> 1) * 16 + swz / 64; C = (st & 1) * 32 + (swz % 64) / 2; }
__host__ __device__ __forceinline__ int perm32(int rho) { const int n = rho >> 4, i = rho & 15; return 8 * (i >> 2) + 4 * n + (i & 3); }

struct Unit { int pm, pn; };
struct Gemm { const bf16_t* A; const bf16_t* Bt; int M, N, K; };

struct StaticOrder {
    int nM, nN, nwg, G, c;
    __host__ __device__ void init(int M, int N, int G_, int c_) { nM = M / BM; nN = N / BM; nwg = nM * nN; G = G_; c = c_; }
    __host__ __device__ bool next(int i, Unit& u) const {
        const long L = (long)i * G + c; if (L >= nwg) return false;
        int wgid = (int)L; { const int q = nwg / NXCD, r = nwg % NXCD, xcd = wgid % NXCD, off = wgid / NXCD; wgid = (xcd < r ? xcd * (q + 1) : r * (q + 1) + (xcd - r) * q) + off; }
        const int nig = WGM * nN, gid = wgid / nig, fm = gid * WGM, gsz = (nM - fm) < WGM ? (nM - fm) : WGM;
        u.pm = fm + ((wgid % nig) % gsz); u.pn = (wgid % nig) / gsz; return true;
    }
    __device__ __forceinline__ void a_ready(const Unit&) const {}
    __device__ __forceinline__ void done(const Unit&) const {}
};

__device__ __forceinline__ unsigned cvt_pk_bf16(float lo, float hi) { unsigned r; asm volatile("v_cvt_pk_bf16_f32 %0, %1, %2" : "=v"(r) : "v"(lo), "v"(hi)); return r; }
typedef float f32x2 __attribute__((ext_vector_type(2)));
__device__ __forceinline__ f32x2 gelu_pk(f32x2 v) {
    const f32x2 av = __builtin_elementwise_abs(v), d = av * 0.2316418882f + 1.0f;
    f32x2 t; t.x = __builtin_amdgcn_rcpf(d.x); t.y = __builtin_amdgcn_rcpf(d.y);
    f32x2 q = t * 0.5307027145f + (-0.7265760135f); q = q * t + 0.7107068705f; q = q * t + (-0.142248368f); q = q * t + 0.127414796f; q = q * t;
    const f32x2 s = (v * v) * (-0.72134752044f);
    f32x2 e; e.x = __builtin_amdgcn_exp2f(s.x); e.y = __builtin_amdgcn_exp2f(s.y);
    const f32x2 m = v * (q * e), r = v - m;
    f32x2 o; o.x = v.x < 0.f ? m.x : r.x; o.y = v.y < 0.f ? m.y : r.y; return o;
}

template <int ACT  > struct EpiBf16 {
    static constexpr bool PERM = true, AFTER_DRAIN = false; static_assert(ACT == 0 || ACT == 1, "EpiBf16: ACT is 0 (none) or 1 (gelu_pk)");
    bf16_t* O; int ldc; const float* bias; int split_cols; size_t split_stride; float scale0;
    __device__ __forceinline__ void operator()(const f32x4 (&acc)[2][2][4][2], const Unit& u, int wr, int wc, int fr, int fq) const {
        const int row0 = u.pm * BM + wr * 64 + fr; int colt = u.pn * BM; bf16_t* base = O;
        float sc = 1.f; if (split_cols) { const int t = colt / split_cols; base += (size_t)t * split_stride; colt -= t * split_cols; if (t == 0) sc = scale0; }
        const int col0 = colt + wc * 32 + 8 * fq, bcol0 = u.pn * BM + wc * 32 + 8 * fq;
        f32x4 bv[2][2];
#pragma unroll
        for (int bj = 0; bj < 2; ++bj)
#pragma unroll
            for (int n = 0; n < 2; ++n) bv[bj][n] = bias ? *(const f32x4*)(bias + bcol0 + bj * HALF + 4 * n) : (f32x4){0.f, 0.f, 0.f, 0.f};
#pragma unroll
        for (int ai = 0; ai < 2; ++ai)
#pragma unroll
            for (int m = 0; m < 4; ++m) { bf16_t* rowp = base + (size_t)(row0 + ai * HALF + m * 16) * ldc + col0;
#pragma unroll
                for (int bj = 0; bj < 2; ++bj) { f32x4 v0 = acc[ai][bj][m][0] + bv[bj][0], v1 = acc[ai][bj][m][1] + bv[bj][1];
                    if (ACT == 1) { f32x2 a = gelu_pk((f32x2){v0[0], v0[1]}), b = gelu_pk((f32x2){v0[2], v0[3]}), c = gelu_pk((f32x2){v1[0], v1[1]}), d = gelu_pk((f32x2){v1[2], v1[3]});
                        v0 = (f32x4){a.x, a.y, b.x, b.y}; v1 = (f32x4){c.x, c.y, d.x, d.y}; }
                    v0 = v0 * sc; v1 = v1 * sc; u32x4 w; w.x = cvt_pk_bf16(v0[0], v0[1]); w.y = cvt_pk_bf16(v0[2], v0[3]); w.z = cvt_pk_bf16(v1[0], v1[1]); w.w = cvt_pk_bf16(v1[2], v1[3]);
                    *(u32x4*)(rowp + bj * HALF) = w; } }
    }
};
struct EpiResid {
    static constexpr bool PERM = false, AFTER_DRAIN = false;
    const float* base; float* out; int ldc; float* ssq;
    __device__ __forceinline__ void operator()(const f32x4 (&acc)[2][2][4][2], const Unit& u, int wr, int wc, int fr, int fq) const {
        const int row0 = u.pm * BM + wr * 64 + fr, col0 = u.pn * BM + wc * 32 + 4 * fq;
#pragma unroll
        for (int ai = 0; ai < 2; ++ai)
#pragma unroll
            for (int m = 0; m < 4; ++m) { const int row = row0 + ai * HALF + m * 16; const size_t off = (size_t)row * ldc + col0; float s = 0.f;
#pragma unroll
                for (int bj = 0; bj < 2; ++bj)
#pragma unroll
                    for (int n = 0; n < 2; ++n) { const f32x4 v = *(const f32x4*)(base + off + bj * HALF + n * 16) + acc[ai][bj][m][n];
                        *(f32x4*)(out + off + bj * HALF + n * 16) = v; s += (v[0] * v[0] + v[1] * v[1]) + (v[2] * v[2] + v[3] * v[3]); }
                s += __shfl_xor(s, 16); s += __shfl_xor(s, 32);
                if (fq == 0) atomicAdd(ssq + row, s);
                asm volatile("" ::: "memory"); }
    }
};
template <class Epi, class Sched, bool ALIGN_EPI = false, bool SP2 = false>
__device__ __forceinline__ void gemm_phase(PG8_LAS unsigned char* lds, const Gemm g, const Sched& S, const Epi& E) {
    const int tid = threadIdx.x, wid = __builtin_amdgcn_readfirstlane(tid >> 6), lane = tid & 63, wr = wid >> 2, wc = wid & 3, fr = lane & 15, fq = lane >> 4;
    const int K = g.K, nt = K / BK;
    unsigned voffA[2], voffB[2];
#pragma unroll
    for (int i = 0; i < 2; ++i) { int R, C; stage_rc(tid * 16 + i * 8192, R, C); const int Rb = Epi::PERM ? ((R & ~31) + perm32(R & 31)) : R;
        voffA[i] = (unsigned)(R * K + C) * 2u; voffB[i] = (unsigned)(Rb * K + C) * 2u; }
    const size_t kstep = (size_t)(BK * 2);
    const size_t hstep = (size_t)HALF * K * 2;
    const size_t tstep = 2 * hstep;
    const unsigned ldsw = (unsigned)wid * 1024u;
    const int aoff = lds_byte(wr * 64 + fr, fq * 8), boff = lds_byte(wc * 32 + fr, fq * 8);
#define PG8_SA(b, h) (((b) * 2 + (h)) * HTB)
#define PG8_SB(b, h) ((4 + (b) * 2 + (h)) * HTB)
#define PG8_STAGE(bufoff, gbase, voff) do { _Pragma("unroll") for (int _i = 0; _i < 2; ++_i) \
        __builtin_amdgcn_global_load_lds((const unsigned*)((const char*)(gbase) + (voff)[_i]), (PG8_LAS unsigned*)(lds + (bufoff) + ldsw + _i * 8192), 16, 0, 0); } while (0)
#define PG8_LDA(dst, b, h) do { _Pragma("unroll") for (int m = 0; m < 4; ++m) _Pragma("unroll") for (int k = 0; k < 2; ++k) dst[m][k] = *(const PG8_LAS bf16x8*)(lds + PG8_SA(b, h) + aoff + m * 2048 + k * 1024); } while (0)
#define PG8_LDB(dst, b, h) do { _Pragma("unroll") for (int n = 0; n < 2; ++n) _Pragma("unroll") for (int k = 0; k < 2; ++k) dst[n][k] = *(const PG8_LAS bf16x8*)(lds + PG8_SB(b, h) + boff + n * 2048 + k * 1024); } while (0)
#define PG8_MMA(ai, bj, At, Bt) do { __builtin_amdgcn_s_setprio(1); _Pragma("unroll") for (int m = 0; m < 4; ++m) _Pragma("unroll") for (int n = 0; n < 2; ++n) _Pragma("unroll") for (int k = 0; k < 2; ++k) \
        acc[ai][bj][m][n] = __builtin_amdgcn_mfma_f32_16x16x32_bf16(Bt[n][k], At[m][k], acc[ai][bj][m][n], 0, 0, 0); __builtin_amdgcn_s_setprio(0); } while (0)
#define PG8_WAIT_V(n) asm volatile("s_waitcnt vmcnt(" #n ")" ::: "memory")
#define PG8_WAIT_L(n) asm volatile("s_waitcnt lgkmcnt(" #n ")" ::: "memory")
#define PG8_BAR __builtin_amdgcn_s_barrier()
#define PG8_SCHED __builtin_amdgcn_sched_barrier(0)
    Unit cur, nxt; int ui = 0;
    if (!S.next(0, cur)) return;
    f32x4 acc[2][2][4][2];
#pragma unroll
    for (int a = 0; a < 2; ++a)
#pragma unroll
        for (int b = 0; b < 2; ++b)
#pragma unroll
            for (int m = 0; m < 4; ++m)
#pragma unroll
                for (int n = 0; n < 2; ++n) acc[a][b][m][n] = (f32x4){0.f, 0.f, 0.f, 0.f};
    bf16x8 At[4][2], B0[2][2], B1[2][2];
    const char* cA = (const char*)g.A + (size_t)cur.pm * tstep; const char* cB = (const char*)g.Bt + (size_t)cur.pn * tstep;
    S.a_ready(cur);
    if constexpr (SP2) {
        PG8_STAGE(PG8_SB(0, 0), cB, voffB); PG8_STAGE(PG8_SB(0, 1), cB + hstep, voffB); PG8_STAGE(PG8_SA(0, 0), cA, voffA); PG8_STAGE(PG8_SA(0, 1), cA + hstep, voffA);
        if (wr == 1) PG8_BAR;
        PG8_WAIT_V(2); PG8_BAR;
        PG8_STAGE(PG8_SB(1, 0), cB + kstep, voffB); PG8_STAGE(PG8_SA(1, 0), cA + kstep, voffA); PG8_STAGE(PG8_SB(1, 1), cB + hstep + kstep, voffB);
        PG8_WAIT_V(6); PG8_BAR;
    } else {
        PG8_STAGE(PG8_SB(0, 0), cB, voffB); PG8_STAGE(PG8_SA(0, 0), cA, voffA); PG8_STAGE(PG8_SB(0, 1), cB + hstep, voffB); PG8_STAGE(PG8_SA(0, 1), cA + hstep, voffA);
        if (wr == 1) PG8_BAR;
        PG8_WAIT_V(4); PG8_BAR;
        PG8_STAGE(PG8_SB(1, 0), cB + kstep, voffB); PG8_STAGE(PG8_SA(1, 0), cA + kstep, voffA); PG8_STAGE(PG8_SB(1, 1), cB + hstep + kstep, voffB);
        PG8_WAIT_V(6); PG8_BAR;
    }
    for (;;) {
        const bool has_next = S.next(ui + 1, nxt);
        const char* nA = has_next ? (const char*)g.A + (size_t)nxt.pm * tstep : cA; const char* nB = has_next ? (const char*)g.Bt + (size_t)nxt.pn * tstep : cB;
        for (int t = 0; t < nt; t += 2) {
            const bool last = (t == nt - 2);
            const char* a1 = cA + (size_t)(t + 1) * kstep;
            const char* a2 = last ? nA : cA + (size_t)(t + 2) * kstep; const char* b2 = last ? nB : cB + (size_t)(t + 2) * kstep;
            const char* a3 = a2 + kstep; const char* b3 = b2 + kstep;
            if (last && has_next) S.a_ready(nxt);
            if constexpr (SP2) {
            PG8_LDB(B0, 0, 0); PG8_LDB(B1, 0, 1); PG8_SCHED; PG8_LDA(At, 0, 0); PG8_STAGE(PG8_SA(1, 1), a1 + hstep, voffA);
            PG8_WAIT_V(8); PG8_WAIT_L(0); PG8_BAR; PG8_MMA(0, 0, At, B0); PG8_MMA(0, 1, At, B1); PG8_BAR; PG8_SCHED;
            PG8_LDA(At, 0, 1); PG8_STAGE(PG8_SB(0, 0), b2, voffB); PG8_STAGE(PG8_SB(0, 1), b2 + hstep, voffB); PG8_STAGE(PG8_SA(0, 0), a2, voffA);
            PG8_WAIT_V(8); PG8_WAIT_L(0); PG8_BAR; PG8_MMA(1, 0, At, B0); PG8_MMA(1, 1, At, B1); PG8_BAR; PG8_SCHED;
            PG8_LDB(B0, 1, 0); PG8_LDB(B1, 1, 1); PG8_SCHED; PG8_LDA(At, 1, 0); PG8_STAGE(PG8_SA(0, 1), a2 + hstep, voffA);
            PG8_WAIT_V(8); PG8_WAIT_L(0); PG8_BAR; PG8_MMA(0, 0, At, B0); PG8_MMA(0, 1, At, B1); PG8_BAR; PG8_SCHED;
            PG8_LDA(At, 1, 1); PG8_STAGE(PG8_SB(1, 0), b3, voffB); PG8_STAGE(PG8_SB(1, 1), b3 + hstep, voffB); PG8_STAGE(PG8_SA(1, 0), a3, voffA);
            PG8_WAIT_V(8); PG8_WAIT_L(0); PG8_BAR; PG8_MMA(1, 0, At, B0); PG8_MMA(1, 1, At, B1); PG8_BAR; PG8_SCHED;
            } else {
            PG8_LDB(B0, 0, 0); PG8_SCHED; PG8_LDA(At, 0, 0); PG8_STAGE(PG8_SA(1, 1), a1 + hstep, voffA);
            PG8_WAIT_L(8); PG8_BAR; PG8_WAIT_L(0); PG8_MMA(0, 0, At, B0); PG8_BAR; PG8_SCHED;
            PG8_LDB(B1, 0, 1); PG8_STAGE(PG8_SB(0, 0), b2, voffB);
            PG8_BAR; PG8_WAIT_L(0); PG8_MMA(0, 1, At, B1); PG8_BAR;
            PG8_LDA(At, 0, 1); PG8_STAGE(PG8_SA(0, 0), a2, voffA);
            PG8_BAR; PG8_WAIT_L(0); PG8_MMA(1, 0, At, B0); PG8_BAR; PG8_SCHED;
            PG8_STAGE(PG8_SB(0, 1), b2 + hstep, voffB);
            PG8_WAIT_V(6); PG8_BAR; PG8_MMA(1, 1, At, B1); PG8_BAR;
            PG8_LDB(B0, 1, 0); PG8_SCHED; PG8_LDA(At, 1, 0); PG8_STAGE(PG8_SA(0, 1), a2 + hstep, voffA);
            PG8_WAIT_L(8); PG8_BAR; PG8_WAIT_L(0); PG8_MMA(0, 0, At, B0); PG8_BAR; PG8_SCHED;
            PG8_LDB(B1, 1, 1); PG8_STAGE(PG8_SB(1, 0), b3, voffB);
            PG8_BAR; PG8_WAIT_L(0); PG8_MMA(0, 1, At, B1); PG8_BAR;
            PG8_LDA(At, 1, 1); PG8_STAGE(PG8_SA(1, 0), a3, voffA);
            PG8_BAR; PG8_WAIT_L(0); PG8_MMA(1, 0, At, B0); PG8_BAR; PG8_SCHED;
            PG8_STAGE(PG8_SB(1, 1), b3 + hstep, voffB);
            PG8_WAIT_V(6); PG8_BAR; PG8_MMA(1, 1, At, B1); PG8_BAR;
            }
        }
        if constexpr (ALIGN_EPI) { if (wr == 0) PG8_BAR; }
        if constexpr (!Epi::AFTER_DRAIN) { E(acc, cur, wr, wc, fr, fq); S.done(cur); }
        if (!has_next) break;
#pragma unroll
        for (int a = 0; a < 2; ++a)
#pragma unroll
            for (int b = 0; b < 2; ++b)
#pragma unroll
                for (int m = 0; m < 4; ++m)
#pragma unroll
                    for (int n = 0; n < 2; ++n) acc[a][b][m][n] = (f32x4){0.f, 0.f, 0.f, 0.f};
        cur = nxt; cA = nA; cB = nB; ++ui;
        if constexpr (ALIGN_EPI) { if (wr == 1) PG8_BAR; }
    }
    PG8_WAIT_V(0);
    if constexpr (!ALIGN_EPI) { if (wr == 0) PG8_BAR; }
    PG8_BAR;
    if constexpr (Epi::AFTER_DRAIN) { E.fused(acc, cur, wr, wc, fr, fq, lds, wid, lane); S.done(cur); }
#undef PG8_SA
#undef PG8_SB
#undef PG8_STAGE
#undef PG8_LDA
#undef PG8_LDB
#undef PG8_MMA
#undef PG8_WAIT_V
#undef PG8_WAIT_L
#undef PG8_BAR
#undef PG8_SCHED
}
}
#ifndef PG8_SP2
#define PG8_SP2 true
#endif
#ifndef PG8_ALIGN
#define PG8_ALIGN true
#endif

constexpr int NWAVES = 8, NTHREADS = NWAVES * 64;
constexpr int DM = 2048, NBATCH = 4, SEQ = 4096, M = NBATCH * SEQ;
constexpr int NPROJ_IN = 7184;
constexpr int NPJ = 7168;
constexpr int C_GQ = 0, C_GK = 512, C_GV = 1024, C_GG = 2048, C_HQ = 3072, C_HF = 4096, C_HI = 5120, C_HG = 6144;
constexpr int SRC_GLR = 3072;
constexpr float EPS = 1e-6f, QSCALE = 0.08838834764831845f, INV_TAU = 1.0f / 16.0f;
constexpr int CHUNK = 64, NCHUNK = SEQ / CHUNK;

constexpr size_t MiB = 1u << 20;
constexpr size_t WS_CTL = 0, CTL_ZERO_BYTES = 1 * MiB;
constexpr size_t WS_SSQ = 512 * 1024;
constexpr size_t WS_WINT = 2 * MiB;
constexpr size_t WS_WOUTT = 30 * MiB;
constexpr size_t WS_GLR = 39 * MiB;
constexpr size_t WS_HN = 64 * MiB;
constexpr size_t WS_MIX = 128 * MiB;
constexpr size_t WS_PJ = 192 * MiB;
constexpr size_t WS_END = 416 * MiB;

constexpr int LDS_BYTES = 147456;
constexpr int QK_STRIDE = 272, L_QT = 0, L_KT = 64 * QK_STRIDE, L_VR = 2 * 64 * QK_STRIDE, L_AM = L_VR + 64 * 528, L_TOT = L_AM + 64 * 144, L_FAC = L_TOT + 8 * 128 * 4, L_SS = L_FAC + 128 * 4, L_RS = L_SS + 8 * 64 * 4, L_LG = L_RS + 64 * 4, L_SCAN_END = L_LG + 64 * 128 * 4;
static_assert(L_SCAN_END <= LDS_BYTES, "scan LDS map");

#define LAS __attribute__((address_space(3)))
typedef unsigned short bf16;
typedef float f32x4 __attribute__((ext_vector_type(4)));
typedef float f32x2 __attribute__((ext_vector_type(2)));
typedef float f32x16 __attribute__((ext_vector_type(16)));
typedef short bf16x8 __attribute__((ext_vector_type(8)));
typedef short s16x4 __attribute__((ext_vector_type(4)));
typedef unsigned u32x4 __attribute__((ext_vector_type(4)));
typedef unsigned u32x2 __attribute__((ext_vector_type(2)));
typedef __bf16 bf16x2_t __attribute__((ext_vector_type(2)));
#define MFMA32(a, b, c) __builtin_amdgcn_mfma_f32_32x32x16_bf16((a), (b), (c), 0, 0, 0)

__device__ __forceinline__ unsigned pk2(float lo, float hi) { const bf16x2_t v = __builtin_convertvector((f32x2){lo, hi}, bf16x2_t); return __builtin_bit_cast(unsigned, v); }
__device__ __forceinline__ float bf_lo(unsigned u) { return __uint_as_float(u << 16); }
__device__ __forceinline__ float bf_hi(unsigned u) { return __uint_as_float(u & 0xffff0000u); }
__device__ __forceinline__ float bf_1(unsigned short u) { return __uint_as_float(((unsigned)u) << 16); }
__device__ __forceinline__ float wave_sum(float v) {
#pragma unroll
    for (int o = 1; o < 64; o <<= 1) v += __shfl_xor(v, o);
    return v;
}
__device__ __forceinline__ float sigmoidf_(float x) { return 1.0f / (1.0f + __expf(-x)); }

struct Frame {
    LAS unsigned char* lds;
    int tid, lane, wave, G, bid;
    const float *x, *norm_w, *w_in, *gla_w_up, *gla_b_up, *gla_norm_w, *hgrn_lb, *hgrn_norm_w, *w_out, *final_w;
    float* out;
    bf16 *WinT, *WoutT, *HN, *MIX, *PJ;
    float *GLR, *SSQ;
};

__device__ __forceinline__ void p0_transpose_item(const float* W, int ldw, int src_col, bf16* WT, int K, int dst_row, int kb, LAS float* scr, int lane) {
    const int k0 = 64 * kb;
#pragma unroll 8
    for (int i = 0; i < 32; ++i) { const int kk = 2 * i + (lane >> 5); scr[kk * 33 + (lane & 31)] = W[(size_t)(k0 + kk) * ldw + src_col + (lane & 31)]; }
    asm volatile("s_waitcnt lgkmcnt(0)" ::: "memory");
    const int c = lane & 7;
#pragma unroll
    for (int j = 0; j < 4; ++j) { const int n = (lane >> 3) + 8 * j; const LAS float* s = scr + (8 * c) * 33 + n;
        u32x4 o; o.x = pk2(s[0 * 33], s[1 * 33]); o.y = pk2(s[2 * 33], s[3 * 33]); o.z = pk2(s[4 * 33], s[5 * 33]); o.w = pk2(s[6 * 33], s[7 * 33]);
        *(u32x4*)(WT + (size_t)(dst_row + n) * K + k0 + 8 * c) = o; }
    asm volatile("s_waitcnt lgkmcnt(0)" ::: "memory");
}

__device__ __forceinline__ void p0_prologue(Frame& F) {
    const int gw = F.bid * NWAVES + F.wave, NGW = F.G * NWAVES;
    {
        LAS float* scr = (LAS float*)(F.lds + F.wave * 16384);
        constexpr int KB = DM / 64;
        constexpr int I_IN = KB * (NPJ / 32), I_OUT = KB * (DM / 32);
        for (int it = gw; it < I_IN + I_OUT; it += NGW) {
            if (it < I_IN) { const int kb = it / (NPJ / 32), nb = it % (NPJ / 32), n0 = 32 * nb; const int src = n0 < SRC_GLR ? n0 : n0 + 16;
                p0_transpose_item(F.w_in, NPROJ_IN, src, F.WinT, DM, n0, kb, scr, F.lane); }
            else { const int r = it - I_IN, kb = r / (DM / 32), nb = r % (DM / 32);
                p0_transpose_item(F.w_out, DM, 32 * nb, F.WoutT, DM, 32 * nb, kb, scr, F.lane); }
        }
    }
    __syncthreads();
    LAS float* Wt = (LAS float*)F.lds;
    for (int k = F.tid; k < DM; k += NTHREADS) {
        const f32x4* src = (const f32x4*)(F.w_in + (size_t)k * NPROJ_IN + SRC_GLR);
#pragma unroll
        for (int q = 0; q < 4; ++q) { const f32x4 v = src[q]; Wt[(4 * q + 0) * DM + k] = v[0]; Wt[(4 * q + 1) * DM + k] = v[1]; Wt[(4 * q + 2) * DM + k] = v[2]; Wt[(4 * q + 3) * DM + k] = v[3]; }
    }
    __syncthreads();
    f32x4 nw[8];
#pragma unroll
    for (int j = 0; j < 8; ++j) nw[j] = ((const f32x4*)F.norm_w)[64 * j + F.lane];
    const LAS f32x4* Wt4 = (const LAS f32x4*)Wt;
    for (int m = gw; m < M; m += NGW) {
        const f32x4* xr = (const f32x4*)(F.x + (size_t)m * DM) + F.lane;
        f32x4 v[8]; float s = 0.f;
#pragma unroll
        for (int j = 0; j < 8; ++j) { v[j] = xr[64 * j]; s += (v[j][0] * v[j][0] + v[j][1] * v[j][1]) + (v[j][2] * v[j][2] + v[j][3] * v[j][3]); }
        const float rstd = 1.0f / sqrtf(wave_sum(s) * (1.0f / DM) + EPS);
        float a[16];
#pragma unroll
        for (int c = 0; c < 16; ++c) a[c] = 0.f;
        u32x2* o8 = (u32x2*)(F.HN + (size_t)m * DM) + F.lane;
#pragma unroll
        for (int j = 0; j < 8; ++j) {
            v[j] = v[j] * rstd * nw[j];
            u32x2 w; w.x = pk2(v[j][0], v[j][1]); w.y = pk2(v[j][2], v[j][3]); o8[64 * j] = w;
            asm volatile("" ::: "memory");
#pragma unroll
            for (int c = 0; c < 16; ++c) { const f32x4 wv = Wt4[c * (DM / 4) + 64 * j + F.lane]; a[c] += (v[j][0] * wv[0] + v[j][1] * wv[1]) + (v[j][2] * wv[2] + v[j][3] * wv[3]); }
        }
        float mine = 0.f;
#pragma unroll
        for (int c = 0; c < 16; ++c) { const float t = wave_sum(a[c]); mine = (F.lane == c) ? t : mine; }
        if (F.lane < 16) F.GLR[(size_t)m * 16 + F.lane] = mine;
    }
    __syncthreads();
}

__device__ __forceinline__ bf16x8 tr_frag(LAS unsigned char* img, unsigned lanebase, unsigned stride, unsigned c, unsigned ks) {
    const unsigned a0 = lanebase + (16 * ks) * stride + 64 * c;
    const s16x4 lo = __builtin_amdgcn_ds_read_tr16_b64_v4i16((LAS s16x4*)(img + a0));
    const s16x4 hi = __builtin_amdgcn_ds_read_tr16_b64_v4i16((LAS s16x4*)(img + a0 + 4 * stride));
    return __builtin_shufflevector(lo, hi, 0, 1, 2, 3, 4, 5, 6, 7);
}

__device__ __forceinline__ void scan_item(Frame& F, const int gla, const int b, const int h) {
    const int tid = F.tid, lane = F.lane, wave = F.wave;
    LAS unsigned char* lds = F.lds;
    LAS unsigned char* QT = lds + L_QT; LAS unsigned char* KT = lds + L_KT; LAS unsigned char* VR = lds + L_VR; LAS unsigned char* AM = lds + L_AM;
    LAS float* TOT = (LAS float*)(lds + L_TOT); LAS float* FAC = (LAS float*)(lds + L_FAC); LAS float* SS = (LAS float*)(lds + L_SS); LAS float* RS = (LAS float*)(lds + L_RS);
    const int dv = gla ? 256 : 128, nmw = dv / 32;
    const int qcol = gla ? C_GQ + h * 128 : C_HQ + h * 128, kcol = gla ? C_GK + h * 128 : C_HF + h * 128;
    const int vcol = gla ? C_GV + h * 256 : C_HI + h * 128, gcol = gla ? C_GG + h * 256 : C_HG + h * 128;
    const int mcol = gla ? h * 256 : 1024 + h * 128;
    const float* normw = gla ? F.gla_norm_w + h * 256 : F.hgrn_norm_w + h * 128;
    const int dp = tid & 63, d0 = 2 * dp;
    float wub[8], bub = 0.f, lb0 = 0.f, lb1 = 0.f;
    LAS float* LG = (LAS float*)(lds + L_LG);
    if (gla) {
        const int col = h * 128 + 32 * (wave & 3) + (lane & 31);
#pragma unroll
        for (int s = 0; s < 8; ++s) wub[s] = F.gla_w_up[(size_t)(2 * s + (lane >> 5)) * 512 + col];
        bub = F.gla_b_up[col];
    } else {
#pragma unroll
        for (int s = 0; s < 8; ++s) wub[s] = 0.f;
        const f32x2 l0 = *(const f32x2*)(F.hgrn_lb + h * 128 + d0), l1 = *(const f32x2*)(F.hgrn_lb + 1024 + h * 128 + d0);
        lb0 = 1.0f / (1.0f + __expf(l1[0] - l0[0])); lb1 = 1.0f / (1.0f + __expf(l1[1] - l0[1]));
    }
    float elp0 = 1.f, elp1 = 1.f;
    f32x16 S[4];
#pragma unroll
    for (int i = 0; i < 4; ++i)
#pragma unroll
        for (int j = 0; j < 16; ++j) S[i][j] = 0.f;
    const unsigned r = lane & 31, hh = lane >> 5;
    const unsigned vstride = 2 * dv + 16;
    const unsigned tq = (lane & 15) >> 2, tp = lane & 3, tblk = (lane >> 4) & 1;
    const unsigned trk = (8 * hh + tq) * QK_STRIDE + 32 * tblk + 8 * tp, trv = (8 * hh + tq) * vstride + 32 * tblk + 8 * tp;
    const size_t row0 = (size_t)b * SEQ;

    for (int c = 0; c < NCHUNK; ++c) {
        const size_t t0 = row0 + (size_t)c * CHUNK;
        if (gla) {
            const float* gp = F.GLR + (t0 + 32 * (wave >> 2) + (lane & 31)) * 16 + (lane >> 5);
            f32x16 z;
#pragma unroll
            for (int j = 0; j < 16; ++j) z[j] = 0.f;
#pragma unroll
            for (int s = 0; s < 8; ++s) z = __builtin_amdgcn_mfma_f32_32x32x2f32(gp[2 * s], wub[s], z, 0, 0, 0);
#pragma unroll
            for (int reg = 0; reg < 16; ++reg) { const float zz = z[reg] + bub; const int row = 32 * (wave >> 2) + (reg & 3) + 8 * (reg >> 2) + 4 * (lane >> 5);
                LG[row * 128 + 32 * (wave & 3) + (lane & 31)] = (fminf(zz, 0.f) - __logf(1.0f + __expf(-fabsf(zz)))) * INV_TAU; }
            __syncthreads();
        }
        unsigned qp[8]; float k0[8], k1[8], c0[8], c1[8];
        {
            float cum0 = 0.f, cum1 = 0.f;
#pragma unroll
            for (int i = 0; i < 8; ++i) {
                const size_t t = t0 + 8 * wave + i;
                const unsigned kv = *(const unsigned*)(F.PJ + t * NPJ + kcol + d0);
                qp[i] = *(const unsigned*)(F.PJ + t * NPJ + qcol + d0);
                float lg0, lg1;
                if (gla) {
                    const f32x2 lgv = *(const LAS f32x2*)(LG + (8 * wave + i) * 128 + d0); lg0 = lgv[0]; lg1 = lgv[1];
                    k0[i] = bf_lo(kv); k1[i] = bf_hi(kv);
                } else {
                    const float s0 = sigmoidf_(bf_lo(kv)), s1 = sigmoidf_(bf_hi(kv));
                    const float f0 = lb0 + (1.0f - lb0) * s0, f1 = lb1 + (1.0f - lb1) * s1;
                    lg0 = __logf(f0); lg1 = __logf(f1); k0[i] = 1.0f - f0; k1[i] = 1.0f - f1;
                }
                cum0 += lg0; cum1 += lg1; c0[i] = cum0; c1[i] = cum1;
            }
            *(LAS f32x2*)(TOT + wave * 128 + d0) = (f32x2){cum0, cum1};
        }
        __syncthreads();
        {
            float off0 = 0.f, off1 = 0.f, r0 = 0.f, r1 = 0.f, bl0 = 0.f, bl1 = 0.f;
#pragma unroll
            for (int g = 0; g < 8; ++g) { const f32x2 tv = *(const LAS f32x2*)(TOT + g * 128 + d0);
                if (g < wave) { off0 += tv[0]; off1 += tv[1]; } if (g < 4) { r0 += tv[0]; r1 += tv[1]; } bl0 += tv[0]; bl1 += tv[1]; }
#pragma unroll
            for (int i = 0; i < 8; ++i) {
                const float b0 = off0 + c0[i] - r0, b1 = off1 + c1[i] - r1;
                const unsigned row = 8 * wave + i;
                const unsigned o = row * QK_STRIDE + 4 * dp;
                *(LAS unsigned*)(QT + o) = pk2(bf_lo(qp[i]) * QSCALE * __expf(b0), bf_hi(qp[i]) * QSCALE * __expf(b1));
                *(LAS unsigned*)(KT + o) = pk2(k0[i] * __expf(-b0), k1[i] * __expf(-b1));
            }
            if (wave == 0) { *(LAS f32x2*)(FAC + d0) = (f32x2){__expf(r0) * elp0, __expf(r1) * elp1}; elp0 = __expf(bl0 - r0); elp1 = __expf(bl1 - r1); }
        }
        {
            const int cpr = dv / 8;
            for (int idx = tid; idx < 64 * cpr; idx += NTHREADS) { const int row = idx / cpr, ch = idx % cpr;
                const u32x4 v = *(const u32x4*)(F.PJ + (t0 + row) * NPJ + vcol + 8 * ch);
                *(LAS u32x4*)(VR + row * vstride + 16 * ch) = v; }
        }
        __syncthreads();
        if (wave < 3) {
            const int it = wave > 0, jt = wave > 1;
            f32x16 a;
#pragma unroll
            for (int j = 0; j < 16; ++j) a[j] = 0.f;
#pragma unroll
            for (int s = 0; s < 8; ++s) { const bf16x8 qa = *(const LAS bf16x8*)(QT + (32 * it + r) * QK_STRIDE + 32 * s + 16 * hh); const bf16x8 kb = *(const LAS bf16x8*)(KT + (32 * jt + r) * QK_STRIDE + 32 * s + 16 * hh); a = MFMA32(qa, kb, a); }
            const int jj = 32 * jt + r;
#pragma unroll
            for (int reg = 0; reg < 16; ++reg) { const int ii = 32 * it + (reg & 3) + 8 * (reg >> 2) + 4 * hh; const float v = (jj <= ii) ? a[reg] : 0.f;
                *(LAS unsigned short*)(AM + ii * 144 + jj * 2) = (unsigned short)(pk2(v, 0.f) & 0xffffu); }
        }
        __syncthreads();
        f32x16 o[2];
        if (wave < nmw) {
#pragma unroll
            for (int i = 0; i < 2; ++i)
#pragma unroll
                for (int j = 0; j < 16; ++j) o[i][j] = 0.f;
#pragma unroll
            for (int db = 0; db < 4; ++db) {
                asm volatile("" ::: "memory");
#pragma unroll
                for (int g4 = 0; g4 < 4; ++g4) { const f32x4 fv = *(const LAS f32x4*)(FAC + 32 * db + 8 * g4 + 4 * hh);
#pragma unroll
                    for (int e = 0; e < 4; ++e) S[db][4 * g4 + e] *= fv[e]; }
#pragma unroll
                for (int s = 0; s < 2; ++s) {
                    u32x4 pb; pb.x = pk2(S[db][8 * s + 0], S[db][8 * s + 1]); pb.y = pk2(S[db][8 * s + 2], S[db][8 * s + 3]); pb.z = pk2(S[db][8 * s + 4], S[db][8 * s + 5]); pb.w = pk2(S[db][8 * s + 6], S[db][8 * s + 7]);
                    const bf16x8 bs = __builtin_bit_cast(bf16x8, pb);
#pragma unroll
                    for (int it = 0; it < 2; ++it) {
                        const LAS unsigned char* qp = QT + (32 * it + r) * QK_STRIDE + 64 * db + 32 * s + 8 * hh; const s16x4 lo = *(const LAS s16x4*)qp, hi = *(const LAS s16x4*)(qp + 16);
                        o[it] = MFMA32(__builtin_shufflevector(lo, hi, 0, 1, 2, 3, 4, 5, 6, 7), bs, o[it]);
                    }
                }
            }
            bf16x8 vf[4];
#pragma unroll
            for (int ks = 0; ks < 4; ++ks) vf[ks] = tr_frag(VR, trv, vstride, wave, ks);
#pragma unroll
            for (int it = 0; it < 2; ++it)
#pragma unroll
                for (int ks = 0; ks < 4; ++ks) { if (it == 0 && ks >= 2) continue;
                    const bf16x8 af = *(const LAS bf16x8*)(AM + (32 * it + r) * 144 + (16 * ks + 8 * hh) * 2); o[it] = MFMA32(af, vf[ks], o[it]); }
#pragma unroll
            for (int db = 0; db < 4; ++db) {
                asm volatile("" ::: "memory");
#pragma unroll
                for (int ks = 0; ks < 4; ++ks) { const bf16x8 kf = tr_frag(KT, trk, QK_STRIDE, db, ks); S[db] = MFMA32(kf, vf[ks], S[db]); } }
            asm volatile("" ::: "memory");
#pragma unroll
            for (int it = 0; it < 2; ++it)
#pragma unroll
                for (int reg = 0; reg < 16; ++reg) { float sq = o[it][reg] * o[it][reg];
                    sq += __shfl_xor(sq, 1); sq += __shfl_xor(sq, 2); sq += __shfl_xor(sq, 4); sq += __shfl_xor(sq, 8); sq += __shfl_xor(sq, 16);
                    if (r == 0) SS[wave * 64 + 32 * it + (reg & 3) + 8 * (reg >> 2) + 4 * hh] = sq; }
        }
        __syncthreads();
        if (tid < 64) { float tsum = 0.f; for (int w = 0; w < nmw; ++w) tsum += SS[w * 64 + tid]; RS[tid] = 1.0f / sqrtf(tsum / (float)dv + EPS); }
        __syncthreads();
        if (wave < nmw) {
            const int e = 32 * wave + r; const float gn = normw[e];
#pragma unroll
            for (int it = 0; it < 2; ++it)
#pragma unroll
                for (int g4 = 0; g4 < 4; ++g4) { const f32x4 rs = *(const LAS f32x4*)(RS + 32 * it + 8 * g4 + 4 * hh);
#pragma unroll
                    for (int e4 = 0; e4 < 4; ++e4) { const int reg = 4 * g4 + e4; const size_t t = t0 + 32 * it + 8 * g4 + 4 * hh + e4;
                        const float gate = bf_1(F.PJ[t * NPJ + gcol + e]); const float val = o[it][reg] * rs[e4] * gn * (gate * sigmoidf_(gate));
                        F.MIX[t * DM + mcol + e] = (unsigned short)(pk2(val, 0.f) & 0xffffu); } }
        }
    }
    __syncthreads();
}

__device__ __forceinline__ void p2_scan(Frame& F) {
    for (int it = F.bid; it < 48; it += F.G) {
        if (it < 16) scan_item(F, 1, it >> 2, it & 3);
        else { const int j = it - 16; scan_item(F, 0, j >> 3, j & 7); }
    }
}

__device__ __forceinline__ void p4_final(Frame& F) {
    const int gw = F.bid * NWAVES + F.wave, NGW = F.G * NWAVES;
    f32x4 fw[8];
#pragma unroll
    for (int j = 0; j < 8; ++j) fw[j] = ((const f32x4*)F.final_w)[64 * j + F.lane];
    for (int m = gw; m < M; m += NGW) {
        const float rstd = 1.0f / sqrtf(F.SSQ[m] * (1.0f / DM) + EPS);
        f32x4* orow = (f32x4*)(F.out + (size_t)m * DM) + F.lane;
        f32x4 v[8];
#pragma unroll
        for (int j = 0; j < 8; ++j) v[j] = orow[64 * j];
#pragma unroll
        for (int j = 0; j < 8; ++j) orow[64 * j] = v[j] * rstd * fw[j];
    }
}

struct Args { const float* in[10]; float* out; unsigned char* ws; int ph_lo, ph_hi; };
__global__ void __launch_bounds__(NTHREADS, 2) mk_fwd(Args args) {
    extern __shared__ __attribute__((aligned(16))) unsigned char lds_raw[];
    Frame F;
    F.lds = (LAS unsigned char*)lds_raw;
    F.tid = threadIdx.x; F.lane = F.tid & 63; F.wave = __builtin_amdgcn_readfirstlane(F.tid >> 6);
    F.G = gridDim.x; F.bid = blockIdx.x;
    F.x = args.in[0]; F.norm_w = args.in[1]; F.w_in = args.in[2]; F.gla_w_up = args.in[3]; F.gla_b_up = args.in[4]; F.gla_norm_w = args.in[5];
    F.hgrn_lb = args.in[6]; F.hgrn_norm_w = args.in[7]; F.w_out = args.in[8]; F.final_w = args.in[9]; F.out = args.out;
    unsigned char* ws = args.ws;
    F.WinT = (bf16*)(ws + WS_WINT); F.WoutT = (bf16*)(ws + WS_WOUTT); F.HN = (bf16*)(ws + WS_HN); F.MIX = (bf16*)(ws + WS_MIX); F.PJ = (bf16*)(ws + WS_PJ);
    F.GLR = (float*)(ws + WS_GLR); F.SSQ = (float*)(ws + WS_SSQ);
    const int lo = args.ph_lo, hi = args.ph_hi;
#ifndef MK_PHASE_MASK
#define MK_PHASE_MASK 31
#endif
#define IN(k) (((MK_PHASE_MASK >> (k)) & 1) && lo <= (k) && (k) < hi)
#define BOTH(k) (IN(k) && IN((k) + 1))
#if MK_ONE_LAUNCH
#define GRID_BAR() do { cg::this_grid().sync(); } while (0)
#else
#define GRID_BAR() do { } while (0)
#endif
    if (IN(0)) { p0_prologue(F); if (BOTH(0)) GRID_BAR(); }
    if (IN(1)) {
        pg8::Gemm g{F.HN, F.WinT, M, NPJ, DM}; pg8::StaticOrder S; S.init(M, NPJ, F.G, F.bid);
        pg8::EpiBf16<0> E{F.PJ, NPJ, nullptr, 0, 0, 1.f};
        pg8::gemm_phase<pg8::EpiBf16<0>, pg8::StaticOrder, PG8_ALIGN, PG8_SP2>(F.lds, g, S, E);
        if (BOTH(1)) GRID_BAR();
    }
    if (IN(2)) { p2_scan(F); if (BOTH(2)) GRID_BAR(); }
    if (IN(3)) {
        pg8::Gemm g{F.MIX, F.WoutT, M, DM, DM}; pg8::StaticOrder S; S.init(M, DM, F.G, F.bid);
        pg8::EpiResid E{F.x, F.out, DM, F.SSQ};
        pg8::gemm_phase<pg8::EpiResid, pg8::StaticOrder, PG8_ALIGN, PG8_SP2>(F.lds, g, S, E);
        if (BOTH(3)) GRID_BAR();
    }
    if (IN(4)) { p4_final(F); }
#undef IN
#undef BOTH
}

extern "C" void kernel_launch(void* const* d_in, const int* in_sizes, int n_in, void* d_out, int out_size, void* d_ws, size_t ws_size, hipStream_t stream) {
    static int grid = 0;
    if (grid == 0) {
        if (n_in != 10 || in_sizes[0] != M * DM || out_size != M * DM || ws_size < WS_END) { fprintf(stderr, "kernel_launch: unexpected shapes (n_in %d, in0 %d, out %d, ws %zu)\n", n_in, n_in > 0 ? in_sizes[0] : -1, out_size, ws_size); grid = -1; return; }
        int dev = 0, cus = 0, per_cu = 0;
        if (hipGetDevice(&dev) != hipSuccess || hipDeviceGetAttribute(&cus, hipDeviceAttributeMultiprocessorCount, dev) != hipSuccess) { grid = -1; return; }
        if (hipFuncSetAttribute((const void*)mk_fwd, hipFuncAttributeMaxDynamicSharedMemorySize, LDS_BYTES) != hipSuccess) { fprintf(stderr, "kernel_launch: hipFuncSetAttribute failed\n"); grid = -1; return; }
        if (hipOccupancyMaxActiveBlocksPerMultiprocessor(&per_cu, (const void*)mk_fwd, NTHREADS, LDS_BYTES) != hipSuccess || per_cu < 1) { fprintf(stderr, "kernel_launch: occupancy query says %d blocks per CU\n", per_cu); grid = -1; return; }
        (void)hipGetLastError();
        grid = cus;
    }
    if (grid < 0) return;
    (void)hipMemsetAsync((char*)d_ws + WS_CTL, 0, CTL_ZERO_BYTES, stream);
    Args a{};
    for (int i = 0; i < 10; ++i) a.in[i] = (const float*)d_in[i];
    a.out = (float*)d_out; a.ws = (unsigned char*)d_ws;
#if MK_ONE_LAUNCH
    a.ph_lo = 0; a.ph_hi = 5;
    void* kargs[] = {&a};
    hipError_t e = hipLaunchCooperativeKernel((const void*)mk_fwd, dim3(grid), dim3(NTHREADS), kargs, LDS_BYTES, stream);
    if (e != hipSuccess) fprintf(stderr, "kernel_launch: cooperative launch failed: %s (grid %d)\n", hipGetErrorString(e), grid);
#else
    for (int p = 0; p < 5; ++p) { a.ph_lo = p; a.ph_hi = p + 1; hipLaunchKernelGGL(mk_fwd, dim3(grid), dim3(NTHREADS), LDS_BYTES, stream, a); }
#endif
}
```

```cpp
#include <hip/hip_runtime.h>
#include <hip/hip_cooperative_groups.h>
#include <cstdio>
#include <cstdint>
namespace cg = cooperative_groups;
#ifndef MK_ONE_LAUNCH
#define MK_ONE_LAUNCH 1
#endif
namespace pg8 {
#define PG8_LAS __attribute__((address_space(3)))
typedef unsigned short bf16_t;
typedef short bf16x8 __attribute__((ext_vector_type(8)));
typedef float f32x4 __attribute__((ext_vector_type(4)));
typedef unsigned u32x4 __attribute__((ext_vector_type(4)));
constexpr int BM = 256, BK = 64, HALF = 128, HTB = HALF * BK * 2  , STAGE_BYTES = 8 * HTB, NXCD = 8, WGM = 8;

__host__ __device__ __forceinline__ int lds_byte(int r, int c) { const int st = (r >> 4) * 2 + (c >> 5), rr = r & 15, cc = c & 31, ob = rr * 64 + cc * 2; return st * 1024 + (ob ^ (((ob >> 9) & 1) << 5)); }
__host__ __device__ __forceinline__ void stage_rc(int b, int& R, int& C) { const int st = b / 1024, sb = b % 1024, swz = sb ^ (((sb >> 9) & 1) << 5); R = (st >> 1) * 16 + swz / 64; C = (st & 1) * 32 + (swz % 64) / 2; }
__host__ __device__ __forceinline__ int perm32(int rho) { const int n = rho >> 4, i = rho & 15; return 8 * (i >> 2) + 4 * n + (i & 3); }

struct Unit { int pm, pn; };
struct Gemm { const bf16_t* A; const bf16_t* Bt; int M, N, K; };

struct StaticOrder {
    int nM, nN, nwg, G, c;
    __host__ __device__ void init(int M, int N, int G_, int c_) { nM = M / BM; nN = N / BM; nwg = nM * nN; G = G_; c = c_; }
    __host__ __device__ bool next(int i, Unit& u) const {
        const long L = (long)i * G + c; if (L >= nwg) return false;
        int wgid = (int)L; { const int q = nwg / NXCD, r = nwg % NXCD, xcd = wgid % NXCD, off = wgid / NXCD; wgid = (xcd < r ? xcd * (q + 1) : r * (q + 1) + (xcd - r) * q) + off; }
        const int nig = WGM * nN, gid = wgid / nig, fm = gid * WGM, gsz = (nM - fm) < WGM ? (nM - fm) : WGM;
        u.pm = fm + ((wgid % nig) % gsz); u.pn = (wgid % nig) / gsz; return true;
    }
    __device__ __forceinline__ void a_ready(const Unit&) const {}
    __device__ __forceinline__ void done(const Unit&) const {}
};

__device__ __forceinline__ unsigned cvt_pk_bf16(float lo, float hi) { unsigned r; asm volatile("v_cvt_pk_bf16_f32 %0, %1, %2" : "=v"(r) : "v"(lo), "v"(hi)); return r; }
typedef float f32x2 __attribute__((ext_vector_type(2)));
__device__ __forceinline__ f32x2 gelu_pk(f32x2 v) {
    const f32x2 av = __builtin_elementwise_abs(v), d = av * 0.2316418882f + 1.0f;
    f32x2 t; t.x = __builtin_amdgcn_rcpf(d.x); t.y = __builtin_amdgcn_rcpf(d.y);
    f32x2 q = t * 0.5307027145f + (-0.7265760135f); q = q * t + 0.7107068705f; q = q * t + (-0.142248368f); q = q * t + 0.127414796f; q = q * t;
    const f32x2 s = (v * v) * (-0.72134752044f);
    f32x2 e; e.x = __builtin_amdgcn_exp2f(s.x); e.y = __builtin_amdgcn_exp2f(s.y);
    const f32x2 m = v * (q * e), r = v - m;
    f32x2 o; o.x = v.x < 0.f ? m.x : r.x; o.y = v.y < 0.f ? m.y : r.y; return o;
}

template <int ACT  > struct EpiBf16 {
    static constexpr bool PERM = true, AFTER_DRAIN = false; static_assert(ACT == 0 || ACT == 1, "EpiBf16: ACT is 0 (none) or 1 (gelu_pk)");
    bf16_t* O; int ldc; const float* bias; int split_cols; size_t split_stride; float scale0;
    __device__ __forceinline__ void operator()(const f32x4 (&acc)[2][2][4][2], const Unit& u, int wr, int wc, int fr, int fq) const {
        const int row0 = u.pm * BM + wr * 64 + fr; int colt = u.pn * BM; bf16_t* base = O;
        float sc = 1.f; if (split_cols) { const int t = colt / split_cols; base += (size_t)t * split_stride; colt -= t * split_cols; if (t == 0) sc = scale0; }
        const int col0 = colt + wc * 32 + 8 * fq, bcol0 = u.pn * BM + wc * 32 + 8 * fq;
        f32x4 bv[2][2];
#pragma unroll
        for (int bj = 0; bj < 2; ++bj)
#pragma unroll
            for (int n = 0; n < 2; ++n) bv[bj][n] = bias ? *(const f32x4*)(bias + bcol0 + bj * HALF + 4 * n) : (f32x4){0.f, 0.f, 0.f, 0.f};
#pragma unroll
        for (int ai = 0; ai < 2; ++ai)
#pragma unroll
            for (int m = 0; m < 4; ++m) { bf16_t* rowp = base + (size_t)(row0 + ai * HALF + m * 16) * ldc + col0;
#pragma unroll
                for (int bj = 0; bj < 2; ++bj) { f32x4 v0 = acc[ai][bj][m][0] + bv[bj][0], v1 = acc[ai][bj][m][1] + bv[bj][1];
                    if (ACT == 1) { f32x2 a = gelu_pk((f32x2){v0[0], v0[1]}), b = gelu_pk((f32x2){v0[2], v0[3]}), c = gelu_pk((f32x2){v1[0], v1[1]}), d = gelu_pk((f32x2){v1[2], v1[3]});
                        v0 = (f32x4){a.x, a.y, b.x, b.y}; v1 = (f32x4){c.x, c.y, d.x, d.y}; }
                    v0 = v0 * sc; v1 = v1 * sc; u32x4 w; w.x = cvt_pk_bf16(v0[0], v0[1]); w.y = cvt_pk_bf16(v0[2], v0[3]); w.z = cvt_pk_bf16(v1[0], v1[1]); w.w = cvt_pk_bf16(v1[2], v1[3]);
                    *(u32x4*)(rowp + bj * HALF) = w; } }
    }
};
struct EpiResid {
    static constexpr bool PERM = false, AFTER_DRAIN = false;
    const float* base; float* out; int ldc; float* ssq;
    __device__ __forceinline__ void operator()(const f32x4 (&acc)[2][2][4][2], const Unit& u, int wr, int wc, int fr, int fq) const {
        const int row0 = u.pm * BM + wr * 64 + fr, col0 = u.pn * BM + wc * 32 + 4 * fq;
#pragma unroll
        for (int ai = 0; ai < 2; ++ai)
#pragma unroll
            for (int m = 0; m < 4; ++m) { const int row = row0 + ai * HALF + m * 16; const size_t off = (size_t)row * ldc + col0; float s = 0.f;
#pragma unroll
                for (int bj = 0; bj < 2; ++bj)
#pragma unroll
                    for (int n = 0; n < 2; ++n) { const f32x4 v = *(const f32x4*)(base + off + bj * HALF + n * 16) + acc[ai][bj][m][n];
                        *(f32x4*)(out + off + bj * HALF + n * 16) = v; s += (v[0] * v[0] + v[1] * v[1]) + (v[2] * v[2] + v[3] * v[3]); }
                s += __shfl_xor(s, 16); s += __shfl_xor(s, 32);
                if (fq == 0) atomicAdd(ssq + row, s);
                asm volatile("" ::: "memory"); }
    }
};
template <class Epi, class Sched, bool ALIGN_EPI = false, bool SP2 = false>
__device__ __forceinline__ void gemm_phase(PG8_LAS unsigned char* lds, const Gemm g, const Sched& S, const Epi& E) {
    const int tid = threadIdx.x, wid = __builtin_amdgcn_readfirstlane(tid >> 6), lane = tid & 63, wr = wid >> 2, wc = wid & 3, fr = lane & 15, fq = lane >> 4;
    const int K = g.K, nt = K / BK;
    unsigned voffA[2], voffB[2];
#pragma unroll
    for (int i = 0; i < 2; ++i) { int R, C; stage_rc(tid * 16 + i * 8192, R, C); const int Rb = Epi::PERM ? ((R & ~31) + perm32(R & 31)) : R;
        voffA[i] = (unsigned)(R * K + C) * 2u; voffB[i] = (unsigned)(Rb * K + C) * 2u; }
    const size_t kstep = (size_t)(BK * 2);
    const size_t hstep = (size_t)HALF * K * 2;
    const size_t tstep = 2 * hstep;
    const unsigned ldsw = (unsigned)wid * 1024u;
    const int aoff = lds_byte(wr * 64 + fr, fq * 8), boff = lds_byte(wc * 32 + fr, fq * 8);
#define PG8_SA(b, h) (((b) * 2 + (h)) * HTB)
#define PG8_SB(b, h) ((4 + (b) * 2 + (h)) * HTB)
#define PG8_STAGE(bufoff, gbase, voff) do { _Pragma("unroll") for (int _i = 0; _i < 2; ++_i) \
        __builtin_amdgcn_global_load_lds((const unsigned*)((const char*)(gbase) + (voff)[_i]), (PG8_LAS unsigned*)(lds + (bufoff) + ldsw + _i * 8192), 16, 0, 0); } while (0)
#define PG8_LDA(dst, b, h) do { _Pragma("unroll") for (int m = 0; m < 4; ++m) _Pragma("unroll") for (int k = 0; k < 2; ++k) dst[m][k] = *(const PG8_LAS bf16x8*)(lds + PG8_SA(b, h) + aoff + m * 2048 + k * 1024); } while (0)
#define PG8_LDB(dst, b, h) do { _Pragma("unroll") for (int n = 0; n < 2; ++n) _Pragma("unroll") for (int k = 0; k < 2; ++k) dst[n][k] = *(const PG8_LAS bf16x8*)(lds + PG8_SB(b, h) + boff + n * 2048 + k * 1024); } while (0)
#define PG8_MMA(ai, bj, At, Bt) do { __builtin_amdgcn_s_setprio(1); _Pragma("unroll") for (int m = 0; m < 4; ++m) _Pragma("unroll") for (int n = 0; n < 2; ++n) _Pragma("unroll") for (int k = 0; k < 2; ++k) \
        acc[ai][bj][m][n] = __builtin_amdgcn_mfma_f32_16x16x32_bf16(Bt[n][k], At[m][k], acc[ai][bj][m][n], 0, 0, 0); __builtin_amdgcn_s_setprio(0); } while (0)
#define PG8_WAIT_V(n) asm volatile("s_waitcnt vmcnt(" #n ")" ::: "memory")
#define PG8_WAIT_L(n) asm volatile("s_waitcnt lgkmcnt(" #n ")" ::: "memory")
#define PG8_BAR __builtin_amdgcn_s_barrier()
#define PG8_SCHED __builtin_amdgcn_sched_barrier(0)
    Unit cur, nxt; int ui = 0;
    if (!S.next(0, cur)) return;
    f32x4 acc[2][2][4][2];
#pragma unroll
    for (int a = 0; a < 2; ++a)
#pragma unroll
        for (int b = 0; b < 2; ++b)
#pragma unroll
            for (int m = 0; m < 4; ++m)
#pragma unroll
                for (int n = 0; n < 2; ++n) acc[a][b][m][n] = (f32x4){0.f, 0.f, 0.f, 0.f};
    bf16x8 At[4][2], B0[2][2], B1[2][2];
    const char* cA = (const char*)g.A + (size_t)cur.pm * tstep; const char* cB = (const char*)g.Bt + (size_t)cur.pn * tstep;
    S.a_ready(cur);
    if constexpr (SP2) {
        PG8_STAGE(PG8_SB(0, 0), cB, voffB); PG8_STAGE(PG8_SB(0, 1), cB + hstep, voffB); PG8_STAGE(PG8_SA(0, 0), cA, voffA); PG8_STAGE(PG8_SA(0, 1), cA + hstep, voffA);
        if (wr == 1) PG8_BAR;
        PG8_WAIT_V(2); PG8_BAR;
        PG8_STAGE(PG8_SB(1, 0), cB + kstep, voffB); PG8_STAGE(PG8_SA(1, 0), cA + kstep, voffA); PG8_STAGE(PG8_SB(1, 1), cB + hstep + kstep, voffB);
        PG8_WAIT_V(6); PG8_BAR;
    } else {
        PG8_STAGE(PG8_SB(0, 0), cB, voffB); PG8_STAGE(PG8_SA(0, 0), cA, voffA); PG8_STAGE(PG8_SB(0, 1), cB + hstep, voffB); PG8_STAGE(PG8_SA(0, 1), cA + hstep, voffA);
        if (wr == 1) PG8_BAR;
        PG8_WAIT_V(4); PG8_BAR;
        PG8_STAGE(PG8_SB(1, 0), cB + kstep, voffB); PG8_STAGE(PG8_SA(1, 0), cA + kstep, voffA); PG8_STAGE(PG8_SB(1, 1), cB + hstep + kstep, voffB);
        PG8_WAIT_V(6); PG8_BAR;
    }
    for (;;) {
        const bool has_next = S.next(ui + 1, nxt);
        const char* nA = has_next ? (const char*)g.A + (size_t)nxt.pm * tstep : cA; const char* nB = has_next ? (const char*)g.Bt + (size_t)nxt.pn * tstep : cB;
        for (int t = 0; t < nt; t += 2) {
            const bool last = (t == nt - 2);
            const char* a1 = cA + (size_t)(t + 1) * kstep;
            const char* a2 = last ? nA : cA + (size_t)(t + 2) * kstep; const char* b2 = last ? nB : cB + (size_t)(t + 2) * kstep;
            const char* a3 = a2 + kstep; const char* b3 = b2 + kstep;
            if (last && has_next) S.a_ready(nxt);
            if constexpr (SP2) {
            PG8_LDB(B0, 0, 0); PG8_LDB(B1, 0, 1); PG8_SCHED; PG8_LDA(At, 0, 0); PG8_STAGE(PG8_SA(1, 1), a1 + hstep, voffA);
            PG8_WAIT_V(8); PG8_WAIT_L(0); PG8_BAR; PG8_MMA(0, 0, At, B0); PG8_MMA(0, 1, At, B1); PG8_BAR; PG8_SCHED;
            PG8_LDA(At, 0, 1); PG8_STAGE(PG8_SB(0, 0), b2, voffB); PG8_STAGE(PG8_SB(0, 1), b2 + hstep, voffB); PG8_STAGE(PG8_SA(0, 0), a2, voffA);
            PG8_WAIT_V(8); PG8_WAIT_L(0); PG8_BAR; PG8_MMA(1, 0, At, B0); PG8_MMA(1, 1, At, B1); PG8_BAR; PG8_SCHED;
            PG8_LDB(B0, 1, 0); PG8_LDB(B1, 1, 1); PG8_SCHED; PG8_LDA(At, 1, 0); PG8_STAGE(PG8_SA(0, 1), a2 + hstep, voffA);
            PG8_WAIT_V(8); PG8_WAIT_L(0); PG8_BAR; PG8_MMA(0, 0, At, B0); PG8_MMA(0, 1, At, B1); PG8_BAR; PG8_SCHED;
            PG8_LDA(At, 1, 1); PG8_STAGE(PG8_SB(1, 0), b3, voffB); PG8_STAGE(PG8_SB(1, 1), b3 + hstep, voffB); PG8_STAGE(PG8_SA(1, 0), a3, voffA);
            PG8_WAIT_V(8); PG8_WAIT_L(0); PG8_BAR; PG8_MMA(1, 0, At, B0); PG8_MMA(1, 1, At, B1); PG8_BAR; PG8_SCHED;
            } else {
            PG8_LDB(B0, 0, 0); PG8_SCHED; PG8_LDA(At, 0, 0); PG8_STAGE(PG8_SA(1, 1), a1 + hstep, voffA);
            PG8_WAIT_L(8); PG8_BAR; PG8_WAIT_L(0); PG8_MMA(0, 0, At, B0); PG8_BAR; PG8_SCHED;
            PG8_LDB(B1, 0, 1); PG8_STAGE(PG8_SB(0, 0), b2, voffB);
            PG8_BAR; PG8_WAIT_L(0); PG8_MMA(0, 1, At, B1); PG8_BAR;
            PG8_LDA(At, 0, 1); PG8_STAGE(PG8_SA(0, 0), a2, voffA);
            PG8_BAR; PG8_WAIT_L(0); PG8_MMA(1, 0, At, B0); PG8_BAR; PG8_SCHED;
            PG8_STAGE(PG8_SB(0, 1), b2 + hstep, voffB);
            PG8_WAIT_V(6); PG8_BAR; PG8_MMA(1, 1, At, B1); PG8_BAR;
            PG8_LDB(B0, 1, 0); PG8_SCHED; PG8_LDA(At, 1, 0); PG8_STAGE(PG8_SA(0, 1), a2 + hstep, voffA);
            PG8_WAIT_L(8); PG8_BAR; PG8_WAIT_L(0); PG8_MMA(0, 0, At, B0); PG8_BAR; PG8_SCHED;
            PG8_LDB(B1, 1, 1); PG8_STAGE(PG8_SB(1, 0), b3, voffB);
            PG8_BAR; PG8_WAIT_L(0); PG8_MMA(0, 1, At, B1); PG8_BAR;
            PG8_LDA(At, 1, 1); PG8_STAGE(PG8_SA(1, 0), a3, voffA);
            PG8_BAR; PG8_WAIT_L(0); PG8_MMA(1, 0, At, B0); PG8_BAR; PG8_SCHED;
            PG8_STAGE(PG8_SB(1, 1), b3 + hstep, voffB);
            PG8_WAIT_V(6); PG8_BAR; PG8_MMA(1, 1, At, B1); PG8_BAR;
            }
        }
        if constexpr (ALIGN_EPI) { if (wr == 0) PG8_BAR; }
        if constexpr (!Epi::AFTER_DRAIN) { E(acc, cur, wr, wc, fr, fq); S.done(cur); }
        if (!has_next) break;
#pragma unroll
        for (int a = 0; a < 2; ++a)
#pragma unroll
            for (int b = 0; b < 2; ++b)
#pragma unroll
                for (int m = 0; m < 4; ++m)
#pragma unroll
                    for (int n = 0; n < 2; ++n) acc[a][b][m][n] = (f32x4){0.f, 0.f, 0.f, 0.f};
        cur = nxt; cA = nA; cB = nB; ++ui;
        if constexpr (ALIGN_EPI) { if (wr == 1) PG8_BAR; }
    }
    PG8_WAIT_V(0);
    if constexpr (!ALIGN_EPI) { if (wr == 0) PG8_BAR; }
    PG8_BAR;
    if constexpr (Epi::AFTER_DRAIN) { E.fused(acc, cur, wr, wc, fr, fq, lds, wid, lane); S.done(cur); }
#undef PG8_SA
#undef PG8_SB
#undef PG8_STAGE
#undef PG8_LDA
#undef PG8_LDB
#undef PG8_MMA
#undef PG8_WAIT_V
#undef PG8_WAIT_L
#undef PG8_BAR
#undef PG8_SCHED
}
}
#ifndef PG8_SP2
#define PG8_SP2 true
#endif
#ifndef PG8_ALIGN
#define PG8_ALIGN true
#endif

constexpr int NWAVES = 8, NTHREADS = NWAVES * 64;
constexpr int DM = 2048, NBATCH = 4, SEQ = 4096, M = NBATCH * SEQ;
constexpr int NPROJ_IN = 7184;
constexpr int NPJ = 7168;
constexpr int C_GQ = 0, C_GK = 512, C_GV = 1024, C_GG = 2048, C_HQ = 3072, C_HF = 4096, C_HI = 5120, C_HG = 6144;
constexpr int SRC_GLR = 3072;
constexpr float EPS = 1e-6f, QSCALE = 0.08838834764831845f, INV_TAU = 1.0f / 16.0f;
constexpr int CHUNK = 64, NCHUNK = SEQ / CHUNK;

constexpr size_t MiB = 1u << 20;
constexpr size_t WS_CTL = 0, CTL_ZERO_BYTES = 1 * MiB;
constexpr size_t WS_SSQ = 512 * 1024;
constexpr size_t WS_WINT = 2 * MiB;
constexpr size_t WS_WOUTT = 30 * MiB;
constexpr size_t WS_GLR = 39 * MiB;
constexpr size_t WS_HN = 64 * MiB;
constexpr size_t WS_MIX = 128 * MiB;
constexpr size_t WS_PJ = 192 * MiB;
constexpr size_t WS_END = 416 * MiB;

constexpr int LDS_BYTES = 147456;
constexpr int QK_STRIDE = 272, L_QT = 0, L_KT = 64 * QK_STRIDE, L_VR = 2 * 64 * QK_STRIDE, L_AM = L_VR + 64 * 528, L_TOT = L_AM + 64 * 144, L_FAC = L_TOT + 8 * 128 * 4, L_SS = L_FAC + 128 * 4, L_RS = L_SS + 8 * 64 * 4, L_LG = L_RS + 64 * 4, L_SCAN_END = L_LG + 64 * 128 * 4;
static_assert(L_SCAN_END <= LDS_BYTES, "scan LDS map");

#define LAS __attribute__((address_space(3)))
typedef unsigned short bf16;
typedef float f32x4 __attribute__((ext_vector_type(4)));
typedef float f32x2 __attribute__((ext_vector_type(2)));
typedef float f32x16 __attribute__((ext_vector_type(16)));
typedef short bf16x8 __attribute__((ext_vector_type(8)));
typedef short s16x4 __attribute__((ext_vector_type(4)));
typedef unsigned u32x4 __attribute__((ext_vector_type(4)));
typedef unsigned u32x2 __attribute__((ext_vector_type(2)));
typedef __bf16 bf16x2_t __attribute__((ext_vector_type(2)));
#define MFMA32(a, b, c) __builtin_amdgcn_mfma_f32_32x32x16_bf16((a), (b), (c), 0, 0, 0)

__device__ __forceinline__ unsigned pk2(float lo, float hi) { const bf16x2_t v = __builtin_convertvector((f32x2){lo, hi}, bf16x2_t); return __builtin_bit_cast(unsigned, v); }
__device__ __forceinline__ float bf_lo(unsigned u) { return __uint_as_float(u << 16); }
__device__ __forceinline__ float bf_hi(unsigned u) { return __uint_as_float(u & 0xffff0000u); }
__device__ __forceinline__ float bf_1(unsigned short u) { return __uint_as_float(((unsigned)u) << 16); }
__device__ __forceinline__ float wave_sum(float v) {
#pragma unroll
    for (int o = 1; o < 64; o <<= 1) v += __shfl_xor(v, o);
    return v;
}
__device__ __forceinline__ float sigmoidf_(float x) { return 1.0f / (1.0f + __expf(-x)); }

struct Frame {
    LAS unsigned char* lds;
    int tid, lane, wave, G, bid;
    const float *x, *norm_w, *w_in, *gla_w_up, *gla_b_up, *gla_norm_w, *hgrn_lb, *hgrn_norm_w, *w_out, *final_w;
    float* out;
    bf16 *WinT, *WoutT, *HN, *MIX, *PJ;
    float *GLR, *SSQ;
};

__device__ __forceinline__ void p0_transpose_item(const float* W, int ldw, int src_col, bf16* WT, int K, int dst_row, int kb, LAS float* scr, int lane) {
    const int k0 = 64 * kb;
#pragma unroll 8
    for (int i = 0; i < 32; ++i) { const int kk = 2 * i + (lane >> 5); scr[kk * 33 + (lane & 31)] = W[(size_t)(k0 + kk) * ldw + src_col + (lane & 31)]; }
    asm volatile("s_waitcnt lgkmcnt(0)" ::: "memory");
    const int c = lane & 7;
#pragma unroll
    for (int j = 0; j < 4; ++j) { const int n = (lane >> 3) + 8 * j; const LAS float* s = scr + (8 * c) * 33 + n;
        u32x4 o; o.x = pk2(s[0 * 33], s[1 * 33]); o.y = pk2(s[2 * 33], s[3 * 33]); o.z = pk2(s[4 * 33], s[5 * 33]); o.w = pk2(s[6 * 33], s[7 * 33]);
        *(u32x4*)(WT + (size_t)(dst_row + n) * K + k0 + 8 * c) = o; }
    asm volatile("s_waitcnt lgkmcnt(0)" ::: "memory");
}

__device__ __forceinline__ void p0_prologue(Frame& F) {
    const int gw = F.bid * NWAVES + F.wave, NGW = F.G * NWAVES;
    {
        LAS float* scr = (LAS float*)(F.lds + F.wave * 16384);
        constexpr int KB = DM / 64;
        constexpr int I_IN = KB * (NPJ / 32), I_OUT = KB * (DM / 32);
        for (int it = gw; it < I_IN + I_OUT; it += NGW) {
            if (it < I_IN) { const int kb = it / (NPJ / 32), nb = it % (NPJ / 32), n0 = 32 * nb; const int src = n0 < SRC_GLR ? n0 : n0 + 16;
                p0_transpose_item(F.w_in, NPROJ_IN, src, F.WinT, DM, n0, kb, scr, F.lane); }
            else { const int r = it - I_IN, kb = r / (DM / 32), nb = r % (DM / 32);
                p0_transpose_item(F.w_out, DM, 32 * nb, F.WoutT, DM, 32 * nb, kb, scr, F.lane); }
        }
    }
    __syncthreads();
    LAS float* Wt = (LAS float*)F.lds;
    for (int k = F.tid; k < DM; k += NTHREADS) {
        const f32x4* src = (const f32x4*)(F.w_in + (size_t)k * NPROJ_IN + SRC_GLR);
#pragma unroll
        for (int q = 0; q < 4; ++q) { const f32x4 v = src[q]; Wt[(4 * q + 0) * DM + k] = v[0]; Wt[(4 * q + 1) * DM + k] = v[1]; Wt[(4 * q + 2) * DM + k] = v[2]; Wt[(4 * q + 3) * DM + k] = v[3]; }
    }
    __syncthreads();
    f32x4 nw[8];
#pragma unroll
    for (int j = 0; j < 8; ++j) nw[j] = ((const f32x4*)F.norm_w)[64 * j + F.lane];
    const LAS f32x4* Wt4 = (const LAS f32x4*)Wt;
    for (int m = gw; m < M; m += NGW) {
        const f32x4* xr = (const f32x4*)(F.x + (size_t)m * DM) + F.lane;
        f32x4 v[8]; float s = 0.f;
#pragma unroll
        for (int j = 0; j < 8; ++j) { v[j] = xr[64 * j]; s += (v[j][0] * v[j][0] + v[j][1] * v[j][1]) + (v[j][2] * v[j][2] + v[j][3] * v[j][3]); }
        const float rstd = 1.0f / sqrtf(wave_sum(s) * (1.0f / DM) + EPS);
        float a[16];
#pragma unroll
        for (int c = 0; c < 16; ++c) a[c] = 0.f;
        u32x2* o8 = (u32x2*)(F.HN + (size_t)m * DM) + F.lane;
#pragma unroll
        for (int j = 0; j < 8; ++j) {
            v[j] = v[j] * rstd * nw[j];
            u32x2 w; w.x = pk2(v[j][0], v[j][1]); w.y = pk2(v[j][2], v[j][3]); o8[64 * j] = w;
            asm volatile("" ::: "memory");
#pragma unroll
            for (int c = 0; c < 16; ++c) { const f32x4 wv = Wt4[c * (DM / 4) + 64 * j + F.lane]; a[c] += (v[j][0] * wv[0] + v[j][1] * wv[1]) + (v[j][2] * wv[2] + v[j][3] * wv[3]); }
        }
        float mine = 0.f;
#pragma unroll
        for (int c = 0; c < 16; ++c) { const float t = wave_sum(a[c]); mine = (F.lane == c) ? t : mine; }
        if (F.lane < 16) F.GLR[(size_t)m * 16 + F.lane] = mine;
    }
    __syncthreads();
}

__device__ __forceinline__ bf16x8 tr_frag(LAS unsigned char* img, unsigned lanebase, unsigned stride, unsigned c, unsigned ks) {
    const unsigned a0 = lanebase + (16 * ks) * stride + 64 * c;
    const s16x4 lo = __builtin_amdgcn_ds_read_tr16_b64_v4i16((LAS s16x4*)(img + a0));
    const s16x4 hi = __builtin_amdgcn_ds_read_tr16_b64_v4i16((LAS s16x4*)(img + a0 + 4 * stride));
    return __builtin_shufflevector(lo, hi, 0, 1, 2, 3, 4, 5, 6, 7);
}

__device__ __forceinline__ void scan_item(Frame& F, const int gla, const int b, const int h) {
    const int tid = F.tid, lane = F.lane, wave = F.wave;
    LAS unsigned char* lds = F.lds;
    LAS unsigned char* QT = lds + L_QT; LAS unsigned char* KT = lds + L_KT; LAS unsigned char* VR = lds + L_VR; LAS unsigned char* AM = lds + L_AM;
    LAS float* TOT = (LAS float*)(lds + L_TOT); LAS float* FAC = (LAS float*)(lds + L_FAC); LAS float* SS = (LAS float*)(lds + L_SS); LAS float* RS = (LAS float*)(lds + L_RS);
    const int dv = gla ? 256 : 128, nmw = dv / 32;
    const int qcol = gla ? C_GQ + h * 128 : C_HQ + h * 128, kcol = gla ? C_GK + h * 128 : C_HF + h * 128;
    const int vcol = gla ? C_GV + h * 256 : C_HI + h * 128, gcol = gla ? C_GG + h * 256 : C_HG + h * 128;
    const int mcol = gla ? h * 256 : 1024 + h * 128;
    const float* normw = gla ? F.gla_norm_w + h * 256 : F.hgrn_norm_w + h * 128;
    const int dp = tid & 63, d0 = 2 * dp;
    float wub[8], bub = 0.f, lb0 = 0.f, lb1 = 0.f;
    LAS float* LG = (LAS float*)(lds + L_LG);
    if (gla) {
        const int col = h * 128 + 32 * (wave & 3) + (lane & 31);
#pragma unroll
        for (int s = 0; s < 8; ++s) wub[s] = F.gla_w_up[(size_t)(2 * s + (lane >> 5)) * 512 + col];
        bub = F.gla_b_up[col];
    } else {
#pragma unroll
        for (int s = 0; s < 8; ++s) wub[s] = 0.f;
        const f32x2 l0 = *(const f32x2*)(F.hgrn_lb + h * 128 + d0), l1 = *(const f32x2*)(F.hgrn_lb + 1024 + h * 128 + d0);
        lb0 = 1.0f / (1.0f + __expf(l1[0] - l0[0])); lb1 = 1.0f / (1.0f + __expf(l1[1] - l0[1]));
    }
    float elp0 = 1.f, elp1 = 1.f;
    f32x16 S[4];
#pragma unroll
    for (int i = 0; i < 4; ++i)
#pragma unroll
        for (int j = 0; j < 16; ++j) S[i][j] = 0.f;
    const unsigned r = lane & 31, hh = lane >> 5;
    const unsigned vstride = 2 * dv + 16;
    const unsigned tq = (lane & 15) >> 2, tp = lane & 3, tblk = (lane >> 4) & 1;
    const unsigned trk = (8 * hh + tq) * QK_STRIDE + 32 * tblk + 8 * tp, trv = (8 * hh + tq) * vstride + 32 * tblk + 8 * tp;
    const size_t row0 = (size_t)b * SEQ;

    for (int c = 0; c < NCHUNK; ++c) {
        const size_t t0 = row0 + (size_t)c * CHUNK;
        if (gla) {
            const float* gp = F.GLR + (t0 + 32 * (wave >> 2) + (lane & 31)) * 16 + (lane >> 5);
            f32x16 z;
#pragma unroll
            for (int j = 0; j < 16; ++j) z[j] = 0.f;
#pragma unroll
            for (int s = 0; s < 8; ++s) z = __builtin_amdgcn_mfma_f32_32x32x2f32(gp[2 * s], wub[s], z, 0, 0, 0);
#pragma unroll
            for (int reg = 0; reg < 16; ++reg) { const float zz = z[reg] + bub; const int row = 32 * (wave >> 2) + (reg & 3) + 8 * (reg >> 2) + 4 * (lane >> 5);
                LG[row * 128 + 32 * (wave & 3) + (lane & 31)] = (fminf(zz, 0.f) - __logf(1.0f + __expf(-fabsf(zz)))) * INV_TAU; }
            __syncthreads();
        }
        unsigned qp[8]; float k0[8], k1[8], c0[8], c1[8];
        {
            float cum0 = 0.f, cum1 = 0.f;
#pragma unroll
            for (int i = 0; i < 8; ++i) {
                const size_t t = t0 + 8 * wave + i;
                const unsigned kv = *(const unsigned*)(F.PJ + t * NPJ + kcol + d0);
                qp[i] = *(const unsigned*)(F.PJ + t * NPJ + qcol + d0);
                float lg0, lg1;
                if (gla) {
                    const f32x2 lgv = *(const LAS f32x2*)(LG + (8 * wave + i) * 128 + d0); lg0 = lgv[0]; lg1 = lgv[1];
                    k0[i] = bf_lo(kv); k1[i] = bf_hi(kv);
                } else {
                    const float s0 = sigmoidf_(bf_lo(kv)), s1 = sigmoidf_(bf_hi(kv));
                    const float f0 = lb0 + (1.0f - lb0) * s0, f1 = lb1 + (1.0f - lb1) * s1;
                    lg0 = __logf(f0); lg1 = __logf(f1); k0[i] = 1.0f - f0; k1[i] = 1.0f - f1;
                }
                cum0 += lg0; cum1 += lg1; c0[i] = cum0; c1[i] = cum1;
            }
            *(LAS f32x2*)(TOT + wave * 128 + d0) = (f32x2){cum0, cum1};
        }
        __syncthreads();
        {
            float off0 = 0.f, off1 = 0.f, r0 = 0.f, r1 = 0.f, bl0 = 0.f, bl1 = 0.f;
#pragma unroll
            for (int g = 0; g < 8; ++g) { const f32x2 tv = *(const LAS f32x2*)(TOT + g * 128 + d0);
                if (g < wave) { off0 += tv[0]; off1 += tv[1]; } if (g < 4) { r0 += tv[0]; r1 += tv[1]; } bl0 += tv[0]; bl1 += tv[1]; }
#pragma unroll
            for (int i = 0; i < 8; ++i) {
                const float b0 = off0 + c0[i] - r0, b1 = off1 + c1[i] - r1;
                const unsigned row = 8 * wave + i;
                const unsigned o = row * QK_STRIDE + 4 * dp;
                *(LAS unsigned*)(QT + o) = pk2(bf_lo(qp[i]) * QSCALE * __expf(b0), bf_hi(qp[i]) * QSCALE * __expf(b1));
                *(LAS unsigned*)(KT + o) = pk2(k0[i] * __expf(-b0), k1[i] * __expf(-b1));
            }
            if (wave == 0) { *(LAS f32x2*)(FAC + d0) = (f32x2){__expf(r0) * elp0, __expf(r1) * elp1}; elp0 = __expf(bl0 - r0); elp1 = __expf(bl1 - r1); }
        }
        {
            const int cpr = dv / 8;
            for (int idx = tid; idx < 64 * cpr; idx += NTHREADS) { const int row = idx / cpr, ch = idx % cpr;
                const u32x4 v = *(const u32x4*)(F.PJ + (t0 + row) * NPJ + vcol + 8 * ch);
                *(LAS u32x4*)(VR + row * vstride + 16 * ch) = v; }
        }
        __syncthreads();
        if (wave < 3) {
            const int it = wave > 0, jt = wave > 1;
            f32x16 a;
#pragma unroll
            for (int j = 0; j < 16; ++j) a[j] = 0.f;
#pragma unroll
            for (int s = 0; s < 8; ++s) { const bf16x8 qa = *(const LAS bf16x8*)(QT + (32 * it + r) * QK_STRIDE + 32 * s + 16 * hh); const bf16x8 kb = *(const LAS bf16x8*)(KT + (32 * jt + r) * QK_STRIDE + 32 * s + 16 * hh); a = MFMA32(qa, kb, a); }
            const int jj = 32 * jt + r;
#pragma unroll
            for (int reg = 0; reg < 16; ++reg) { const int ii = 32 * it + (reg & 3) + 8 * (reg >> 2) + 4 * hh; const float v = (jj <= ii) ? a[reg] : 0.f;
                *(LAS unsigned short*)(AM + ii * 144 + jj * 2) = (unsigned short)(pk2(v, 0.f) & 0xffffu); }
        }
        __syncthreads();
        f32x16 o[2];
        if (wave < nmw) {
#pragma unroll
            for (int i = 0; i < 2; ++i)
#pragma unroll
                for (int j = 0; j < 16; ++j) o[i][j] = 0.f;
#pragma unroll
            for (int db = 0; db < 4; ++db) {
                asm volatile("" ::: "memory");
#pragma unroll
                for (int g4 = 0; g4 < 4; ++g4) { const f32x4 fv = *(const LAS f32x4*)(FAC + 32 * db + 8 * g4 + 4 * hh);
#pragma unroll
                    for (int e = 0; e < 4; ++e) S[db][4 * g4 + e] *= fv[e]; }
#pragma unroll
                for (int s = 0; s < 2; ++s) {
                    u32x4 pb; pb.x = pk2(S[db][8 * s + 0], S[db][8 * s + 1]); pb.y = pk2(S[db][8 * s + 2], S[db][8 * s + 3]); pb.z = pk2(S[db][8 * s + 4], S[db][8 * s + 5]); pb.w = pk2(S[db][8 * s + 6], S[db][8 * s + 7]);
                    const bf16x8 bs = __builtin_bit_cast(bf16x8, pb);
#pragma unroll
                    for (int it = 0; it < 2; ++it) {
                        const LAS unsigned char* qp = QT + (32 * it + r) * QK_STRIDE + 64 * db + 32 * s + 8 * hh; const s16x4 lo = *(const LAS s16x4*)qp, hi = *(const LAS s16x4*)(qp + 16);
                        o[it] = MFMA32(__builtin_shufflevector(lo, hi, 0, 1, 2, 3, 4, 5, 6, 7), bs, o[it]);
                    }
                }
            }
            bf16x8 vf[4];
#pragma unroll
            for (int ks = 0; ks < 4; ++ks) vf[ks] = tr_frag(VR, trv, vstride, wave, ks);
#pragma unroll
            for (int it = 0; it < 2; ++it)
#pragma unroll
                for (int ks = 0; ks < 4; ++ks) { if (it == 0 && ks >= 2) continue;
                    const bf16x8 af = *(const LAS bf16x8*)(AM + (32 * it + r) * 144 + (16 * ks + 8 * hh) * 2); o[it] = MFMA32(af, vf[ks], o[it]); }
#pragma unroll
            for (int db = 0; db < 4; ++db) {
                asm volatile("" ::: "memory");
#pragma unroll
                for (int ks = 0; ks < 4; ++ks) { const bf16x8 kf = tr_frag(KT, trk, QK_STRIDE, db, ks); S[db] = MFMA32(kf, vf[ks], S[db]); } }
            asm volatile("" ::: "memory");
#pragma unroll
            for (int it = 0; it < 2; ++it)
#pragma unroll
                for (int reg = 0; reg < 16; ++reg) { float sq = o[it][reg] * o[it][reg];
                    sq += __shfl_xor(sq, 1); sq += __shfl_xor(sq, 2); sq += __shfl_xor(sq, 4); sq += __shfl_xor(sq, 8); sq += __shfl_xor(sq, 16);
                    if (r == 0) SS[wave * 64 + 32 * it + (reg & 3) + 8 * (reg >> 2) + 4 * hh] = sq; }
        }
        __syncthreads();
        if (tid < 64) { float tsum = 0.f; for (int w = 0; w < nmw; ++w) tsum += SS[w * 64 + tid]; RS[tid] = 1.0f / sqrtf(tsum / (float)dv + EPS); }
        __syncthreads();
        if (wave < nmw) {
            const int e = 32 * wave + r; const float gn = normw[e];
#pragma unroll
            for (int it = 0; it < 2; ++it)
#pragma unroll
                for (int g4 = 0; g4 < 4; ++g4) { const f32x4 rs = *(const LAS f32x4*)(RS + 32 * it + 8 * g4 + 4 * hh);
#pragma unroll
                    for (int e4 = 0; e4 < 4; ++e4) { const int reg = 4 * g4 + e4; const size_t t = t0 + 32 * it + 8 * g4 + 4 * hh + e4;
                        const float gate = bf_1(F.PJ[t * NPJ + gcol + e]); const float val = o[it][reg] * rs[e4] * gn * (gate * sigmoidf_(gate));
                        F.MIX[t * DM + mcol + e] = (unsigned short)(pk2(val, 0.f) & 0xffffu); } }
        }
    }
    __syncthreads();
}

__device__ __forceinline__ void p2_scan(Frame& F) {
    for (int it = F.bid; it < 48; it += F.G) {
        if (it < 16) scan_item(F, 1, it >> 2, it & 3);
        else { const int j = it - 16; scan_item(F, 0, j >> 3, j & 7); }
    }
}

__device__ __forceinline__ void p4_final(Frame& F) {
    const int gw = F.bid * NWAVES + F.wave, NGW = F.G * NWAVES;
    f32x4 fw[8];
#pragma unroll
    for (int j = 0; j < 8; ++j) fw[j] = ((const f32x4*)F.final_w)[64 * j + F.lane];
    for (int m = gw; m < M; m += NGW) {
        const float rstd = 1.0f / sqrtf(F.SSQ[m] * (1.0f / DM) + EPS);
        f32x4* orow = (f32x4*)(F.out + (size_t)m * DM) + F.lane;
        f32x4 v[8];
#pragma unroll
        for (int j = 0; j < 8; ++j) v[j] = orow[64 * j];
#pragma unroll
        for (int j = 0; j < 8; ++j) orow[64 * j] = v[j] * rstd * fw[j];
    }
}

struct Args { const float* in[10]; float* out; unsigned char* ws; int ph_lo, ph_hi; };
__global__ void __launch_bounds__(NTHREADS, 2) mk_fwd(Args args) {
    extern __shared__ __attribute__((aligned(16))) unsigned char lds_raw[];
    Frame F;
    F.lds = (LAS unsigned char*)lds_raw;
    F.tid = threadIdx.x; F.lane = F.tid & 63; F.wave = __builtin_amdgcn_readfirstlane(F.tid >> 6);
    F.G = gridDim.x; F.bid = blockIdx.x;
    F.x = args.in[0]; F.norm_w = args.in[1]; F.w_in = args.in[2]; F.gla_w_up = args.in[3]; F.gla_b_up = args.in[4]; F.gla_norm_w = args.in[5];
    F.hgrn_lb = args.in[6]; F.hgrn_norm_w = args.in[7]; F.w_out = args.in[8]; F.final_w = args.in[9]; F.out = args.out;
    unsigned char* ws = args.ws;
    F.WinT = (bf16*)(ws + WS_WINT); F.WoutT = (bf16*)(ws + WS_WOUTT); F.HN = (bf16*)(ws + WS_HN); F.MIX = (bf16*)(ws + WS_MIX); F.PJ = (bf16*)(ws + WS_PJ);
    F.GLR = (float*)(ws + WS_GLR); F.SSQ = (float*)(ws + WS_SSQ);
    const int lo = args.ph_lo, hi = args.ph_hi;
#ifndef MK_PHASE_MASK
#define MK_PHASE_MASK 31
#endif
#define IN(k) (((MK_PHASE_MASK >> (k)) & 1) && lo <= (k) && (k) < hi)
#define BOTH(k) (IN(k) && IN((k) + 1))
#if MK_ONE_LAUNCH
#define GRID_BAR() do { cg::this_grid().sync(); } while (0)
#else
#define GRID_BAR() do { } while (0)
#endif
    if (IN(0)) { p0_prologue(F); if (BOTH(0)) GRID_BAR(); }
    if (IN(1)) {
        pg8::Gemm g{F.HN, F.WinT, M, NPJ, DM}; pg8::StaticOrder S; S.init(M, NPJ, F.G, F.bid);
        pg8::EpiBf16<0> E{F.PJ, NPJ, nullptr, 0, 0, 1.f};
        pg8::gemm_phase<pg8::EpiBf16<0>, pg8::StaticOrder, PG8_ALIGN, PG8_SP2>(F.lds, g, S, E);
        if (BOTH(1)) GRID_BAR();
    }
    if (IN(2)) { p2_scan(F); if (BOTH(2)) GRID_BAR(); }
    if (IN(3)) {
        pg8::Gemm g{F.MIX, F.WoutT, M, DM, DM}; pg8::StaticOrder S; S.init(M, DM, F.G, F.bid);
        pg8::EpiResid E{F.x, F.out, DM, F.SSQ};
        pg8::gemm_phase<pg8::EpiResid, pg8::StaticOrder, PG8_ALIGN, PG8_SP2>(F.lds, g, S, E);
        if (BOTH(3)) GRID_BAR();
    }
    if (IN(4)) { p4_final(F); }
#undef IN
#undef BOTH
}

extern "C" void kernel_launch(void* const* d_in, const int* in_sizes, int n_in, void* d_out, int out_size, void* d_ws, size_t ws_size, hipStream_t stream) {
    static int grid = 0;
    if (grid == 0) {
        if (n_in != 10 || in_sizes[0] != M * DM || out_size != M * DM || ws_size < WS_END) { fprintf(stderr, "kernel_launch: unexpected shapes (n_in %d, in0 %d, out %d, ws %zu)\n", n_in, n_in > 0 ? in_sizes[0] : -1, out_size, ws_size); grid = -1; return; }
        int dev = 0, cus = 0, per_cu = 0;
        if (hipGetDevice(&dev) != hipSuccess || hipDeviceGetAttribute(&cus, hipDeviceAttributeMultiprocessorCount, dev) != hipSuccess) { grid = -1; return; }
        if (hipFuncSetAttribute((const void*)mk_fwd, hipFuncAttributeMaxDynamicSharedMemorySize, LDS_BYTES) != hipSuccess) { fprintf(stderr, "kernel_launch: hipFuncSetAttribute failed\n"); grid = -1; return; }
        if (hipOccupancyMaxActiveBlocksPerMultiprocessor(&per_cu, (const void*)mk_fwd, NTHREADS, LDS_BYTES) != hipSuccess || per_cu < 1) { fprintf(stderr, "kernel_launch: occupancy query says %d blocks per CU\n", per_cu); grid = -1; return; }
        (void)hipGetLastError();
        grid = cus;
    }
    if (grid < 0) return;
    (void)hipMemsetAsync((char*)d_ws + WS_CTL, 0, CTL_ZERO_BYTES, stream);
    Args a{};
    for (int i = 0; i < 10; ++i) a.in[i] = (const float*)d_in[i];
    a.out = (float*)d_out; a.ws = (unsigned char*)d_ws;
#if MK_ONE_LAUNCH
    a.ph_lo = 0; a.ph_hi = 5;
    void* kargs[] = {&a};
    hipError_t e = hipLaunchCooperativeKernel((const void*)mk_fwd, dim3(grid), dim3(NTHREADS), kargs, LDS_BYTES, stream);
    if (e != hipSuccess) fprintf(stderr, "kernel_launch: cooperative launch failed: %s (grid %d)\n", hipGetErrorString(e), grid);
#else
    for (int p = 0; p < 5; ++p) { a.ph_lo = p; a.ph_hi = p + 1; hipLaunchKernelGGL(mk_fwd, dim3(grid), dim3(NTHREADS), LDS_BYTES, stream, a); }
#endif
}
```

```cpp
#include <hip/hip_runtime.h>
#include <hip/hip_cooperative_groups.h>
#include <cstdio>
#include <cstdint>
namespace cg = cooperative_groups;
#ifndef MK_ONE_LAUNCH
#define MK_ONE_LAUNCH 1
#endif
namespace pg8 {
#define PG8_LAS __attribute__((address_space(3)))
typedef unsigned short bf16_t;
typedef short bf16x8 __attribute__((ext_vector_type(8)));
typedef float f32x4 __attribute__((ext_vector_type(4)));
typedef unsigned u32x4 __attribute__((ext_vector_type(4)));
constexpr int BM = 256, BK = 64, HALF = 128, HTB = HALF * BK * 2  , STAGE_BYTES = 8 * HTB, NXCD = 8, WGM = 8;

__host__ __device__ __forceinline__ int lds_byte(int r, int c) { const int st = (r >> 4) * 2 + (c >> 5), rr = r & 15, cc = c & 31, ob = rr * 64 + cc * 2; return st * 1024 + (ob ^ (((ob >> 9) & 1) << 5)); }
__host__ __device__ __forceinline__ void stage_rc(int b, int& R, int& C) { const int st = b / 1024, sb = b % 1024, swz = sb ^ (((sb >> 9) & 1) << 5); R = (st >> 1) * 16 + swz / 64; C = (st & 1) * 32 + (swz % 64) / 2; }
__host__ __device__ __forceinline__ int perm32(int rho) { const int n = rho >> 4, i = rho & 15; return 8 * (i >> 2) + 4 * n + (i & 3); }

struct Unit { int pm, pn; };
struct Gemm { const bf16_t* A; const bf16_t* Bt; int M, N, K; };

struct StaticOrder {
    int nM, nN, nwg, G, c;
    __host__ __device__ void init(int M, int N, int G_, int c_) { nM = M / BM; nN = N / BM; nwg = nM * nN; G = G_; c = c_; }
    __host__ __device__ bool next(int i, Unit& u) const {
        const long L = (long)i * G + c; if (L >= nwg) return false;
        int wgid = (int)L; { const int q = nwg / NXCD, r = nwg % NXCD, xcd = wgid % NXCD, off = wgid / NXCD; wgid = (xcd < r ? xcd * (q + 1) : r * (q + 1) + (xcd - r) * q) + off; }
        const int nig = WGM * nN, gid = wgid / nig, fm = gid * WGM, gsz = (nM - fm) < WGM ? (nM - fm) : WGM;
        u.pm = fm + ((wgid % nig) % gsz); u.pn = (wgid % nig) / gsz; return true;
    }
    __device__ __forceinline__ void a_ready(const Unit&) const {}
    __device__ __forceinline__ void done(const Unit&) const {}
};

__device__ __forceinline__ unsigned cvt_pk_bf16(float lo, float hi) { unsigned r; asm volatile("v_cvt_pk_bf16_f32 %0, %1, %2" : "=v"(r) : "v"(lo), "v"(hi)); return r; }
typedef float f32x2 __attribute__((ext_vector_type(2)));
__device__ __forceinline__ f32x2 gelu_pk(f32x2 v) {
    const f32x2 av = __builtin_elementwise_abs(v), d = av * 0.2316418882f + 1.0f;
    f32x2 t; t.x = __builtin_amdgcn_rcpf(d.x); t.y = __builtin_amdgcn_rcpf(d.y);
    f32x2 q = t * 0.5307027145f + (-0.7265760135f); q = q * t + 0.7107068705f; q = q * t + (-0.142248368f); q = q * t + 0.127414796f; q = q * t;
    const f32x2 s = (v * v) * (-0.72134752044f);
    f32x2 e; e.x = __builtin_amdgcn_exp2f(s.x); e.y = __builtin_amdgcn_exp2f(s.y);
    const f32x2 m = v * (q * e), r = v - m;
    f32x2 o; o.x = v.x < 0.f ? m.x : r.x; o.y = v.y < 0.f ? m.y : r.y; return o;
}

template <int ACT  > struct EpiBf16 {
    static constexpr bool PERM = true, AFTER_DRAIN = false; static_assert(ACT == 0 || ACT == 1, "EpiBf16: ACT is 0 (none) or 1 (gelu_pk)");
    bf16_t* O; int ldc; const float* bias; int split_cols; size_t split_stride; float scale0;
    __device__ __forceinline__ void operator()(const f32x4 (&acc)[2][2][4][2], const Unit& u, int wr, int wc, int fr, int fq) const {
        const int row0 = u.pm * BM + wr * 64 + fr; int colt = u.pn * BM; bf16_t* base = O;
        float sc = 1.f; if (split_cols) { const int t = colt / split_cols; base += (size_t)t * split_stride; colt -= t * split_cols; if (t == 0) sc = scale0; }
        const int col0 = colt + wc * 32 + 8 * fq, bcol0 = u.pn * BM + wc * 32 + 8 * fq;
        f32x4 bv[2][2];
#pragma unroll
        for (int bj = 0; bj < 2; ++bj)
#pragma unroll
            for (int n = 0; n < 2; ++n) bv[bj][n] = bias ? *(const f32x4*)(bias + bcol0 + bj * HALF + 4 * n) : (f32x4){0.f, 0.f, 0.f, 0.f};
#pragma unroll
        for (int ai = 0; ai < 2; ++ai)
#pragma unroll
            for (int m = 0; m < 4; ++m) { bf16_t* rowp = base + (size_t)(row0 + ai * HALF + m * 16) * ldc + col0;
#pragma unroll
                for (int bj = 0; bj < 2; ++bj) { f32x4 v0 = acc[ai][bj][m][0] + bv[bj][0], v1 = acc[ai][bj][m][1] + bv[bj][1];
                    if (ACT == 1) { f32x2 a = gelu_pk((f32x2){v0[0], v0[1]}), b = gelu_pk((f32x2){v0[2], v0[3]}), c = gelu_pk((f32x2){v1[0], v1[1]}), d = gelu_pk((f32x2){v1[2], v1[3]});
                        v0 = (f32x4){a.x, a.y, b.x, b.y}; v1 = (f32x4){c.x, c.y, d.x, d.y}; }
                    v0 = v0 * sc; v1 = v1 * sc; u32x4 w; w.x = cvt_pk_bf16(v0[0], v0[1]); w.y = cvt_pk_bf16(v0[2], v0[3]); w.z = cvt_pk_bf16(v1[0], v1[1]); w.w = cvt_pk_bf16(v1[2], v1[3]);
                    *(u32x4*)(rowp + bj * HALF) = w; } }
    }
};
struct EpiResid {
    static constexpr bool PERM = false, AFTER_DRAIN = false;
    const float* base; float* out; int ldc; float* ssq;
    __device__ __forceinline__ void operator()(const f32x4 (&acc)[2][2][4][2], const Unit& u, int wr, int wc, int fr, int fq) const {
        const int row0 = u.pm * BM + wr * 64 + fr, col0 = u.pn * BM + wc * 32 + 4 * fq;
#pragma unroll
        for (int ai = 0; ai < 2; ++ai)
#pragma unroll
            for (int m = 0; m < 4; ++m) { const int row = row0 + ai * HALF + m * 16; const size_t off = (size_t)row * ldc + col0; float s = 0.f;
#pragma unroll
                for (int bj = 0; bj < 2; ++bj)
#pragma unroll
                    for (int n = 0; n < 2; ++n) { const f32x4 v = *(const f32x4*)(base + off + bj * HALF + n * 16) + acc[ai][bj][m][n];
                        *(f32x4*)(out + off + bj * HALF + n * 16) = v; s += (v[0] * v[0] + v[1] * v[1]) + (v[2] * v[2] + v[3] * v[3]); }
                s += __shfl_xor(s, 16); s += __shfl_xor(s, 32);
                if (fq == 0) atomicAdd(ssq + row, s);
                asm volatile("" ::: "memory"); }
    }
};
template <class Epi, class Sched, bool ALIGN_EPI = false, bool SP2 = false>
__device__ __forceinline__ void gemm_phase(PG8_LAS unsigned char* lds, const Gemm g, const Sched& S, const Epi& E) {
    const int tid = threadIdx.x, wid = __builtin_amdgcn_readfirstlane(tid >> 6), lane = tid & 63, wr = wid >> 2, wc = wid & 3, fr = lane & 15, fq = lane >> 4;
    const int K = g.K, nt = K / BK;
    unsigned voffA[2], voffB[2];
#pragma unroll
    for (int i = 0; i < 2; ++i) { int R, C; stage_rc(tid * 16 + i * 8192, R, C); const int Rb = Epi::PERM ? ((R & ~31) + perm32(R & 31)) : R;
        voffA[i] = (unsigned)(R * K + C) * 2u; voffB[i] = (unsigned)(Rb * K + C) * 2u; }
    const size_t kstep = (size_t)(BK * 2);
    const size_t hstep = (size_t)HALF * K * 2;
    const size_t tstep = 2 * hstep;
    const unsigned ldsw = (unsigned)wid * 1024u;
    const int aoff = lds_byte(wr * 64 + fr, fq * 8), boff = lds_byte(wc * 32 + fr, fq * 8);
#define PG8_SA(b, h) (((b) * 2 + (h)) * HTB)
#define PG8_SB(b, h) ((4 + (b) * 2 + (h)) * HTB)
#define PG8_STAGE(bufoff, gbase, voff) do { _Pragma("unroll") for (int _i = 0; _i < 2; ++_i) \
        __builtin_amdgcn_global_load_lds((const unsigned*)((const char*)(gbase) + (voff)[_i]), (PG8_LAS unsigned*)(lds + (bufoff) + ldsw + _i * 8192), 16, 0, 0); } while (0)
#define PG8_LDA(dst, b, h) do { _Pragma("unroll") for (int m = 0; m < 4; ++m) _Pragma("unroll") for (int k = 0; k < 2; ++k) dst[m][k] = *(const PG8_LAS bf16x8*)(lds + PG8_SA(b, h) + aoff + m * 2048 + k * 1024); } while (0)
#define PG8_LDB(dst, b, h) do { _Pragma("unroll") for (int n = 0; n < 2; ++n) _Pragma("unroll") for (int k = 0; k < 2; ++k) dst[n][k] = *(const PG8_LAS bf16x8*)(lds + PG8_SB(b, h) + boff + n * 2048 + k * 1024); } while (0)
#define PG8_MMA(ai, bj, At, Bt) do { __builtin_amdgcn_s_setprio(1); _Pragma("unroll") for (int m = 0; m < 4; ++m) _Pragma("unroll") for (int n = 0; n < 2; ++n) _Pragma("unroll") for (int k = 0; k < 2; ++k) \
        acc[ai][bj][m][n] = __builtin_amdgcn_mfma_f32_16x16x32_bf16(Bt[n][k], At[m][k], acc[ai][bj][m][n], 0, 0, 0); __builtin_amdgcn_s_setprio(0); } while (0)
#define PG8_WAIT_V(n) asm volatile("s_waitcnt vmcnt(" #n ")" ::: "memory")
#define PG8_WAIT_L(n) asm volatile("s_waitcnt lgkmcnt(" #n ")" ::: "memory")
#define PG8_BAR __builtin_amdgcn_s_barrier()
#define PG8_SCHED __builtin_amdgcn_sched_barrier(0)
    Unit cur, nxt; int ui = 0;
    if (!S.next(0, cur)) return;
    f32x4 acc[2][2][4][2];
#pragma unroll
    for (int a = 0; a < 2; ++a)
#pragma unroll
        for (int b = 0; b < 2; ++b)
#pragma unroll
            for (int m = 0; m < 4; ++m)
#pragma unroll
                for (int n = 0; n < 2; ++n) acc[a][b][m][n] = (f32x4){0.f, 0.f, 0.f, 0.f};
    bf16x8 At[4][2], B0[2][2], B1[2][2];
    const char* cA = (const char*)g.A + (size_t)cur.pm * tstep; const char* cB = (const char*)g.Bt + (size_t)cur.pn * tstep;
    S.a_ready(cur);
    if constexpr (SP2) {
        PG8_STAGE(PG8_SB(0, 0), cB, voffB); PG8_STAGE(PG8_SB(0, 1), cB + hstep, voffB); PG8_STAGE(PG8_SA(0, 0), cA, voffA); PG8_STAGE(PG8_SA(0, 1), cA + hstep, voffA);
        if (wr == 1) PG8_BAR;
        PG8_WAIT_V(2); PG8_BAR;
        PG8_STAGE(PG8_SB(1, 0), cB + kstep, voffB); PG8_STAGE(PG8_SA(1, 0), cA + kstep, voffA); PG8_STAGE(PG8_SB(1, 1), cB + hstep + kstep, voffB);
        PG8_WAIT_V(6); PG8_BAR;
    } else {
        PG8_STAGE(PG8_SB(0, 0), cB, voffB); PG8_STAGE(PG8_SA(0, 0), cA, voffA); PG8_STAGE(PG8_SB(0, 1), cB + hstep, voffB); PG8_STAGE(PG8_SA(0, 1), cA + hstep, voffA);
        if (wr == 1) PG8_BAR;
        PG8_WAIT_V(4); PG8_BAR;
        PG8_STAGE(PG8_SB(1, 0), cB + kstep, voffB); PG8_STAGE(PG8_SA(1, 0), cA + kstep, voffA); PG8_STAGE(PG8_SB(1, 1), cB + hstep + kstep, voffB);
        PG8_WAIT_V(6); PG8_BAR;
    }
    for (;;) {
        const bool has_next = S.next(ui + 1, nxt);
        const char* nA = has_next ? (const char*)g.A + (size_t)nxt.pm * tstep : cA; const char* nB = has_next ? (const char*)g.Bt + (size_t)nxt.pn * tstep : cB;
        for (int t = 0; t < nt; t += 2) {
            const bool last = (t == nt - 2);
            const char* a1 = cA + (size_t)(t + 1) * kstep;
            const char* a2 = last ? nA : cA + (size_t)(t + 2) * kstep; const char* b2 = last ? nB : cB + (size_t)(t + 2) * kstep;
            const char* a3 = a2 + kstep; const char* b3 = b2 + kstep;
            if (last && has_next) S.a_ready(nxt);
            if constexpr (SP2) {
            PG8_LDB(B0, 0, 0); PG8_LDB(B1, 0, 1); PG8_SCHED; PG8_LDA(At, 0, 0); PG8_STAGE(PG8_SA(1, 1), a1 + hstep, voffA);
            PG8_WAIT_V(8); PG8_WAIT_L(0); PG8_BAR; PG8_MMA(0, 0, At, B0); PG8_MMA(0, 1, At, B1); PG8_BAR; PG8_SCHED;
            PG8_LDA(At, 0, 1); PG8_STAGE(PG8_SB(0, 0), b2, voffB); PG8_STAGE(PG8_SB(0, 1), b2 + hstep, voffB); PG8_STAGE(PG8_SA(0, 0), a2, voffA);
            PG8_WAIT_V(8); PG8_WAIT_L(0); PG8_BAR; PG8_MMA(1, 0, At, B0); PG8_MMA(1, 1, At, B1); PG8_BAR; PG8_SCHED;
            PG8_LDB(B0, 1, 0); PG8_LDB(B1, 1, 1); PG8_SCHED; PG8_LDA(At, 1, 0); PG8_STAGE(PG8_SA(0, 1), a2 + hstep, voffA);
            PG8_WAIT_V(8); PG8_WAIT_L(0); PG8_BAR; PG8_MMA(0, 0, At, B0); PG8_MMA(0, 1, At, B1); PG8_BAR; PG8_SCHED;
            PG8_LDA(At, 1, 1); PG8_STAGE(PG8_SB(1, 0), b3, voffB); PG8_STAGE(PG8_SB(1, 1), b3 + hstep, voffB); PG8_STAGE(PG8_SA(1, 0), a3, voffA);
            PG8_WAIT_V(8); PG8_WAIT_L(0); PG8_BAR; PG8_MMA(1, 0, At, B0); PG8_MMA(1, 1, At, B1); PG8_BAR; PG8_SCHED;
            } else {
            PG8_LDB(B0, 0, 0); PG8_SCHED; PG8_LDA(At, 0, 0); PG8_STAGE(PG8_SA(1, 1), a1 + hstep, voffA);
            PG8_WAIT_L(8); PG8_BAR; PG8_WAIT_L(0); PG8_MMA(0, 0, At, B0); PG8_BAR; PG8_SCHED;
            PG8_LDB(B1, 0, 1); PG8_STAGE(PG8_SB(0, 0), b2, voffB);
            PG8_BAR; PG8_WAIT_L(0); PG8_MMA(0, 1, At, B1); PG8_BAR;
            PG8_LDA(At, 0, 1); PG8_STAGE(PG8_SA(0, 0), a2, voffA);
            PG8_BAR; PG8_WAIT_L(0); PG8_MMA(1, 0, At, B0); PG8_BAR; PG8_SCHED;
            PG8_STAGE(PG8_SB(0, 1), b2 + hstep, voffB);
            PG8_WAIT_V(6); PG8_BAR; PG8_MMA(1, 1, At, B1); PG8_BAR;
            PG8_LDB(B0, 1, 0); PG8_SCHED; PG8_LDA(At, 1, 0); PG8_STAGE(PG8_SA(0, 1), a2 + hstep, voffA);
            PG8_WAIT_L(8); PG8_BAR; PG8_WAIT_L(0); PG8_MMA(0, 0, At, B0); PG8_BAR; PG8_SCHED;
            PG8_LDB(B1, 1, 1); PG8_STAGE(PG8_SB(1, 0), b3, voffB);
            PG8_BAR; PG8_WAIT_L(0); PG8_MMA(0, 1, At, B1); PG8_BAR;
            PG8_LDA(At, 1, 1); PG8_STAGE(PG8_SA(1, 0), a3, voffA);
            PG8_BAR; PG8_WAIT_L(0); PG8_MMA(1, 0, At, B0); PG8_BAR; PG8_SCHED;
            PG8_STAGE(PG8_SB(1, 1), b3 + hstep, voffB);
            PG8_WAIT_V(6); PG8_BAR; PG8_MMA(1, 1, At, B1); PG8_BAR;
            }
        }
        if constexpr (ALIGN_EPI) { if (wr == 0) PG8_BAR; }
        if constexpr (!Epi::AFTER_DRAIN) { E(acc, cur, wr, wc, fr, fq); S.done(cur); }
        if (!has_next) break;
#pragma unroll
        for (int a = 0; a < 2; ++a)
#pragma unroll
            for (int b = 0; b < 2; ++b)
#pragma unroll
                for (int m = 0; m < 4; ++m)
#pragma unroll
                    for (int n = 0; n < 2; ++n) acc[a][b][m][n] = (f32x4){0.f, 0.f, 0.f, 0.f};
        cur = nxt; cA = nA; cB = nB; ++ui;
        if constexpr (ALIGN_EPI) { if (wr == 1) PG8_BAR; }
    }
    PG8_WAIT_V(0);
    if constexpr (!ALIGN_EPI) { if (wr == 0) PG8_BAR; }
    PG8_BAR;
    if constexpr (Epi::AFTER_DRAIN) { E.fused(acc, cur, wr, wc, fr, fq, lds, wid, lane); S.done(cur); }
#undef PG8_SA
#undef PG8_SB
#undef PG8_STAGE
#undef PG8_LDA
#undef PG8_LDB
#undef PG8_MMA
#undef PG8_WAIT_V
#undef PG8_WAIT_L
#undef PG8_BAR
#undef PG8_SCHED
}
}
#ifndef PG8_SP2
#define PG8_SP2 true
#endif
#ifndef PG8_ALIGN
#define PG8_ALIGN true
#endif

constexpr int NWAVES = 8, NTHREADS = NWAVES * 64;
constexpr int DM = 2048, NBATCH = 4, SEQ = 4096, M = NBATCH * SEQ;
constexpr int NPROJ_IN = 7184;
constexpr int NPJ = 7168;
constexpr int C_GQ = 0, C_GK = 512, C_GV = 1024, C_GG = 2048, C_HQ = 3072, C_HF = 4096, C_HI = 5120, C_HG = 6144;
constexpr int SRC_GLR = 3072;
constexpr float EPS = 1e-6f, QSCALE = 0.08838834764831845f, INV_TAU = 1.0f / 16.0f;
constexpr int CHUNK = 64, NCHUNK = SEQ / CHUNK;

constexpr size_t MiB = 1u << 20;
constexpr size_t WS_CTL = 0, CTL_ZERO_BYTES = 1 * MiB;
constexpr size_t WS_SSQ = 512 * 1024;
constexpr size_t WS_WINT = 2 * MiB;
constexpr size_t WS_WOUTT = 30 * MiB;
constexpr size_t WS_GLR = 39 * MiB;
constexpr size_t WS_HN = 64 * MiB;
constexpr size_t WS_MIX = 128 * MiB;
constexpr size_t WS_PJ = 192 * MiB;
constexpr size_t WS_END = 416 * MiB;

constexpr int LDS_BYTES = 155648;
constexpr int QK_STRIDE = 272, L_QT = 0, L_KT = 64 * QK_STRIDE, L_VR = 2 * 64 * QK_STRIDE, L_AM = L_VR + 64 * 528, L_TOT = L_AM + 64 * 144, L_FAC = L_TOT + 8 * 128 * 4, L_SS = L_FAC + 128 * 4, L_RS = L_SS + 8 * 64 * 4, L_LG = L_RS + 64 * 4, L_KS = L_LG + 64 * 128 * 4, L_SCAN_END = L_KS + 64 * 128 * 4;
static_assert(L_SCAN_END <= LDS_BYTES, "scan LDS map");

#define LAS __attribute__((address_space(3)))
typedef unsigned short bf16;
typedef float f32x4 __attribute__((ext_vector_type(4)));
typedef float f32x2 __attribute__((ext_vector_type(2)));
typedef float f32x16 __attribute__((ext_vector_type(16)));
typedef short bf16x8 __attribute__((ext_vector_type(8)));
typedef short s16x4 __attribute__((ext_vector_type(4)));
typedef unsigned u32x4 __attribute__((ext_vector_type(4)));
typedef unsigned u32x2 __attribute__((ext_vector_type(2)));
typedef __bf16 bf16x2_t __attribute__((ext_vector_type(2)));
#define MFMA32(a, b, c) __builtin_amdgcn_mfma_f32_32x32x16_bf16((a), (b), (c), 0, 0, 0)

__device__ __forceinline__ unsigned pk2(float lo, float hi) { const bf16x2_t v = __builtin_convertvector((f32x2){lo, hi}, bf16x2_t); return __builtin_bit_cast(unsigned, v); }
__device__ __forceinline__ float bf_lo(unsigned u) { return __uint_as_float(u << 16); }
__device__ __forceinline__ float bf_hi(unsigned u) { return __uint_as_float(u & 0xffff0000u); }
__device__ __forceinline__ float bf_1(unsigned short u) { return __uint_as_float(((unsigned)u) << 16); }
__device__ __forceinline__ float wave_sum(float v) {
#pragma unroll
    for (int o = 1; o < 64; o <<= 1) v += __shfl_xor(v, o);
    return v;
}
__device__ __forceinline__ float sigmoidf_(float x) { return 1.0f / (1.0f + __expf(-x)); }

struct Frame {
    LAS unsigned char* lds;
    int tid, lane, wave, G, bid;
    const float *x, *norm_w, *w_in, *gla_w_up, *gla_b_up, *gla_norm_w, *hgrn_lb, *hgrn_norm_w, *w_out, *final_w;
    float* out;
    bf16 *WinT, *WoutT, *HN, *MIX, *PJ;
    float *GLR, *SSQ;
    unsigned char* ws;
};

__device__ __forceinline__ void p0_transpose_item(const float* W, int ldw, int src_col, bf16* WT, int K, int dst_row, int kb, LAS float* scr, int lane) {
    const int k0 = 64 * kb;
#pragma unroll 8
    for (int i = 0; i < 32; ++i) { const int kk = 2 * i + (lane >> 5); scr[kk * 33 + (lane & 31)] = W[(size_t)(k0 + kk) * ldw + src_col + (lane & 31)]; }
    asm volatile("s_waitcnt lgkmcnt(0)" ::: "memory");
    const int c = lane & 7;
#pragma unroll
    for (int j = 0; j < 4; ++j) { const int n = (lane >> 3) + 8 * j; const LAS float* s = scr + (8 * c) * 33 + n;
        u32x4 o; o.x = pk2(s[0 * 33], s[1 * 33]); o.y = pk2(s[2 * 33], s[3 * 33]); o.z = pk2(s[4 * 33], s[5 * 33]); o.w = pk2(s[6 * 33], s[7 * 33]);
        *(u32x4*)(WT + (size_t)(dst_row + n) * K + k0 + 8 * c) = o; }
    asm volatile("s_waitcnt lgkmcnt(0)" ::: "memory");
}

__device__ __forceinline__ void p0_prologue(Frame& F) {
    const int gw = F.bid * NWAVES + F.wave, NGW = F.G * NWAVES;
    {
        LAS float* scr = (LAS float*)(F.lds + F.wave * 16384);
        constexpr int KB = DM / 64;
        constexpr int I_IN = KB * (NPJ / 32), I_OUT = KB * (DM / 32);
        for (int it = gw; it < I_IN + I_OUT; it += NGW) {
            if (it < I_IN) { const int kb = it / (NPJ / 32), nb = it % (NPJ / 32), n0 = 32 * nb; const int src = n0 < SRC_GLR ? n0 : n0 + 16;
                p0_transpose_item(F.w_in, NPROJ_IN, src, F.WinT, DM, n0, kb, scr, F.lane); }
            else { const int r = it - I_IN, kb = r / (DM / 32), nb = r % (DM / 32);
                p0_transpose_item(F.w_out, DM, 32 * nb, F.WoutT, DM, 32 * nb, kb, scr, F.lane); }
        }
    }
    __syncthreads();
    LAS float* Wt = (LAS float*)F.lds;
    for (int k = F.tid; k < DM; k += NTHREADS) {
        const f32x4* src = (const f32x4*)(F.w_in + (size_t)k * NPROJ_IN + SRC_GLR);
#pragma unroll
        for (int q = 0; q < 4; ++q) { const f32x4 v = src[q]; Wt[(4 * q + 0) * DM + k] = v[0]; Wt[(4 * q + 1) * DM + k] = v[1]; Wt[(4 * q + 2) * DM + k] = v[2]; Wt[(4 * q + 3) * DM + k] = v[3]; }
    }
    __syncthreads();
    f32x4 nw[8];
#pragma unroll
    for (int j = 0; j < 8; ++j) nw[j] = ((const f32x4*)F.norm_w)[64 * j + F.lane];
    const LAS f32x4* Wt4 = (const LAS f32x4*)Wt;
    for (int m = gw; m < M; m += NGW) {
        const f32x4* xr = (const f32x4*)(F.x + (size_t)m * DM) + F.lane;
        f32x4 v[8]; float s = 0.f;
#pragma unroll
        for (int j = 0; j < 8; ++j) { v[j] = xr[64 * j]; s += (v[j][0] * v[j][0] + v[j][1] * v[j][1]) + (v[j][2] * v[j][2] + v[j][3] * v[j][3]); }
        const float rstd = 1.0f / sqrtf(wave_sum(s) * (1.0f / DM) + EPS);
        float a[16];
#pragma unroll
        for (int c = 0; c < 16; ++c) a[c] = 0.f;
        u32x2* o8 = (u32x2*)(F.HN + (size_t)m * DM) + F.lane;
#pragma unroll
        for (int j = 0; j < 8; ++j) {
            v[j] = v[j] * rstd * nw[j];
            u32x2 w; w.x = pk2(v[j][0], v[j][1]); w.y = pk2(v[j][2], v[j][3]); o8[64 * j] = w;
            asm volatile("" ::: "memory");
#pragma unroll
            for (int c = 0; c < 16; ++c) { const f32x4 wv = Wt4[c * (DM / 4) + 64 * j + F.lane]; a[c] += (v[j][0] * wv[0] + v[j][1] * wv[1]) + (v[j][2] * wv[2] + v[j][3] * wv[3]); }
        }
        float mine = 0.f;
#pragma unroll
        for (int c = 0; c < 16; ++c) { const float t = wave_sum(a[c]); mine = (F.lane == c) ? t : mine; }
        if (F.lane < 16) F.GLR[(size_t)m * 16 + F.lane] = mine;
    }
    __syncthreads();
}

constexpr int NSEG_G = 8, NSEG_H = 4;
constexpr size_t WS_LG = WS_HN, WS_LH = WS_HN + 16 * MiB, WS_DG = WS_HN + 48 * MiB, WS_DH = WS_HN + 49 * MiB;
static_assert(16 * NSEG_G * 131072 <= 16 * MiB && 32 * NSEG_H * 65536 <= 32 * MiB, "L buffers");

__device__ __forceinline__ bf16x8 tr_frag(LAS unsigned char* img, unsigned lanebase, unsigned stride, unsigned c, unsigned ks) {
    const unsigned a0 = lanebase + (16 * ks) * stride + 64 * c;
    const s16x4 lo = __builtin_amdgcn_ds_read_tr16_b64_v4i16((LAS s16x4*)(img + a0));
    const s16x4 hi = __builtin_amdgcn_ds_read_tr16_b64_v4i16((LAS s16x4*)(img + a0 + 4 * stride));
    return __builtin_shufflevector(lo, hi, 0, 1, 2, 3, 4, 5, 6, 7);
}

template <int GLA, int PASSB>
__device__ __forceinline__ void scan_item(Frame& F, const int b, const int h, const int seg) {
    constexpr int dv = GLA ? 256 : 128, nmw = dv / 32, NSEG = GLA ? NSEG_G : NSEG_H, NC = NCHUNK / NSEG;
    constexpr unsigned vstride = 2 * dv + 16;
    constexpr int NVL = 64 * (dv / 8) / NTHREADS;
    const int tid = F.tid, lane = F.lane, wave = F.wave;
    LAS unsigned char* lds = F.lds;
    LAS unsigned char* QT = lds + L_QT; LAS unsigned char* KT = lds + L_KT; LAS unsigned char* VR = lds + L_VR; LAS unsigned char* AM = lds + L_AM;
    LAS float* TOT = (LAS float*)(lds + L_TOT); LAS float* FAC = (LAS float*)(lds + L_FAC); LAS float* SS = (LAS float*)(lds + L_SS); LAS float* RS = (LAS float*)(lds + L_RS);
    LAS float* LG = (LAS float*)(lds + L_LG); LAS float* KS = (LAS float*)(lds + L_KS);
    const int qcol = GLA ? C_GQ + h * 128 : C_HQ + h * 128, kcol = GLA ? C_GK + h * 128 : C_HF + h * 128;
    const int vcol = GLA ? C_GV + h * 256 : C_HI + h * 128, gcol = GLA ? C_GG + h * 256 : C_HG + h * 128;
    const int mcol = GLA ? h * 256 : 1024 + h * 128;
    const float* normw = GLA ? F.gla_norm_w + h * 256 : F.hgrn_norm_w + h * 128;
    const int dp = tid & 63, d0 = 2 * dp;
    const int item = GLA ? (b * 4 + h) * NSEG + seg : (b * 8 + h) * NSEG + seg;
    float* Lbase = (float*)(F.ws + (GLA ? WS_LG : WS_LH)); float* Dbase = (float*)(F.ws + (GLA ? WS_DG : WS_DH));
    constexpr int LSZ = 128 * dv;
    float wub[8], bub = 0.f, lb0 = 0.f, lb1 = 0.f;
    if (GLA) {
        const int col = h * 128 + 32 * (wave & 3) + (lane & 31);
#pragma unroll
        for (int s = 0; s < 8; ++s) wub[s] = F.gla_w_up[(size_t)(2 * s + (lane >> 5)) * 512 + col];
        bub = F.gla_b_up[col];
    } else {
#pragma unroll
        for (int s = 0; s < 8; ++s) wub[s] = 0.f;
        const f32x2 l0 = *(const f32x2*)(F.hgrn_lb + h * 128 + d0), l1 = *(const f32x2*)(F.hgrn_lb + 1024 + h * 128 + d0);
        lb0 = 1.0f / (1.0f + __expf(l1[0] - l0[0])); lb1 = 1.0f / (1.0f + __expf(l1[1] - l0[1]));
    }
    float elp0 = 1.f, elp1 = 1.f, dsum0 = 0.f, dsum1 = 0.f;
    const unsigned r = lane & 31, hh = lane >> 5;
    const unsigned tq = (lane & 15) >> 2, tp = lane & 3, tblk = (lane >> 4) & 1;
    const unsigned trk = (8 * hh + tq) * QK_STRIDE + 32 * tblk + 8 * tp, trv = (8 * hh + tq) * vstride + 32 * tblk + 8 * tp;
    const size_t row0 = (size_t)b * SEQ + (size_t)seg * NC * CHUNK;

    f32x16 S[4];
#pragma unroll
    for (int i = 0; i < 4; ++i)
#pragma unroll
        for (int j = 0; j < 16; ++j) S[i][j] = 0.f;
    if (PASSB && wave < nmw) {
        for (int sp = 0; sp < seg; ++sp) {
            const float* Lp = Lbase + (size_t)(item - seg + sp) * LSZ; const float* Dp = Dbase + (size_t)(item - seg + sp) * 128;
#pragma unroll
            for (int db = 0; db < 4; ++db)
#pragma unroll
                for (int g4 = 0; g4 < 4; ++g4) { const f32x4 lv = *(const f32x4*)(Lp + (((wave * 4 + db) * 4 + g4) * 64 + lane) * 4); const f32x4 dvv = *(const f32x4*)(Dp + 32 * db + 8 * g4 + 4 * hh);
#pragma unroll
                    for (int e = 0; e < 4; ++e) S[db][4 * g4 + e] = S[db][4 * g4 + e] * dvv[e] + lv[e]; }
        }
    }
    unsigned nq[8], nk[8]; float ng[8]; u32x4 vg[NVL];
    const __amdgpu_buffer_rsrc_t rs_pj = __builtin_amdgcn_make_buffer_rsrc((void*)F.PJ, 0, (int)((size_t)M * NPJ * 2), 0x00020000);
    const __amdgpu_buffer_rsrc_t rs_glr = __builtin_amdgcn_make_buffer_rsrc((void*)F.GLR, 0, M * 16 * 4, 0x00020000);
    const __amdgpu_buffer_rsrc_t rs_mix = __builtin_amdgcn_make_buffer_rsrc((void*)F.MIX, 0, (int)((size_t)M * DM * 2), 0x00020000);
    constexpr int CPR = dv / 8, RPP = NTHREADS / CPR;
    const unsigned vo_qk = 4 * dp, vo_g = ((lane & 31) * 16 + (lane >> 5)) * 4, vo_v = (tid / CPR) * (NPJ * 2) + (tid % CPR) * 16, vo_m = (tid / CPR) * (DM * 2) + (tid % CPR) * 16;
#define SCAN_PREFETCH(T0) do { const unsigned _sb = ((unsigned)(T0) + 8 * wave) * (NPJ * 2); \
        _Pragma("unroll") for (int i = 0; i < 8; ++i) { nk[i] = __builtin_amdgcn_raw_buffer_load_b32(rs_pj, vo_qk, _sb + i * (NPJ * 2) + kcol * 2, 0); if (PASSB) nq[i] = __builtin_amdgcn_raw_buffer_load_b32(rs_pj, vo_qk, _sb + i * (NPJ * 2) + qcol * 2, 0); } \
        if (GLA) { const unsigned _sg = ((unsigned)(T0) + 32 * (wave >> 2)) * 64; _Pragma("unroll") for (int s = 0; s < 8; ++s) ng[s] = __uint_as_float(__builtin_amdgcn_raw_buffer_load_b32(rs_glr, vo_g, _sg + 8 * s, 0)); } \
        } while (0)
#define SCAN_LOADVG(T0, COL) do { const unsigned _sv = (unsigned)(T0) * (NPJ * 2) + (COL) * 2; _Pragma("unroll") for (int j = 0; j < NVL; ++j) vg[j] = __builtin_amdgcn_raw_buffer_load_b128(rs_pj, vo_v, _sv + j * (RPP * NPJ * 2), 0); } while (0)
#pragma unroll
    for (int i = 0; i < 8; ++i) { nq[i] = 0u; ng[i] = 0.f; }
    SCAN_PREFETCH(row0); SCAN_LOADVG(row0, vcol);

    for (int c = 0; c < NC; ++c) {
        const size_t t0 = row0 + (size_t)c * CHUNK;
        if (GLA) {
            f32x16 z;
#pragma unroll
            for (int j = 0; j < 16; ++j) z[j] = 0.f;
#pragma unroll
            for (int s = 0; s < 8; ++s) z = __builtin_amdgcn_mfma_f32_32x32x2f32(ng[s], wub[s], z, 0, 0, 0);
#pragma unroll
            for (int reg = 0; reg < 16; ++reg) { const float zz = z[reg] + bub; const int row = 32 * (wave >> 2) + (reg & 3) + 8 * (reg >> 2) + 4 * (lane >> 5);
                LG[row * 128 + 32 * (wave & 3) + (lane & 31)] = (fminf(zz, 0.f) - __logf(1.0f + __expf(-fabsf(zz)))) * INV_TAU; }
            __syncthreads();
        }
        {
            float cum0 = 0.f, cum1 = 0.f;
#pragma unroll
            for (int i = 0; i < 8; ++i) {
                LAS f32x2* lgp = (LAS f32x2*)(LG + (8 * wave + i) * 128 + d0);
                float lg0, lg1;
                if (GLA) { const f32x2 lgv = *lgp; lg0 = lgv[0]; lg1 = lgv[1]; }
                else {
                    const unsigned kv = nk[i];
                    const float s0 = sigmoidf_(bf_lo(kv)), s1 = sigmoidf_(bf_hi(kv));
                    const float f0 = lb0 + (1.0f - lb0) * s0, f1 = lb1 + (1.0f - lb1) * s1;
                    lg0 = __logf(f0); lg1 = __logf(f1);
                    *(LAS f32x2*)(KS + (8 * wave + i) * 128 + d0) = (f32x2){1.0f - f0, 1.0f - f1};
                }
                cum0 += lg0; cum1 += lg1; *lgp = (f32x2){cum0, cum1};
            }
            *(LAS f32x2*)(TOT + wave * 128 + d0) = (f32x2){cum0, cum1};
        }
        __syncthreads();
        {
            float off0 = 0.f, off1 = 0.f, r0 = 0.f, r1 = 0.f, bl0 = 0.f, bl1 = 0.f;
#pragma unroll
            for (int g = 0; g < 8; ++g) { const f32x2 tv = *(const LAS f32x2*)(TOT + g * 128 + d0);
                if (g < wave) { off0 += tv[0]; off1 += tv[1]; } if (g < 4) { r0 += tv[0]; r1 += tv[1]; } bl0 += tv[0]; bl1 += tv[1]; }
            off0 -= r0; off1 -= r1;
#pragma unroll
            for (int i = 0; i < 8; ++i) {
                const f32x2 cv = *(const LAS f32x2*)(LG + (8 * wave + i) * 128 + d0);
                const float b0 = off0 + cv[0], b1 = off1 + cv[1];
                const unsigned o = (8 * wave + i) * QK_STRIDE + 4 * dp;
                if (PASSB) *(LAS unsigned*)(QT + o) = pk2(bf_lo(nq[i]) * QSCALE * __expf(b0), bf_hi(nq[i]) * QSCALE * __expf(b1));
                float kk0, kk1;
                if (GLA) { kk0 = bf_lo(nk[i]); kk1 = bf_hi(nk[i]); } else { const f32x2 kv = *(const LAS f32x2*)(KS + (8 * wave + i) * 128 + d0); kk0 = kv[0]; kk1 = kv[1]; }
                *(LAS unsigned*)(KT + o) = pk2(kk0 * __expf(-b0), kk1 * __expf(-b1));
            }
            if (wave == 0) { *(LAS f32x2*)(FAC + d0) = (f32x2){__expf(r0) * elp0, __expf(r1) * elp1}; elp0 = __expf(bl0 - r0); elp1 = __expf(bl1 - r1); dsum0 += bl0; dsum1 += bl1; }
        }
#pragma unroll
        for (int j = 0; j < NVL; ++j) *(LAS u32x4*)(VR + (tid / CPR + RPP * j) * vstride + 16 * (tid % CPR)) = vg[j];
        if (PASSB) SCAN_LOADVG(t0, gcol); else if (c + 1 < NC) SCAN_LOADVG(t0 + CHUNK, vcol);
        if (c + 1 < NC) SCAN_PREFETCH(t0 + CHUNK);
        __syncthreads();
        if (PASSB) {
            if (wave < 3) {
                const int it = wave > 0, jt = wave > 1;
                f32x16 a;
#pragma unroll
                for (int j = 0; j < 16; ++j) a[j] = 0.f;
#pragma unroll
                for (int s = 0; s < 8; ++s) { const bf16x8 qa = *(const LAS bf16x8*)(QT + (32 * it + r) * QK_STRIDE + 32 * s + 16 * hh); const bf16x8 kb = *(const LAS bf16x8*)(KT + (32 * jt + r) * QK_STRIDE + 32 * s + 16 * hh); a = MFMA32(qa, kb, a); }
                const int jj = 32 * jt + r;
#pragma unroll
                for (int reg = 0; reg < 16; ++reg) { const int ii = 32 * it + (reg & 3) + 8 * (reg >> 2) + 4 * hh; const float v = (jj <= ii) ? a[reg] : 0.f;
                    *(LAS unsigned short*)(AM + ii * 144 + jj * 2) = (unsigned short)(pk2(v, 0.f) & 0xffffu); }
            }
            __syncthreads();
        }
        f32x16 o[2];
        if (wave < nmw) {
#pragma unroll
            for (int i = 0; i < 2; ++i)
#pragma unroll
                for (int j = 0; j < 16; ++j) o[i][j] = 0.f;
#pragma unroll
            for (int db = 0; db < 4; ++db) {
                asm volatile("" ::: "memory");
#pragma unroll
                for (int g4 = 0; g4 < 4; ++g4) { const f32x4 fv = *(const LAS f32x4*)(FAC + 32 * db + 8 * g4 + 4 * hh);
#pragma unroll
                    for (int e = 0; e < 4; ++e) S[db][4 * g4 + e] *= fv[e]; }
                if (PASSB) {
#pragma unroll
                    for (int s = 0; s < 2; ++s) {
                        u32x4 pb; pb.x = pk2(S[db][8 * s + 0], S[db][8 * s + 1]); pb.y = pk2(S[db][8 * s + 2], S[db][8 * s + 3]); pb.z = pk2(S[db][8 * s + 4], S[db][8 * s + 5]); pb.w = pk2(S[db][8 * s + 6], S[db][8 * s + 7]);
                        const bf16x8 bs = __builtin_bit_cast(bf16x8, pb);
#pragma unroll
                        for (int it = 0; it < 2; ++it) {
                            const LAS unsigned char* qp = QT + (32 * it + r) * QK_STRIDE + 64 * db + 32 * s + 8 * hh; const s16x4 lo = *(const LAS s16x4*)qp, hi = *(const LAS s16x4*)(qp + 16);
                            o[it] = MFMA32(__builtin_shufflevector(lo, hi, 0, 1, 2, 3, 4, 5, 6, 7), bs, o[it]);
                        }
                    }
                }
            }
            bf16x8 vf[4];
#pragma unroll
            for (int ks = 0; ks < 4; ++ks) vf[ks] = tr_frag(VR, trv, vstride, wave, ks);
            if (PASSB) {
#pragma unroll
                for (int it = 0; it < 2; ++it)
#pragma unroll
                    for (int ks = 0; ks < 4; ++ks) { if (it == 0 && ks >= 2) continue;
                        const bf16x8 af = *(const LAS bf16x8*)(AM + (32 * it + r) * 144 + (16 * ks + 8 * hh) * 2); o[it] = MFMA32(af, vf[ks], o[it]); }
            }
#pragma unroll
            for (int db = 0; db < 4; ++db) {
                asm volatile("" ::: "memory");
#pragma unroll
                for (int ks = 0; ks < 4; ++ks) { const bf16x8 kf = tr_frag(KT, trk, QK_STRIDE, db, ks); S[db] = MFMA32(kf, vf[ks], S[db]); } }
            asm volatile("" ::: "memory");
            if (PASSB) {
#pragma unroll
                for (int it = 0; it < 2; ++it)
#pragma unroll
                    for (int reg = 0; reg < 16; ++reg) { float sq = o[it][reg] * o[it][reg];
                        sq += __shfl_xor(sq, 1); sq += __shfl_xor(sq, 2); sq += __shfl_xor(sq, 4); sq += __shfl_xor(sq, 8); sq += __shfl_xor(sq, 16);
                        if (r == 0) SS[wave * 64 + 32 * it + (reg & 3) + 8 * (reg >> 2) + 4 * hh] = sq; }
            }
        }
        if (PASSB) {
            __syncthreads();
            if (tid < 64) { float tsum = 0.f;
#pragma unroll
                for (int w = 0; w < nmw; ++w) tsum += SS[w * 64 + tid];
                RS[tid] = 1.0f / sqrtf(tsum / (float)dv + EPS); }
#pragma unroll
            for (int j = 0; j < NVL; ++j) *(LAS u32x4*)(VR + (tid / CPR + RPP * j) * vstride + 16 * (tid % CPR)) = vg[j];
            if (c + 1 < NC) SCAN_LOADVG(t0 + CHUNK, vcol);
            __syncthreads();
            if (wave < nmw) {
                const int e = 32 * wave + r; const float gn = normw[e];
#pragma unroll
                for (int it = 0; it < 2; ++it)
#pragma unroll
                    for (int g4 = 0; g4 < 4; ++g4) { const f32x4 rs = *(const LAS f32x4*)(RS + 32 * it + 8 * g4 + 4 * hh);
#pragma unroll
                        for (int e4 = 0; e4 < 4; ++e4) { const int reg = 4 * g4 + e4; LAS unsigned short* gp = (LAS unsigned short*)(VR + (32 * it + 8 * g4 + 4 * hh + e4) * vstride + 2 * e);
                            const float gate = bf_1(*gp); const float val = o[it][reg] * rs[e4] * gn * (gate * sigmoidf_(gate));
                            *gp = (unsigned short)(pk2(val, 0.f) & 0xffffu); } }
            }
            __syncthreads();
#pragma unroll
            for (int j = 0; j < NVL; ++j) __builtin_amdgcn_raw_buffer_store_b128(*(const LAS u32x4*)(VR + (tid / CPR + RPP * j) * vstride + 16 * (tid % CPR)), rs_mix, vo_m, ((unsigned)t0 + RPP * j) * (DM * 2) + mcol * 2, 0);
        }
    }
    if (!PASSB) {
        __syncthreads();
        if (wave == 0) { *(LAS f32x2*)(FAC + d0) = (f32x2){elp0, elp1}; *(f32x2*)(Dbase + (size_t)item * 128 + d0) = (f32x2){__expf(dsum0), __expf(dsum1)}; }
        __syncthreads();
        if (wave < nmw) {
            float* Lp = Lbase + (size_t)item * LSZ;
#pragma unroll
            for (int db = 0; db < 4; ++db)
#pragma unroll
                for (int g4 = 0; g4 < 4; ++g4) { const f32x4 fv = *(const LAS f32x4*)(FAC + 32 * db + 8 * g4 + 4 * hh); f32x4 ov;
#pragma unroll
                    for (int e = 0; e < 4; ++e) ov[e] = S[db][4 * g4 + e] * fv[e];
                    *(f32x4*)(Lp + (((wave * 4 + db) * 4 + g4) * 64 + lane) * 4) = ov; }
        }
    }
    __syncthreads();
#undef SCAN_PREFETCH
#undef SCAN_LOADVG
}

__device__ __forceinline__ void p2a_scan(Frame& F) {
    constexpr int NG = 16 * (NSEG_G - 1), NH = 32 * (NSEG_H - 1);
    static_assert(NG + NH <= 256, "pass A items");
    const int it = F.bid;
    if (it < NG) { const int bh = it / (NSEG_G - 1), seg = it % (NSEG_G - 1); scan_item<1, 0>(F, bh >> 2, bh & 3, seg); }
    else if (it < NG + NH) { const int j = it - NG, bh = j / (NSEG_H - 1), seg = j % (NSEG_H - 1); scan_item<0, 0>(F, bh >> 3, bh & 7, seg); }
}
__device__ __forceinline__ void p2b_scan(Frame& F) {
    constexpr int NG = 16 * NSEG_G, NH = 32 * NSEG_H;
    static_assert(NG + NH <= 256, "pass B items");
    const int it = F.bid;
    if (it < NG) { const int bh = it / NSEG_G, seg = it % NSEG_G; scan_item<1, 1>(F, bh >> 2, bh & 3, seg); }
    else if (it < NG + NH) { const int j = it - NG, bh = j / NSEG_H, seg = j % NSEG_H; scan_item<0, 1>(F, bh >> 3, bh & 7, seg); }
}

__device__ __forceinline__ void p4_final(Frame& F) {
    const int gw = F.bid * NWAVES + F.wave, NGW = F.G * NWAVES;
    f32x4 fw[8];
#pragma unroll
    for (int j = 0; j < 8; ++j) fw[j] = ((const f32x4*)F.final_w)[64 * j + F.lane];
    for (int m = gw; m < M; m += NGW) {
        const float rstd = 1.0f / sqrtf(F.SSQ[m] * (1.0f / DM) + EPS);
        f32x4* orow = (f32x4*)(F.out + (size_t)m * DM) + F.lane;
        f32x4 v[8];
#pragma unroll
        for (int j = 0; j < 8; ++j) v[j] = orow[64 * j];
#pragma unroll
        for (int j = 0; j < 8; ++j) orow[64 * j] = v[j] * rstd * fw[j];
    }
}

struct Args { const float* in[10]; float* out; unsigned char* ws; int ph_lo, ph_hi; };
__global__ void __launch_bounds__(NTHREADS, 2) mk_fwd(Args args) {
    extern __shared__ __attribute__((aligned(16))) unsigned char lds_raw[];
    Frame F;
    F.lds = (LAS unsigned char*)lds_raw;
    F.tid = threadIdx.x; F.lane = F.tid & 63; F.wave = __builtin_amdgcn_readfirstlane(F.tid >> 6);
    F.G = gridDim.x; F.bid = blockIdx.x;
    F.x = args.in[0]; F.norm_w = args.in[1]; F.w_in = args.in[2]; F.gla_w_up = args.in[3]; F.gla_b_up = args.in[4]; F.gla_norm_w = args.in[5];
    F.hgrn_lb = args.in[6]; F.hgrn_norm_w = args.in[7]; F.w_out = args.in[8]; F.final_w = args.in[9]; F.out = args.out;
    unsigned char* ws = args.ws; F.ws = ws;
    F.WinT = (bf16*)(ws + WS_WINT); F.WoutT = (bf16*)(ws + WS_WOUTT); F.HN = (bf16*)(ws + WS_HN); F.MIX = (bf16*)(ws + WS_MIX); F.PJ = (bf16*)(ws + WS_PJ);
    F.GLR = (float*)(ws + WS_GLR); F.SSQ = (float*)(ws + WS_SSQ);
    const int lo = args.ph_lo, hi = args.ph_hi;
#ifndef MK_PHASE_MASK
#define MK_PHASE_MASK 63
#endif
#define IN(k) (((MK_PHASE_MASK >> (k)) & 1) && lo <= (k) && (k) < hi)
#define BOTH(k) (IN(k) && IN((k) + 1))
#if MK_ONE_LAUNCH
#define GRID_BAR() do { cg::this_grid().sync(); } while (0)
#else
#define GRID_BAR() do { } while (0)
#endif
#ifndef MK_DUP
#define MK_DUP -1
#endif
    if (IN(0)) { p0_prologue(F); if (MK_DUP == 0) { GRID_BAR(); p0_prologue(F); } if (BOTH(0)) GRID_BAR(); }
    if (IN(1)) {
        pg8::Gemm g{F.HN, F.WinT, M, NPJ, DM}; pg8::StaticOrder S; S.init(M, NPJ, F.G, F.bid);
        pg8::EpiBf16<0> E{F.PJ, NPJ, nullptr, 0, 0, 1.f};
        pg8::gemm_phase<pg8::EpiBf16<0>, pg8::StaticOrder, PG8_ALIGN, PG8_SP2>(F.lds, g, S, E);
        if (MK_DUP == 1) { GRID_BAR(); pg8::gemm_phase<pg8::EpiBf16<0>, pg8::StaticOrder, PG8_ALIGN, PG8_SP2>(F.lds, g, S, E); }
        if (BOTH(1)) GRID_BAR();
    }
    if (IN(2)) { p2a_scan(F); if (MK_DUP == 2) { GRID_BAR(); p2a_scan(F); } if (BOTH(2)) GRID_BAR(); }
    if (IN(3)) { p2b_scan(F); if (MK_DUP == 3) { GRID_BAR(); p2b_scan(F); } if (BOTH(3)) GRID_BAR(); }
    if (IN(4)) {
        pg8::Gemm g{F.MIX, F.WoutT, M, DM, DM}; pg8::StaticOrder S; S.init(M, DM, F.G, F.bid);
        pg8::EpiResid E{F.x, F.out, DM, F.SSQ};
        pg8::gemm_phase<pg8::EpiResid, pg8::StaticOrder, PG8_ALIGN, PG8_SP2>(F.lds, g, S, E);
        if (BOTH(4)) GRID_BAR();
    }
    if (IN(5)) { p4_final(F); }
#undef IN
#undef BOTH
}

extern "C" void kernel_launch(void* const* d_in, const int* in_sizes, int n_in, void* d_out, int out_size, void* d_ws, size_t ws_size, hipStream_t stream) {
    static int grid = 0;
    if (grid == 0) {
        if (n_in != 10 || in_sizes[0] != M * DM || out_size != M * DM || ws_size < WS_END) { fprintf(stderr, "kernel_launch: unexpected shapes (n_in %d, in0 %d, out %d, ws %zu)\n", n_in, n_in > 0 ? in_sizes[0] : -1, out_size, ws_size); grid = -1; return; }
        int dev = 0, cus = 0, per_cu = 0;
        if (hipGetDevice(&dev) != hipSuccess || hipDeviceGetAttribute(&cus, hipDeviceAttributeMultiprocessorCount, dev) != hipSuccess) { grid = -1; return; }
        if (hipFuncSetAttribute((const void*)mk_fwd, hipFuncAttributeMaxDynamicSharedMemorySize, LDS_BYTES) != hipSuccess) { fprintf(stderr, "kernel_launch: hipFuncSetAttribute failed\n"); grid = -1; return; }
        if (hipOccupancyMaxActiveBlocksPerMultiprocessor(&per_cu, (const void*)mk_fwd, NTHREADS, LDS_BYTES) != hipSuccess || per_cu < 1) { fprintf(stderr, "kernel_launch: occupancy query says %d blocks per CU\n", per_cu); grid = -1; return; }
        (void)hipGetLastError();
        grid = cus;
        if (grid < 256) { fprintf(stderr, "kernel_launch: %d CUs; the scan phases need 256 workgroups\n", grid); grid = -1; return; }
        grid = 256;
    }
    if (grid < 0) return;
    (void)hipMemsetAsync((char*)d_ws + WS_CTL, 0, CTL_ZERO_BYTES, stream);
    Args a{};
    for (int i = 0; i < 10; ++i) a.in[i] = (const float*)d_in[i];
    a.out = (float*)d_out; a.ws = (unsigned char*)d_ws;
#if MK_ONE_LAUNCH
    a.ph_lo = 0; a.ph_hi = 6;
    void* kargs[] = {&a};
    hipError_t e = hipLaunchCooperativeKernel((const void*)mk_fwd, dim3(grid), dim3(NTHREADS), kargs, LDS_BYTES, stream);
    if (e != hipSuccess) fprintf(stderr, "kernel_launch: cooperative launch failed: %s (grid %d)\n", hipGetErrorString(e), grid);
#else
    for (int p = 0; p < 6; ++p) { a.ph_lo = p; a.ph_hi = p + 1; hipLaunchKernelGGL(mk_fwd, dim3(grid), dim3(NTHREADS), LDS_BYTES, stream, a); }
#endif
}
```

```cpp
#include <hip/hip_runtime.h>
#include <hip/hip_cooperative_groups.h>
#include <cstdio>
#include <cstdint>
namespace cg = cooperative_groups;
#ifndef MK_ONE_LAUNCH
#define MK_ONE_LAUNCH 1
#endif
namespace pg8 {
#define PG8_LAS __attribute__((address_space(3)))
typedef unsigned short bf16_t;
typedef short bf16x8 __attribute__((ext_vector_type(8)));
typedef float f32x4 __attribute__((ext_vector_type(4)));
typedef unsigned u32x4 __attribute__((ext_vector_type(4)));
constexpr int BM = 256, BK = 64, HALF = 128, HTB = HALF * BK * 2  , STAGE_BYTES = 8 * HTB, NXCD = 8, WGM = 8;

__host__ __device__ __forceinline__ int lds_byte(int r, int c) { const int st = (r >> 4) * 2 + (c >> 5), rr = r & 15, cc = c & 31, ob = rr * 64 + cc * 2; return st * 1024 + (ob ^ (((ob >> 9) & 1) << 5)); }
__host__ __device__ __forceinline__ void stage_rc(int b, int& R, int& C) { const int st = b / 1024, sb = b % 1024, swz = sb ^ (((sb >> 9) & 1) << 5); R = (st >> 1) * 16 + swz / 64; C = (st & 1) * 32 + (swz % 64) / 2; }
__host__ __device__ __forceinline__ int perm32(int rho) { const int n = rho >> 4, i = rho & 15; return 8 * (i >> 2) + 4 * n + (i & 3); }

struct Unit { int pm, pn; };
struct Gemm { const bf16_t* A; const bf16_t* Bt; int M, N, K; };

struct StaticOrder {
    int nM, nN, nwg, G, c;
    __host__ __device__ void init(int M, int N, int G_, int c_) { nM = M / BM; nN = N / BM; nwg = nM * nN; G = G_; c = c_; }
    __host__ __device__ bool next(int i, Unit& u) const {
        const long L = (long)i * G + c; if (L >= nwg) return false;
        int wgid = (int)L; { const int q = nwg / NXCD, r = nwg % NXCD, xcd = wgid % NXCD, off = wgid / NXCD; wgid = (xcd < r ? xcd * (q + 1) : r * (q + 1) + (xcd - r) * q) + off; }
        const int nig = WGM * nN, gid = wgid / nig, fm = gid * WGM, gsz = (nM - fm) < WGM ? (nM - fm) : WGM;
        u.pm = fm + ((wgid % nig) % gsz); u.pn = (wgid % nig) / gsz; return true;
    }
    __device__ __forceinline__ void a_ready(const Unit&) const {}
    __device__ __forceinline__ void done(const Unit&) const {}
};

__device__ __forceinline__ unsigned cvt_pk_bf16(float lo, float hi) { unsigned r; asm volatile("v_cvt_pk_bf16_f32 %0, %1, %2" : "=v"(r) : "v"(lo), "v"(hi)); return r; }
typedef float f32x2 __attribute__((ext_vector_type(2)));
__device__ __forceinline__ f32x2 gelu_pk(f32x2 v) {
    const f32x2 av = __builtin_elementwise_abs(v), d = av * 0.2316418882f + 1.0f;
    f32x2 t; t.x = __builtin_amdgcn_rcpf(d.x); t.y = __builtin_amdgcn_rcpf(d.y);
    f32x2 q = t * 0.5307027145f + (-0.7265760135f); q = q * t + 0.7107068705f; q = q * t + (-0.142248368f); q = q * t + 0.127414796f; q = q * t;
    const f32x2 s = (v * v) * (-0.72134752044f);
    f32x2 e; e.x = __builtin_amdgcn_exp2f(s.x); e.y = __builtin_amdgcn_exp2f(s.y);
    const f32x2 m = v * (q * e), r = v - m;
    f32x2 o; o.x = v.x < 0.f ? m.x : r.x; o.y = v.y < 0.f ? m.y : r.y; return o;
}

template <int ACT  > struct EpiBf16 {
    static constexpr bool PERM = true, AFTER_DRAIN = false; static_assert(ACT == 0 || ACT == 1, "EpiBf16: ACT is 0 (none) or 1 (gelu_pk)");
    bf16_t* O; int ldc; const float* bias; int split_cols; size_t split_stride; float scale0;
    __device__ __forceinline__ void operator()(const f32x4 (&acc)[2][2][4][2], const Unit& u, int wr, int wc, int fr, int fq) const {
        const int row0 = u.pm * BM + wr * 64 + fr; int colt = u.pn * BM; bf16_t* base = O;
        float sc = 1.f; if (split_cols) { const int t = colt / split_cols; base += (size_t)t * split_stride; colt -= t * split_cols; if (t == 0) sc = scale0; }
        const int col0 = colt + wc * 32 + 8 * fq, bcol0 = u.pn * BM + wc * 32 + 8 * fq;
        f32x4 bv[2][2];
#pragma unroll
        for (int bj = 0; bj < 2; ++bj)
#pragma unroll
            for (int n = 0; n < 2; ++n) bv[bj][n] = bias ? *(const f32x4*)(bias + bcol0 + bj * HALF + 4 * n) : (f32x4){0.f, 0.f, 0.f, 0.f};
#pragma unroll
        for (int ai = 0; ai < 2; ++ai)
#pragma unroll
            for (int m = 0; m < 4; ++m) { bf16_t* rowp = base + (size_t)(row0 + ai * HALF + m * 16) * ldc + col0;
#pragma unroll
                for (int bj = 0; bj < 2; ++bj) { f32x4 v0 = acc[ai][bj][m][0] + bv[bj][0], v1 = acc[ai][bj][m][1] + bv[bj][1];
                    if (ACT == 1) { f32x2 a = gelu_pk((f32x2){v0[0], v0[1]}), b = gelu_pk((f32x2){v0[2], v0[3]}), c = gelu_pk((f32x2){v1[0], v1[1]}), d = gelu_pk((f32x2){v1[2], v1[3]});
                        v0 = (f32x4){a.x, a.y, b.x, b.y}; v1 = (f32x4){c.x, c.y, d.x, d.y}; }
                    v0 = v0 * sc; v1 = v1 * sc; u32x4 w; w.x = cvt_pk_bf16(v0[0], v0[1]); w.y = cvt_pk_bf16(v0[2], v0[3]); w.z = cvt_pk_bf16(v1[0], v1[1]); w.w = cvt_pk_bf16(v1[2], v1[3]);
                    *(u32x4*)(rowp + bj * HALF) = w; } }
    }
};
struct EpiResid {
    static constexpr bool PERM = false, AFTER_DRAIN = false;
    const float* base; float* out; int ldc; float* ssq;
    __device__ __forceinline__ void operator()(const f32x4 (&acc)[2][2][4][2], const Unit& u, int wr, int wc, int fr, int fq) const {
        const int row0 = u.pm * BM + wr * 64 + fr, col0 = u.pn * BM + wc * 32 + 4 * fq;
#pragma unroll
        for (int ai = 0; ai < 2; ++ai)
#pragma unroll
            for (int m = 0; m < 4; ++m) { const int row = row0 + ai * HALF + m * 16; const size_t off = (size_t)row * ldc + col0; float s = 0.f;
#pragma unroll
                for (int bj = 0; bj < 2; ++bj)
#pragma unroll
                    for (int n = 0; n < 2; ++n) { const f32x4 v = *(const f32x4*)(base + off + bj * HALF + n * 16) + acc[ai][bj][m][n];
                        *(f32x4*)(out + off + bj * HALF + n * 16) = v; s += (v[0] * v[0] + v[1] * v[1]) + (v[2] * v[2] + v[3] * v[3]); }
                s += __shfl_xor(s, 16); s += __shfl_xor(s, 32);
                if (fq == 0) atomicAdd(ssq + row, s);
                asm volatile("" ::: "memory"); }
    }
};
template <class Epi, class Sched, bool ALIGN_EPI = false, bool SP2 = false>
__device__ __forceinline__ void gemm_phase(PG8_LAS unsigned char* lds, const Gemm g, const Sched& S, const Epi& E) {
    const int tid = threadIdx.x, wid = __builtin_amdgcn_readfirstlane(tid >> 6), lane = tid & 63, wr = wid >> 2, wc = wid & 3, fr = lane & 15, fq = lane >> 4;
    const int K = g.K, nt = K / BK;
    unsigned voffA[2], voffB[2];
#pragma unroll
    for (int i = 0; i < 2; ++i) { int R, C; stage_rc(tid * 16 + i * 8192, R, C); const int Rb = Epi::PERM ? ((R & ~31) + perm32(R & 31)) : R;
        voffA[i] = (unsigned)(R * K + C) * 2u; voffB[i] = (unsigned)(Rb * K + C) * 2u; }
    const size_t kstep = (size_t)(BK * 2);
    const size_t hstep = (size_t)HALF * K * 2;
    const size_t tstep = 2 * hstep;
    const unsigned ldsw = (unsigned)wid * 1024u;
    const int aoff = lds_byte(wr * 64 + fr, fq * 8), boff = lds_byte(wc * 32 + fr, fq * 8);
#define PG8_SA(b, h) (((b) * 2 + (h)) * HTB)
#define PG8_SB(b, h) ((4 + (b) * 2 + (h)) * HTB)
#define PG8_STAGE(bufoff, gbase, voff) do { _Pragma("unroll") for (int _i = 0; _i < 2; ++_i) \
        __builtin_amdgcn_global_load_lds((const unsigned*)((const char*)(gbase) + (voff)[_i]), (PG8_LAS unsigned*)(lds + (bufoff) + ldsw + _i * 8192), 16, 0, 0); } while (0)
#define PG8_LDA(dst, b, h) do { _Pragma("unroll") for (int m = 0; m < 4; ++m) _Pragma("unroll") for (int k = 0; k < 2; ++k) dst[m][k] = *(const PG8_LAS bf16x8*)(lds + PG8_SA(b, h) + aoff + m * 2048 + k * 1024); } while (0)
#define PG8_LDB(dst, b, h) do { _Pragma("unroll") for (int n = 0; n < 2; ++n) _Pragma("unroll") for (int k = 0; k < 2; ++k) dst[n][k] = *(const PG8_LAS bf16x8*)(lds + PG8_SB(b, h) + boff + n * 2048 + k * 1024); } while (0)
#define PG8_MMA(ai, bj, At, Bt) do { __builtin_amdgcn_s_setprio(1); _Pragma("unroll") for (int m = 0; m < 4; ++m) _Pragma("unroll") for (int n = 0; n < 2; ++n) _Pragma("unroll") for (int k = 0; k < 2; ++k) \
        acc[ai][bj][m][n] = __builtin_amdgcn_mfma_f32_16x16x32_bf16(Bt[n][k], At[m][k], acc[ai][bj][m][n], 0, 0, 0); __builtin_amdgcn_s_setprio(0); } while (0)
#define PG8_WAIT_V(n) asm volatile("s_waitcnt vmcnt(" #n ")" ::: "memory")
#define PG8_WAIT_L(n) asm volatile("s_waitcnt lgkmcnt(" #n ")" ::: "memory")
#define PG8_BAR __builtin_amdgcn_s_barrier()
#define PG8_SCHED __builtin_amdgcn_sched_barrier(0)
    Unit cur, nxt; int ui = 0;
    if (!S.next(0, cur)) return;
    f32x4 acc[2][2][4][2];
#pragma unroll
    for (int a = 0; a < 2; ++a)
#pragma unroll
        for (int b = 0; b < 2; ++b)
#pragma unroll
            for (int m = 0; m < 4; ++m)
#pragma unroll
                for (int n = 0; n < 2; ++n) acc[a][b][m][n] = (f32x4){0.f, 0.f, 0.f, 0.f};
    bf16x8 At[4][2], B0[2][2], B1[2][2];
    const char* cA = (const char*)g.A + (size_t)cur.pm * tstep; const char* cB = (const char*)g.Bt + (size_t)cur.pn * tstep;
    S.a_ready(cur);
    if constexpr (SP2) {
        PG8_STAGE(PG8_SB(0, 0), cB, voffB); PG8_STAGE(PG8_SB(0, 1), cB + hstep, voffB); PG8_STAGE(PG8_SA(0, 0), cA, voffA); PG8_STAGE(PG8_SA(0, 1), cA + hstep, voffA);
        if (wr == 1) PG8_BAR;
        PG8_WAIT_V(2); PG8_BAR;
        PG8_STAGE(PG8_SB(1, 0), cB + kstep, voffB); PG8_STAGE(PG8_SA(1, 0), cA + kstep, voffA); PG8_STAGE(PG8_SB(1, 1), cB + hstep + kstep, voffB);
        PG8_WAIT_V(6); PG8_BAR;
    } else {
        PG8_STAGE(PG8_SB(0, 0), cB, voffB); PG8_STAGE(PG8_SA(0, 0), cA, voffA); PG8_STAGE(PG8_SB(0, 1), cB + hstep, voffB); PG8_STAGE(PG8_SA(0, 1), cA + hstep, voffA);
        if (wr == 1) PG8_BAR;
        PG8_WAIT_V(4); PG8_BAR;
        PG8_STAGE(PG8_SB(1, 0), cB + kstep, voffB); PG8_STAGE(PG8_SA(1, 0), cA + kstep, voffA); PG8_STAGE(PG8_SB(1, 1), cB + hstep + kstep, voffB);
        PG8_WAIT_V(6); PG8_BAR;
    }
    for (;;) {
        const bool has_next = S.next(ui + 1, nxt);
        const char* nA = has_next ? (const char*)g.A + (size_t)nxt.pm * tstep : cA; const char* nB = has_next ? (const char*)g.Bt + (size_t)nxt.pn * tstep : cB;
        for (int t = 0; t < nt; t += 2) {
            const bool last = (t == nt - 2);
            const char* a1 = cA + (size_t)(t + 1) * kstep;
            const char* a2 = last ? nA : cA + (size_t)(t + 2) * kstep; const char* b2 = last ? nB : cB + (size_t)(t + 2) * kstep;
            const char* a3 = a2 + kstep; const char* b3 = b2 + kstep;
            if (last && has_next) S.a_ready(nxt);
            if constexpr (SP2) {
            PG8_LDB(B0, 0, 0); PG8_LDB(B1, 0, 1); PG8_SCHED; PG8_LDA(At, 0, 0); PG8_STAGE(PG8_SA(1, 1), a1 + hstep, voffA);
            PG8_WAIT_V(8); PG8_WAIT_L(0); PG8_BAR; PG8_MMA(0, 0, At, B0); PG8_MMA(0, 1, At, B1); PG8_BAR; PG8_SCHED;
            PG8_LDA(At, 0, 1); PG8_STAGE(PG8_SB(0, 0), b2, voffB); PG8_STAGE(PG8_SB(0, 1), b2 + hstep, voffB); PG8_STAGE(PG8_SA(0, 0), a2, voffA);
            PG8_WAIT_V(8); PG8_WAIT_L(0); PG8_BAR; PG8_MMA(1, 0, At, B0); PG8_MMA(1, 1, At, B1); PG8_BAR; PG8_SCHED;
            PG8_LDB(B0, 1, 0); PG8_LDB(B1, 1, 1); PG8_SCHED; PG8_LDA(At, 1, 0); PG8_STAGE(PG8_SA(0, 1), a2 + hstep, voffA);
            PG8_WAIT_V(8); PG8_WAIT_L(0); PG8_BAR; PG8_MMA(0, 0, At, B0); PG8_MMA(0, 1, At, B1); PG8_BAR; PG8_SCHED;
            PG8_LDA(At, 1, 1); PG8_STAGE(PG8_SB(1, 0), b3, voffB); PG8_STAGE(PG8_SB(1, 1), b3 + hstep, voffB); PG8_STAGE(PG8_SA(1, 0), a3, voffA);
            PG8_WAIT_V(8); PG8_WAIT_L(0); PG8_BAR; PG8_MMA(1, 0, At, B0); PG8_MMA(1, 1, At, B1); PG8_BAR; PG8_SCHED;
            } else {
            PG8_LDB(B0, 0, 0); PG8_SCHED; PG8_LDA(At, 0, 0); PG8_STAGE(PG8_SA(1, 1), a1 + hstep, voffA);
            PG8_WAIT_L(8); PG8_BAR; PG8_WAIT_L(0); PG8_MMA(0, 0, At, B0); PG8_BAR; PG8_SCHED;
            PG8_LDB(B1, 0, 1); PG8_STAGE(PG8_SB(0, 0), b2, voffB);
            PG8_BAR; PG8_WAIT_L(0); PG8_MMA(0, 1, At, B1); PG8_BAR;
            PG8_LDA(At, 0, 1); PG8_STAGE(PG8_SA(0, 0), a2, voffA);
            PG8_BAR; PG8_WAIT_L(0); PG8_MMA(1, 0, At, B0); PG8_BAR; PG8_SCHED;
            PG8_STAGE(PG8_SB(0, 1), b2 + hstep, voffB);
            PG8_WAIT_V(6); PG8_BAR; PG8_MMA(1, 1, At, B1); PG8_BAR;
            PG8_LDB(B0, 1, 0); PG8_SCHED; PG8_LDA(At, 1, 0); PG8_STAGE(PG8_SA(0, 1), a2 + hstep, voffA);
            PG8_WAIT_L(8); PG8_BAR; PG8_WAIT_L(0); PG8_MMA(0, 0, At, B0); PG8_BAR; PG8_SCHED;
            PG8_LDB(B1, 1, 1); PG8_STAGE(PG8_SB(1, 0), b3, voffB);
            PG8_BAR; PG8_WAIT_L(0); PG8_MMA(0, 1, At, B1); PG8_BAR;
            PG8_LDA(At, 1, 1); PG8_STAGE(PG8_SA(1, 0), a3, voffA);
            PG8_BAR; PG8_WAIT_L(0); PG8_MMA(1, 0, At, B0); PG8_BAR; PG8_SCHED;
            PG8_STAGE(PG8_SB(1, 1), b3 + hstep, voffB);
            PG8_WAIT_V(6); PG8_BAR; PG8_MMA(1, 1, At, B1); PG8_BAR;
            }
        }
        if constexpr (ALIGN_EPI) { if (wr == 0) PG8_BAR; }
        if constexpr (!Epi::AFTER_DRAIN) { E(acc, cur, wr, wc, fr, fq); S.done(cur); }
        if (!has_next) break;
#pragma unroll
        for (int a = 0; a < 2; ++a)
#pragma unroll
            for (int b = 0; b < 2; ++b)
#pragma unroll
                for (int m = 0; m < 4; ++m)
#pragma unroll
                    for (int n = 0; n < 2; ++n) acc[a][b][m][n] = (f32x4){0.f, 0.f, 0.f, 0.f};
        cur = nxt; cA = nA; cB = nB; ++ui;
        if constexpr (ALIGN_EPI) { if (wr == 1) PG8_BAR; }
    }
    PG8_WAIT_V(0);
    if constexpr (!ALIGN_EPI) { if (wr == 0) PG8_BAR; }
    PG8_BAR;
    if constexpr (Epi::AFTER_DRAIN) { E.fused(acc, cur, wr, wc, fr, fq, lds, wid, lane); S.done(cur); }
#undef PG8_SA
#undef PG8_SB
#undef PG8_STAGE
#undef PG8_LDA
#undef PG8_LDB
#undef PG8_MMA
#undef PG8_WAIT_V
#undef PG8_WAIT_L
#undef PG8_BAR
#undef PG8_SCHED
}
}
#ifndef PG8_SP2
#define PG8_SP2 true
#endif
#ifndef PG8_ALIGN
#define PG8_ALIGN true
#endif

constexpr int NWAVES = 8, NTHREADS = NWAVES * 64;
constexpr int DM = 2048, NBATCH = 4, SEQ = 4096, M = NBATCH * SEQ;
constexpr int NPROJ_IN = 7184;
constexpr int NPJ = 7168;
constexpr int C_GQ = 0, C_GK = 512, C_GV = 1024, C_GG = 2048, C_HQ = 3072, C_HF = 4096, C_HI = 5120, C_HG = 6144;
constexpr int SRC_GLR = 3072;
constexpr float EPS = 1e-6f, QSCALE = 0.08838834764831845f, INV_TAU = 1.0f / 16.0f;
constexpr int CHUNK = 64, NCHUNK = SEQ / CHUNK;

constexpr size_t MiB = 1u << 20;
constexpr size_t WS_CTL = 0, CTL_ZERO_BYTES = 128 * 1024;
constexpr size_t WS_SSQ = 64 * 1024;
constexpr size_t WS_WINT = 2 * MiB;
constexpr size_t WS_WOUTT = 30 * MiB;
constexpr size_t WS_GLR = 39 * MiB;
constexpr size_t WS_HN = 64 * MiB;
constexpr size_t WS_MIX = 128 * MiB;
constexpr size_t WS_PJ = 192 * MiB;
constexpr size_t WS_END = 416 * MiB;

constexpr int LDS_BYTES = 155648;
constexpr int QK_STRIDE = 272, L_QT = 0, L_KT = 64 * QK_STRIDE, L_VR = 2 * 64 * QK_STRIDE, L_AM = L_VR + 64 * 528, L_TOT = L_AM + 64 * 144, L_FAC = L_TOT + 8 * 128 * 4, L_SS = L_FAC + 128 * 4, L_RS = L_SS + 8 * 64 * 4, L_LG = L_RS + 64 * 4, L_KS = L_LG + 64 * 128 * 4, L_SCAN_END = L_KS + 64 * 128 * 4;
static_assert(L_SCAN_END <= LDS_BYTES - 128, "scan LDS map");

#define LAS __attribute__((address_space(3)))
typedef unsigned short bf16;
typedef float f32x4 __attribute__((ext_vector_type(4)));
typedef float f32x2 __attribute__((ext_vector_type(2)));
typedef float f32x16 __attribute__((ext_vector_type(16)));
typedef short bf16x8 __attribute__((ext_vector_type(8)));
typedef short s16x4 __attribute__((ext_vector_type(4)));
typedef unsigned u32x4 __attribute__((ext_vector_type(4)));
typedef unsigned u32x2 __attribute__((ext_vector_type(2)));
typedef __bf16 bf16x2_t __attribute__((ext_vector_type(2)));
#define MFMA32(a, b, c) __builtin_amdgcn_mfma_f32_32x32x16_bf16((a), (b), (c), 0, 0, 0)

__device__ __forceinline__ unsigned pk2(float lo, float hi) { const bf16x2_t v = __builtin_convertvector((f32x2){lo, hi}, bf16x2_t); return __builtin_bit_cast(unsigned, v); }
__device__ __forceinline__ float bf_lo(unsigned u) { return __uint_as_float(u << 16); }
__device__ __forceinline__ float bf_hi(unsigned u) { return __uint_as_float(u & 0xffff0000u); }
__device__ __forceinline__ float bf_1(unsigned short u) { return __uint_as_float(((unsigned)u) << 16); }
__device__ __forceinline__ float wave_sum(float v) {
#pragma unroll
    for (int o = 1; o < 64; o <<= 1) v += __shfl_xor(v, o);
    return v;
}
__device__ __forceinline__ float sigmoidf_(float x) { return 1.0f / (1.0f + __expf(-x)); }

#define XB_TMO      128
#define XB_XCNT(j)  (256  + 64 * (j))
#define XB_XSUB(j)  (1280 + 64 * (j))
#define XB_XGEN(j)  (2304 + 64 * (j))
#define XB_TOP      3328
#define XB_TOPGEN   3392
#define XCD_BAR_WORDS 3456
#define XB_SPIN_CAP (1u << 18)

__device__ __forceinline__ unsigned xb_ld(unsigned* p)              { return __hip_atomic_load(p, __ATOMIC_RELAXED, __HIP_MEMORY_SCOPE_AGENT); }
__device__ __forceinline__ unsigned xb_add(unsigned* p, unsigned v) { return __hip_atomic_fetch_add(p, v, __ATOMIC_RELAXED, __HIP_MEMORY_SCOPE_AGENT); }
__device__ __forceinline__ unsigned xb_xcc_id() { return (unsigned)__builtin_amdgcn_s_getreg((3 << 11) | 20) & 0xFu; }
#define XB_SPIN(cond, bar) do { unsigned _sp = 0; while (cond) { __builtin_amdgcn_s_sleep(1); \
    if ((++_sp & 255u) == 0u) { if (xb_ld(&(bar)[XB_TMO])) break; if (_sp > XB_SPIN_CAP) { atomicAdd(&(bar)[XB_TMO], 1u); break; } } } } while (0)

struct XcdBarrier {
    unsigned* bar; unsigned x;
    volatile LAS unsigned* st;
};

__device__ __forceinline__ XcdBarrier xcd_barrier_post(unsigned* bar, volatile LAS unsigned* st) {
    XcdBarrier b; b.bar = bar; b.x = xb_xcc_id(); b.st = st;
    if (threadIdx.x == 0) (void)xb_add(&bar[XB_XCNT(b.x)], 1u);
    return b;
}
__device__ __forceinline__ void xcd_barrier_complete(unsigned* bar, unsigned x, unsigned& nloc, unsigned& nx) {
    const unsigned G = gridDim.x * gridDim.y * gridDim.z;
    unsigned sum, cnt, mine, sp = 0u;
    for (;;) {
        sum = 0u; cnt = 0u; mine = 0u;
#pragma unroll
        for (unsigned j = 0; j < 16; ++j) { const unsigned c = xb_ld(&bar[XB_XCNT(j)]); sum += c; cnt += (c > 0u) ? 1u : 0u; mine = (j == x) ? c : mine; }
        if (sum == G) break;
        __builtin_amdgcn_s_sleep(1);
        if ((++sp & 255u) == 0u) { if (xb_ld(&bar[XB_TMO])) break; if (sp > XB_SPIN_CAP) { atomicAdd(&bar[XB_TMO], 1u); break; } }
    }
    nloc = mine > 0u ? mine : 1u; nx = cnt > 0u ? cnt : 1u;
}

__device__ __forceinline__ void xcd_barrier(const XcdBarrier& b) {
    asm volatile("s_waitcnt vmcnt(0)" ::: "memory");
    __syncthreads();
    if (threadIdx.x == 0) {
        unsigned* bar = b.bar;
        __builtin_amdgcn_s_waitcnt(0);
        unsigned nloc = b.st[0], nx = b.st[1];
        if (nloc == 0u) { xcd_barrier_complete(bar, b.x, nloc, nx); b.st[0] = nloc; b.st[1] = nx; }
        const unsigned old = xb_add(&bar[XB_XSUB(b.x)], 1u);
        const unsigned gen = old / nloc;
        if (old + 1u == (gen + 1u) * nloc) {
            __builtin_amdgcn_fence(__ATOMIC_RELEASE, "agent");
            asm volatile("s_waitcnt vmcnt(0)" ::: "memory");
            const unsigned og = xb_add(&bar[XB_TOP], 1u);
            const unsigned tg = og / nx;
            if (og + 1u == (tg + 1u) * nx) xb_add(&bar[XB_TOPGEN], 1u);
            else XB_SPIN(xb_ld(&bar[XB_TOPGEN]) == tg, bar);
            __builtin_amdgcn_fence(__ATOMIC_ACQUIRE, "agent");
            xb_add(&bar[XB_XGEN(b.x)], 1u);
            asm volatile("s_waitcnt vmcnt(0)" ::: "memory");
        } else {
            XB_SPIN(xb_ld(&bar[XB_XGEN(b.x)]) == gen, bar);
            __builtin_amdgcn_fence(__ATOMIC_ACQUIRE, "agent");
            asm volatile("s_waitcnt vmcnt(0)" ::: "memory");
        }
    }
    __syncthreads();
}

constexpr int CW_BAR = 4096;
constexpr int MISC_OFF = LDS_BYTES - 128;

struct Frame {
    LAS unsigned char* lds;
    int tid, lane, wave, G, bid;
    const float *x, *norm_w, *w_in, *gla_w_up, *gla_b_up, *gla_norm_w, *hgrn_lb, *hgrn_norm_w, *w_out, *final_w;
    float* out;
    bf16 *WinT, *WoutT, *HN, *MIX, *PJ;
    float *GLR, *SSQ;
    unsigned char* ws;
};

__device__ __forceinline__ void p0_transpose_item(const float* W, int ldw, int src_col, bf16* WT, int K, int dst_row, int kb, LAS float* scr, int lane) {
    const int k0 = 64 * kb;
#pragma unroll 8
    for (int i = 0; i < 32; ++i) { const int kk = 2 * i + (lane >> 5); scr[kk * 33 + (lane & 31)] = W[(size_t)(k0 + kk) * ldw + src_col + (lane & 31)]; }
    asm volatile("s_waitcnt lgkmcnt(0)" ::: "memory");
    const int c = lane & 7;
#pragma unroll
    for (int j = 0; j < 4; ++j) { const int n = (lane >> 3) + 8 * j; const LAS float* s = scr + (8 * c) * 33 + n;
        u32x4 o; o.x = pk2(s[0 * 33], s[1 * 33]); o.y = pk2(s[2 * 33], s[3 * 33]); o.z = pk2(s[4 * 33], s[5 * 33]); o.w = pk2(s[6 * 33], s[7 * 33]);
        *(u32x4*)(WT + (size_t)(dst_row + n) * K + k0 + 8 * c) = o; }
    asm volatile("s_waitcnt lgkmcnt(0)" ::: "memory");
}

__device__ __forceinline__ void p0_prologue(Frame& F) {
    const int gw = F.bid * NWAVES + F.wave, NGW = F.G * NWAVES;
    {
        LAS float* scr = (LAS float*)(F.lds + F.wave * 16384);
        constexpr int KB = DM / 64;
        constexpr int I_IN = KB * (NPJ / 32), I_OUT = KB * (DM / 32);
        for (int it = gw; it < I_IN + I_OUT; it += NGW) {
            if (it < I_IN) { const int kb = it / (NPJ / 32), nb = it % (NPJ / 32), n0 = 32 * nb; const int src = n0 < SRC_GLR ? n0 : n0 + 16;
                p0_transpose_item(F.w_in, NPROJ_IN, src, F.WinT, DM, n0, kb, scr, F.lane); }
            else { const int r = it - I_IN, kb = r / (DM / 32), nb = r % (DM / 32);
                p0_transpose_item(F.w_out, DM, 32 * nb, F.WoutT, DM, 32 * nb, kb, scr, F.lane); }
        }
    }
    __syncthreads();
    LAS float* Wt = (LAS float*)F.lds;
    for (int k = F.tid; k < DM; k += NTHREADS) {
        const f32x4* src = (const f32x4*)(F.w_in + (size_t)k * NPROJ_IN + SRC_GLR);
#pragma unroll
        for (int q = 0; q < 4; ++q) { const f32x4 v = src[q]; Wt[(4 * q + 0) * DM + k] = v[0]; Wt[(4 * q + 1) * DM + k] = v[1]; Wt[(4 * q + 2) * DM + k] = v[2]; Wt[(4 * q + 3) * DM + k] = v[3]; }
    }
    __syncthreads();
    f32x4 nw[8];
#pragma unroll
    for (int j = 0; j < 8; ++j) nw[j] = ((const f32x4*)F.norm_w)[64 * j + F.lane];
    const LAS f32x4* Wt4 = (const LAS f32x4*)Wt;
    for (int m = gw; m < M; m += NGW) {
        const f32x4* xr = (const f32x4*)(F.x + (size_t)m * DM) + F.lane;
        f32x4 v[8]; float s = 0.f;
#pragma unroll
        for (int j = 0; j < 8; ++j) { v[j] = xr[64 * j]; s += (v[j][0] * v[j][0] + v[j][1] * v[j][1]) + (v[j][2] * v[j][2] + v[j][3] * v[j][3]); }
        const float rstd = 1.0f / sqrtf(wave_sum(s) * (1.0f / DM) + EPS);
        float a[16];
#pragma unroll
        for (int c = 0; c < 16; ++c) a[c] = 0.f;
        u32x2* o8 = (u32x2*)(F.HN + (size_t)m * DM) + F.lane;
#pragma unroll
        for (int j = 0; j < 8; ++j) {
            v[j] = v[j] * rstd * nw[j];
            u32x2 w; w.x = pk2(v[j][0], v[j][1]); w.y = pk2(v[j][2], v[j][3]); o8[64 * j] = w;
            asm volatile("" ::: "memory");
#pragma unroll
            for (int c = 0; c < 16; ++c) { const f32x4 wv = Wt4[c * (DM / 4) + 64 * j + F.lane]; a[c] += (v[j][0] * wv[0] + v[j][1] * wv[1]) + (v[j][2] * wv[2] + v[j][3] * wv[3]); }
        }
        float mine = 0.f;
#pragma unroll
        for (int c = 0; c < 16; ++c) { const float t = wave_sum(a[c]); mine = (F.lane == c) ? t : mine; }
        if (F.lane < 16) F.GLR[(size_t)m * 16 + F.lane] = mine;
    }
    __syncthreads();
}

constexpr int NSEG_G = 8, NSEG_H = 4;
constexpr size_t WS_LG = WS_HN, WS_LH = WS_HN + 16 * MiB, WS_DG = WS_HN + 48 * MiB, WS_DH = WS_HN + 49 * MiB;
static_assert(16 * NSEG_G * 131072 <= 16 * MiB && 32 * NSEG_H * 65536 <= 32 * MiB, "L buffers");

__device__ __forceinline__ bf16x8 tr_frag(LAS unsigned char* img, unsigned lanebase, unsigned stride, unsigned c, unsigned ks) {
    const unsigned a0 = lanebase + (16 * ks) * stride + 64 * c;
    const s16x4 lo = __builtin_amdgcn_ds_read_tr16_b64_v4i16((LAS s16x4*)(img + a0));
    const s16x4 hi = __builtin_amdgcn_ds_read_tr16_b64_v4i16((LAS s16x4*)(img + a0 + 4 * stride));
    return __builtin_shufflevector(lo, hi, 0, 1, 2, 3, 4, 5, 6, 7);
}

template <int GLA, int PASSB>
__device__ __forceinline__ void scan_item(Frame& F, const int b, const int h, const int seg) {
    constexpr int dv = GLA ? 256 : 128, nmw = dv / 32, NSEG = GLA ? NSEG_G : NSEG_H, NC = NCHUNK / NSEG;
    constexpr unsigned vstride = 2 * dv + 16;
    constexpr int NVL = 64 * (dv / 8) / NTHREADS;
    const int tid = F.tid, lane = F.lane, wave = F.wave;
    LAS unsigned char* lds = F.lds;
    LAS unsigned char* QT = lds + L_QT; LAS unsigned char* KT = lds + L_KT; LAS unsigned char* VR = lds + L_VR; LAS unsigned char* AM = lds + L_AM;
    LAS float* TOT = (LAS float*)(lds + L_TOT); LAS float* FAC = (LAS float*)(lds + L_FAC); LAS float* SS = (LAS float*)(lds + L_SS); LAS float* RS = (LAS float*)(lds + L_RS);
    LAS float* LG = (LAS float*)(lds + L_LG); LAS float* KS = (LAS float*)(lds + L_KS);
    const int qcol = GLA ? C_GQ + h * 128 : C_HQ + h * 128, kcol = GLA ? C_GK + h * 128 : C_HF + h * 128;
    const int vcol = GLA ? C_GV + h * 256 : C_HI + h * 128, gcol = GLA ? C_GG + h * 256 : C_HG + h * 128;
    const int mcol = GLA ? h * 256 : 1024 + h * 128;
    const float* normw = GLA ? F.gla_norm_w + h * 256 : F.hgrn_norm_w + h * 128;
    const int dp = tid & 63, d0 = 2 * dp;
    const int item = GLA ? (b * 4 + h) * NSEG + seg : (b * 8 + h) * NSEG + seg;
    float* Lbase = (float*)(F.ws + (GLA ? WS_LG : WS_LH)); float* Dbase = (float*)(F.ws + (GLA ? WS_DG : WS_DH));
    constexpr int LSZ = 128 * dv;
    float wub[8], bub = 0.f, lb0 = 0.f, lb1 = 0.f;
    if (GLA) {
        const int col = h * 128 + 32 * (wave & 3) + (lane & 31);
#pragma unroll
        for (int s = 0; s < 8; ++s) wub[s] = F.gla_w_up[(size_t)(2 * s + (lane >> 5)) * 512 + col];
        bub = F.gla_b_up[col];
    } else {
#pragma unroll
        for (int s = 0; s < 8; ++s) wub[s] = 0.f;
        const f32x2 l0 = *(const f32x2*)(F.hgrn_lb + h * 128 + d0), l1 = *(const f32x2*)(F.hgrn_lb + 1024 + h * 128 + d0);
        lb0 = 1.0f / (1.0f + __expf(l1[0] - l0[0])); lb1 = 1.0f / (1.0f + __expf(l1[1] - l0[1]));
    }
    float elp0 = 1.f, elp1 = 1.f, dsum0 = 0.f, dsum1 = 0.f;
    const unsigned r = lane & 31, hh = lane >> 5;
    const unsigned tq = (lane & 15) >> 2, tp = lane & 3, tblk = (lane >> 4) & 1;
    const unsigned trk = (8 * hh + tq) * QK_STRIDE + 32 * tblk + 8 * tp, trv = (8 * hh + tq) * vstride + 32 * tblk + 8 * tp;
    const size_t row0 = (size_t)b * SEQ + (size_t)seg * NC * CHUNK;

    f32x16 S[4];
#pragma unroll
    for (int i = 0; i < 4; ++i)
#pragma unroll
        for (int j = 0; j < 16; ++j) S[i][j] = 0.f;
    if (PASSB && wave < nmw) {
        for (int sp = 0; sp < seg; ++sp) {
            const float* Lp = Lbase + (size_t)(item - seg + sp) * LSZ; const float* Dp = Dbase + (size_t)(item - seg + sp) * 128;
#pragma unroll
            for (int db = 0; db < 4; ++db)
#pragma unroll
                for (int g4 = 0; g4 < 4; ++g4) { const f32x4 lv = *(const f32x4*)(Lp + (((wave * 4 + db) * 4 + g4) * 64 + lane) * 4); const f32x4 dvv = *(const f32x4*)(Dp + 32 * db + 8 * g4 + 4 * hh);
#pragma unroll
                    for (int e = 0; e < 4; ++e) S[db][4 * g4 + e] = S[db][4 * g4 + e] * dvv[e] + lv[e]; }
        }
    }
    unsigned nq[8], nk[8]; float ng[8]; u32x4 vg[NVL];
    const __amdgpu_buffer_rsrc_t rs_pj = __builtin_amdgcn_make_buffer_rsrc((void*)F.PJ, 0, (int)((size_t)M * NPJ * 2), 0x00020000);
    const __amdgpu_buffer_rsrc_t rs_glr = __builtin_amdgcn_make_buffer_rsrc((void*)F.GLR, 0, M * 16 * 4, 0x00020000);
    const __amdgpu_buffer_rsrc_t rs_mix = __builtin_amdgcn_make_buffer_rsrc((void*)F.MIX, 0, (int)((size_t)M * DM * 2), 0x00020000);
    constexpr int CPR = dv / 8, RPP = NTHREADS / CPR;
    const unsigned vo_qk = 4 * dp, vo_g = ((lane & 31) * 16 + (lane >> 5)) * 4, vo_v = (tid / CPR) * (NPJ * 2) + (tid % CPR) * 16, vo_m = (tid / CPR) * (DM * 2) + (tid % CPR) * 16;
#define SCAN_PREFETCH(T0) do { const unsigned _sb = ((unsigned)(T0) + 8 * wave) * (NPJ * 2); \
        _Pragma("unroll") for (int i = 0; i < 8; ++i) { nk[i] = __builtin_amdgcn_raw_buffer_load_b32(rs_pj, vo_qk, _sb + i * (NPJ * 2) + kcol * 2, 0); if (PASSB) nq[i] = __builtin_amdgcn_raw_buffer_load_b32(rs_pj, vo_qk, _sb + i * (NPJ * 2) + qcol * 2, 0); } \
        if (GLA) { const unsigned _sg = ((unsigned)(T0) + 32 * (wave >> 2)) * 64; _Pragma("unroll") for (int s = 0; s < 8; ++s) ng[s] = __uint_as_float(__builtin_amdgcn_raw_buffer_load_b32(rs_glr, vo_g, _sg + 8 * s, 0)); } \
        } while (0)
#define SCAN_LOADVG(T0, COL) do { const unsigned _sv = (unsigned)(T0) * (NPJ * 2) + (COL) * 2; _Pragma("unroll") for (int j = 0; j < NVL; ++j) vg[j] = __builtin_amdgcn_raw_buffer_load_b128(rs_pj, vo_v, _sv + j * (RPP * NPJ * 2), 0); } while (0)
#pragma unroll
    for (int i = 0; i < 8; ++i) { nq[i] = 0u; ng[i] = 0.f; }
    SCAN_PREFETCH(row0); SCAN_LOADVG(row0, vcol);

    for (int c = 0; c < NC; ++c) {
        const size_t t0 = row0 + (size_t)c * CHUNK;
        if (GLA) {
            f32x16 z;
#pragma unroll
            for (int j = 0; j < 16; ++j) z[j] = 0.f;
#pragma unroll
            for (int s = 0; s < 8; ++s) z = __builtin_amdgcn_mfma_f32_32x32x2f32(ng[s], wub[s], z, 0, 0, 0);
#pragma unroll
            for (int reg = 0; reg < 16; ++reg) { const float zz = z[reg] + bub; const int row = 32 * (wave >> 2) + (reg & 3) + 8 * (reg >> 2) + 4 * (lane >> 5);
                LG[row * 128 + 32 * (wave & 3) + (lane & 31)] = (fminf(zz, 0.f) - __logf(1.0f + __expf(-fabsf(zz)))) * INV_TAU; }
            __syncthreads();
        }
        {
            float cum0 = 0.f, cum1 = 0.f;
#pragma unroll
            for (int i = 0; i < 8; ++i) {
                LAS f32x2* lgp = (LAS f32x2*)(LG + (8 * wave + i) * 128 + d0);
                float lg0, lg1;
                if (GLA) { const f32x2 lgv = *lgp; lg0 = lgv[0]; lg1 = lgv[1]; }
                else {
                    const unsigned kv = nk[i];
                    const float s0 = sigmoidf_(bf_lo(kv)), s1 = sigmoidf_(bf_hi(kv));
                    const float f0 = lb0 + (1.0f - lb0) * s0, f1 = lb1 + (1.0f - lb1) * s1;
                    lg0 = __logf(f0); lg1 = __logf(f1);
                    *(LAS f32x2*)(KS + (8 * wave + i) * 128 + d0) = (f32x2){1.0f - f0, 1.0f - f1};
                }
                cum0 += lg0; cum1 += lg1; *lgp = (f32x2){cum0, cum1};
            }
            *(LAS f32x2*)(TOT + wave * 128 + d0) = (f32x2){cum0, cum1};
        }
        __syncthreads();
        {
            float off0 = 0.f, off1 = 0.f, r0 = 0.f, r1 = 0.f, bl0 = 0.f, bl1 = 0.f;
#pragma unroll
            for (int g = 0; g < 8; ++g) { const f32x2 tv = *(const LAS f32x2*)(TOT + g * 128 + d0);
                if (g < wave) { off0 += tv[0]; off1 += tv[1]; } if (g < 4) { r0 += tv[0]; r1 += tv[1]; } bl0 += tv[0]; bl1 += tv[1]; }
            off0 -= r0; off1 -= r1;
#pragma unroll
            for (int i = 0; i < 8; ++i) {
                const f32x2 cv = *(const LAS f32x2*)(LG + (8 * wave + i) * 128 + d0);
                const float b0 = off0 + cv[0], b1 = off1 + cv[1];
                const unsigned o = (8 * wave + i) * QK_STRIDE + 4 * dp;
                if (PASSB) *(LAS unsigned*)(QT + o) = pk2(bf_lo(nq[i]) * QSCALE * __expf(b0), bf_hi(nq[i]) * QSCALE * __expf(b1));
                float kk0, kk1;
                if (GLA) { kk0 = bf_lo(nk[i]); kk1 = bf_hi(nk[i]); } else { const f32x2 kv = *(const LAS f32x2*)(KS + (8 * wave + i) * 128 + d0); kk0 = kv[0]; kk1 = kv[1]; }
                *(LAS unsigned*)(KT + o) = pk2(kk0 * __expf(-b0), kk1 * __expf(-b1));
            }
            if (wave == 0) { *(LAS f32x2*)(FAC + d0) = (f32x2){__expf(r0) * elp0, __expf(r1) * elp1}; elp0 = __expf(bl0 - r0); elp1 = __expf(bl1 - r1); dsum0 += bl0; dsum1 += bl1; }
        }
#pragma unroll
        for (int j = 0; j < NVL; ++j) *(LAS u32x4*)(VR + (tid / CPR + RPP * j) * vstride + 16 * (tid % CPR)) = vg[j];
        if (PASSB) SCAN_LOADVG(t0, gcol); else if (c + 1 < NC) SCAN_LOADVG(t0 + CHUNK, vcol);
        if (c + 1 < NC) SCAN_PREFETCH(t0 + CHUNK);
        __syncthreads();
        if (PASSB) {
            if (wave < 3) {
                const int it = wave > 0, jt = wave > 1;
                f32x16 a;
#pragma unroll
                for (int j = 0; j < 16; ++j) a[j] = 0.f;
#pragma unroll
                for (int s = 0; s < 8; ++s) { const bf16x8 qa = *(const LAS bf16x8*)(QT + (32 * it + r) * QK_STRIDE + 32 * s + 16 * hh); const bf16x8 kb = *(const LAS bf16x8*)(KT + (32 * jt + r) * QK_STRIDE + 32 * s + 16 * hh); a = MFMA32(qa, kb, a); }
                const int jj = 32 * jt + r;
#pragma unroll
                for (int reg = 0; reg < 16; ++reg) { const int ii = 32 * it + (reg & 3) + 8 * (reg >> 2) + 4 * hh; const float v = (jj <= ii) ? a[reg] : 0.f;
                    *(LAS unsigned short*)(AM + ii * 144 + jj * 2) = (unsigned short)(pk2(v, 0.f) & 0xffffu); }
            }
            __syncthreads();
        }
        f32x16 o[2];
        if (wave < nmw) {
#pragma unroll
            for (int i = 0; i < 2; ++i)
#pragma unroll
                for (int j = 0; j < 16; ++j) o[i][j] = 0.f;
#pragma unroll
            for (int db = 0; db < 4; ++db) {
                asm volatile("" ::: "memory");
#pragma unroll
                for (int g4 = 0; g4 < 4; ++g4) { const f32x4 fv = *(const LAS f32x4*)(FAC + 32 * db + 8 * g4 + 4 * hh);
#pragma unroll
                    for (int e = 0; e < 4; ++e) S[db][4 * g4 + e] *= fv[e]; }
                if (PASSB) {
#pragma unroll
                    for (int s = 0; s < 2; ++s) {
                        u32x4 pb; pb.x = pk2(S[db][8 * s + 0], S[db][8 * s + 1]); pb.y = pk2(S[db][8 * s + 2], S[db][8 * s + 3]); pb.z = pk2(S[db][8 * s + 4], S[db][8 * s + 5]); pb.w = pk2(S[db][8 * s + 6], S[db][8 * s + 7]);
                        const bf16x8 bs = __builtin_bit_cast(bf16x8, pb);
#pragma unroll
                        for (int it = 0; it < 2; ++it) {
                            const LAS unsigned char* qp = QT + (32 * it + r) * QK_STRIDE + 64 * db + 32 * s + 8 * hh; const s16x4 lo = *(const LAS s16x4*)qp, hi = *(const LAS s16x4*)(qp + 16);
                            o[it] = MFMA32(__builtin_shufflevector(lo, hi, 0, 1, 2, 3, 4, 5, 6, 7), bs, o[it]);
                        }
                    }
                }
            }
            bf16x8 vf[4];
#pragma unroll
            for (int ks = 0; ks < 4; ++ks) vf[ks] = tr_frag(VR, trv, vstride, wave, ks);
            if (PASSB) {
#pragma unroll
                for (int it = 0; it < 2; ++it)
#pragma unroll
                    for (int ks = 0; ks < 4; ++ks) { if (it == 0 && ks >= 2) continue;
                        const bf16x8 af = *(const LAS bf16x8*)(AM + (32 * it + r) * 144 + (16 * ks + 8 * hh) * 2); o[it] = MFMA32(af, vf[ks], o[it]); }
            }
#pragma unroll
            for (int db = 0; db < 4; ++db) {
                asm volatile("" ::: "memory");
#pragma unroll
                for (int ks = 0; ks < 4; ++ks) { const bf16x8 kf = tr_frag(KT, trk, QK_STRIDE, db, ks); S[db] = MFMA32(kf, vf[ks], S[db]); } }
            asm volatile("" ::: "memory");
            if (PASSB) {
#pragma unroll
                for (int it = 0; it < 2; ++it)
#pragma unroll
                    for (int reg = 0; reg < 16; ++reg) { float sq = o[it][reg] * o[it][reg];
                        sq += __shfl_xor(sq, 1); sq += __shfl_xor(sq, 2); sq += __shfl_xor(sq, 4); sq += __shfl_xor(sq, 8); sq += __shfl_xor(sq, 16);
                        if (r == 0) SS[wave * 64 + 32 * it + (reg & 3) + 8 * (reg >> 2) + 4 * hh] = sq; }
            }
        }
        if (PASSB) {
            __syncthreads();
            if (tid < 64) { float tsum = 0.f;
#pragma unroll
                for (int w = 0; w < nmw; ++w) tsum += SS[w * 64 + tid];
                RS[tid] = 1.0f / sqrtf(tsum / (float)dv + EPS); }
#pragma unroll
            for (int j = 0; j < NVL; ++j) *(LAS u32x4*)(VR + (tid / CPR + RPP * j) * vstride + 16 * (tid % CPR)) = vg[j];
            if (c + 1 < NC) SCAN_LOADVG(t0 + CHUNK, vcol);
            __syncthreads();
            if (wave < nmw) {
                const int e = 32 * wave + r; const float gn = normw[e];
#pragma unroll
                for (int it = 0; it < 2; ++it)
#pragma unroll
                    for (int g4 = 0; g4 < 4; ++g4) { const f32x4 rs = *(const LAS f32x4*)(RS + 32 * it + 8 * g4 + 4 * hh);
#pragma unroll
                        for (int e4 = 0; e4 < 4; ++e4) { const int reg = 4 * g4 + e4; LAS unsigned short* gp = (LAS unsigned short*)(VR + (32 * it + 8 * g4 + 4 * hh + e4) * vstride + 2 * e);
                            const float gate = bf_1(*gp); const float val = o[it][reg] * rs[e4] * gn * (gate * sigmoidf_(gate));
                            *gp = (unsigned short)(pk2(val, 0.f) & 0xffffu); } }
            }
            __syncthreads();
#pragma unroll
            for (int j = 0; j < NVL; ++j) __builtin_amdgcn_raw_buffer_store_b128(*(const LAS u32x4*)(VR + (tid / CPR + RPP * j) * vstride + 16 * (tid % CPR)), rs_mix, vo_m, ((unsigned)t0 + RPP * j) * (DM * 2) + mcol * 2, 0);
        }
    }
    if (!PASSB) {
        __syncthreads();
        if (wave == 0) { *(LAS f32x2*)(FAC + d0) = (f32x2){elp0, elp1}; *(f32x2*)(Dbase + (size_t)item * 128 + d0) = (f32x2){__expf(dsum0), __expf(dsum1)}; }
        __syncthreads();
        if (wave < nmw) {
            float* Lp = Lbase + (size_t)item * LSZ;
#pragma unroll
            for (int db = 0; db < 4; ++db)
#pragma unroll
                for (int g4 = 0; g4 < 4; ++g4) { const f32x4 fv = *(const LAS f32x4*)(FAC + 32 * db + 8 * g4 + 4 * hh); f32x4 ov;
#pragma unroll
                    for (int e = 0; e < 4; ++e) ov[e] = S[db][4 * g4 + e] * fv[e];
                    *(f32x4*)(Lp + (((wave * 4 + db) * 4 + g4) * 64 + lane) * 4) = ov; }
        }
    }
    __syncthreads();
#undef SCAN_PREFETCH
#undef SCAN_LOADVG
}

__device__ __forceinline__ void p2a_scan(Frame& F) {
    constexpr int NG = 16 * (NSEG_G - 1), NH = 32 * (NSEG_H - 1);
    static_assert(NG + NH <= 256, "pass A items");
    const int it = F.bid;
    if (it < NG) { const int bh = it / (NSEG_G - 1), seg = it % (NSEG_G - 1); scan_item<1, 0>(F, bh >> 2, bh & 3, seg); }
    else if (it < NG + NH) { const int j = it - NG, bh = j / (NSEG_H - 1), seg = j % (NSEG_H - 1); scan_item<0, 0>(F, bh >> 3, bh & 7, seg); }
}
__device__ __forceinline__ void p2b_scan(Frame& F) {
    constexpr int NG = 16 * NSEG_G, NH = 32 * NSEG_H;
    static_assert(NG + NH <= 256, "pass B items");
    const int it = F.bid;
    if (it < NG) { const int bh = it / NSEG_G, seg = it % NSEG_G; scan_item<1, 1>(F, bh >> 2, bh & 3, seg); }
    else if (it < NG + NH) { const int j = it - NG, bh = j / NSEG_H, seg = j % NSEG_H; scan_item<0, 1>(F, bh >> 3, bh & 7, seg); }
}

__device__ __forceinline__ void p4_final(Frame& F) {
    const int gw = F.bid * NWAVES + F.wave, NGW = F.G * NWAVES;
    f32x4 fw[8];
#pragma unroll
    for (int j = 0; j < 8; ++j) fw[j] = ((const f32x4*)F.final_w)[64 * j + F.lane];
    for (int m = gw; m < M; m += NGW) {
        const float rstd = 1.0f / sqrtf(F.SSQ[m] * (1.0f / DM) + EPS);
        f32x4* orow = (f32x4*)(F.out + (size_t)m * DM) + F.lane;
        f32x4 v[8];
#pragma unroll
        for (int j = 0; j < 8; ++j) v[j] = orow[64 * j];
#pragma unroll
        for (int j = 0; j < 8; ++j) orow[64 * j] = v[j] * rstd * fw[j];
    }
}

struct Args { const float* in[10]; float* out; unsigned char* ws; int ph_lo, ph_hi; };
__global__ void __launch_bounds__(NTHREADS, 2) mk_fwd(Args args) {
    extern __shared__ __attribute__((aligned(16))) unsigned char lds_raw[];
    Frame F;
    F.lds = (LAS unsigned char*)lds_raw;
    F.tid = threadIdx.x; F.lane = F.tid & 63; F.wave = __builtin_amdgcn_readfirstlane(F.tid >> 6);
    F.G = gridDim.x; F.bid = blockIdx.x;
    F.x = args.in[0]; F.norm_w = args.in[1]; F.w_in = args.in[2]; F.gla_w_up = args.in[3]; F.gla_b_up = args.in[4]; F.gla_norm_w = args.in[5];
    F.hgrn_lb = args.in[6]; F.hgrn_norm_w = args.in[7]; F.w_out = args.in[8]; F.final_w = args.in[9]; F.out = args.out;
    unsigned char* ws = args.ws; F.ws = ws;
    F.WinT = (bf16*)(ws + WS_WINT); F.WoutT = (bf16*)(ws + WS_WOUTT); F.HN = (bf16*)(ws + WS_HN); F.MIX = (bf16*)(ws + WS_MIX); F.PJ = (bf16*)(ws + WS_PJ);
    F.GLR = (float*)(ws + WS_GLR); F.SSQ = (float*)(ws + WS_SSQ);
    const int lo = args.ph_lo, hi = args.ph_hi;
#if MK_ONE_LAUNCH
    if (F.tid < 32) ((LAS unsigned*)(F.lds + MISC_OFF))[F.tid] = 0u;
    __syncthreads();
    const XcdBarrier xbar = xcd_barrier_post((unsigned*)(ws + WS_CTL) + CW_BAR, (volatile LAS unsigned*)(F.lds + MISC_OFF));
#endif
#ifndef MK_PHASE_MASK
#define MK_PHASE_MASK 63
#endif
#define IN(k) (((MK_PHASE_MASK >> (k)) & 1) && lo <= (k) && (k) < hi)
#define BOTH(k) (IN(k) && IN((k) + 1))
#if MK_ONE_LAUNCH
#define GRID_BAR() do { xcd_barrier(xbar); } while (0)
#else
#define GRID_BAR() do { } while (0)
#endif
#ifndef MK_DUP
#define MK_DUP -1
#endif
    if (IN(0)) { p0_prologue(F); if (MK_DUP == 0) { GRID_BAR(); p0_prologue(F); } if (BOTH(0)) GRID_BAR(); }
    if (IN(1)) {
        pg8::Gemm g{F.HN, F.WinT, M, NPJ, DM}; pg8::StaticOrder S; S.init(M, NPJ, F.G, F.bid);
        pg8::EpiBf16<0> E{F.PJ, NPJ, nullptr, 0, 0, 1.f};
        pg8::gemm_phase<pg8::EpiBf16<0>, pg8::StaticOrder, PG8_ALIGN, PG8_SP2>(F.lds, g, S, E);
        if (MK_DUP == 1) { GRID_BAR(); pg8::gemm_phase<pg8::EpiBf16<0>, pg8::StaticOrder, PG8_ALIGN, PG8_SP2>(F.lds, g, S, E); }
        if (BOTH(1)) GRID_BAR();
    }
    if (IN(2)) { p2a_scan(F); if (MK_DUP == 2) { GRID_BAR(); p2a_scan(F); } if (BOTH(2)) GRID_BAR(); }
    if (IN(3)) { p2b_scan(F); if (MK_DUP == 3) { GRID_BAR(); p2b_scan(F); } if (BOTH(3)) GRID_BAR(); }
    if (IN(4)) {
        pg8::Gemm g{F.MIX, F.WoutT, M, DM, DM}; pg8::StaticOrder S; S.init(M, DM, F.G, F.bid);
        pg8::EpiResid E{F.x, F.out, DM, F.SSQ};
        pg8::gemm_phase<pg8::EpiResid, pg8::StaticOrder, PG8_ALIGN, PG8_SP2>(F.lds, g, S, E);
        if (BOTH(4)) GRID_BAR();
    }
    if (IN(5)) { p4_final(F); }
#undef IN
#undef BOTH
}

extern "C" void kernel_launch(void* const* d_in, const int* in_sizes, int n_in, void* d_out, int out_size, void* d_ws, size_t ws_size, hipStream_t stream) {
    static int grid = 0;
    if (grid == 0) {
        if (n_in != 10 || in_sizes[0] != M * DM || out_size != M * DM || ws_size < WS_END) { fprintf(stderr, "kernel_launch: unexpected shapes (n_in %d, in0 %d, out %d, ws %zu)\n", n_in, n_in > 0 ? in_sizes[0] : -1, out_size, ws_size); grid = -1; return; }
        int dev = 0, cus = 0, per_cu = 0;
        if (hipGetDevice(&dev) != hipSuccess || hipDeviceGetAttribute(&cus, hipDeviceAttributeMultiprocessorCount, dev) != hipSuccess) { grid = -1; return; }
        if (hipFuncSetAttribute((const void*)mk_fwd, hipFuncAttributeMaxDynamicSharedMemorySize, LDS_BYTES) != hipSuccess) { fprintf(stderr, "kernel_launch: hipFuncSetAttribute failed\n"); grid = -1; return; }
        if (hipOccupancyMaxActiveBlocksPerMultiprocessor(&per_cu, (const void*)mk_fwd, NTHREADS, LDS_BYTES) != hipSuccess || per_cu < 1) { fprintf(stderr, "kernel_launch: occupancy query says %d blocks per CU\n", per_cu); grid = -1; return; }
        (void)hipGetLastError();
        grid = cus;
        if (grid < 256) { fprintf(stderr, "kernel_launch: %d CUs; the scan phases need 256 workgroups\n", grid); grid = -1; return; }
        grid = 256;
    }
    if (grid < 0) return;
    (void)hipMemsetAsync((char*)d_ws + WS_CTL, 0, CTL_ZERO_BYTES, stream);
    Args a{};
    for (int i = 0; i < 10; ++i) a.in[i] = (const float*)d_in[i];
    a.out = (float*)d_out; a.ws = (unsigned char*)d_ws;
#if MK_ONE_LAUNCH
    a.ph_lo = 0; a.ph_hi = 6;
    void* kargs[] = {&a};
    hipError_t e = hipLaunchCooperativeKernel((const void*)mk_fwd, dim3(grid), dim3(NTHREADS), kargs, LDS_BYTES, stream);
    if (e != hipSuccess) fprintf(stderr, "kernel_launch: cooperative launch failed: %s (grid %d)\n", hipGetErrorString(e), grid);
#else
    for (int p = 0; p < 6; ++p) { a.ph_lo = p; a.ph_hi = p + 1; hipLaunchKernelGGL(mk_fwd, dim3(grid), dim3(NTHREADS), LDS_BYTES, stream, a); }
#endif
}
```

```cpp
#include <hip/hip_runtime.h>
#include <hip/hip_cooperative_groups.h>
#include <cstdio>
#include <cstdint>
namespace cg = cooperative_groups;
#ifndef MK_ONE_LAUNCH
#define MK_ONE_LAUNCH 1
#endif
namespace pg8 {
#define PG8_LAS __attribute__((address_space(3)))
typedef unsigned short bf16_t;
typedef short bf16x8 __attribute__((ext_vector_type(8)));
typedef float f32x4 __attribute__((ext_vector_type(4)));
typedef unsigned u32x4 __attribute__((ext_vector_type(4)));
constexpr int BM = 256, BK = 64, HALF = 128, HTB = HALF * BK * 2  , STAGE_BYTES = 8 * HTB, NXCD = 8, WGM = 8;

__host__ __device__ __forceinline__ int lds_byte(int r, int c) { const int st = (r >> 4) * 2 + (c >> 5), rr = r & 15, cc = c & 31, ob = rr * 64 + cc * 2; return st * 1024 + (ob ^ (((ob >> 9) & 1) << 5)); }
__host__ __device__ __forceinline__ void stage_rc(int b, int& R, int& C) { const int st = b / 1024, sb = b % 1024, swz = sb ^ (((sb >> 9) & 1) << 5); R = (st >> 1) * 16 + swz / 64; C = (st & 1) * 32 + (swz % 64) / 2; }
__host__ __device__ __forceinline__ int perm32(int rho) { const int n = rho >> 4, i = rho & 15; return 8 * (i >> 2) + 4 * n + (i & 3); }

struct Unit { int pm, pn; };
struct Gemm { const bf16_t* A; const bf16_t* Bt; int M, N, K; };

struct StaticOrder {
    int nM, nN, nwg, G, c;
    __host__ __device__ void init(int M, int N, int G_, int c_) { nM = M / BM; nN = N / BM; nwg = nM * nN; G = G_; c = c_; }
    __host__ __device__ bool next(int i, Unit& u) const {
        const long L = (long)i * G + c; if (L >= nwg) return false;
        int wgid = (int)L; { const int q = nwg / NXCD, r = nwg % NXCD, xcd = wgid % NXCD, off = wgid / NXCD; wgid = (xcd < r ? xcd * (q + 1) : r * (q + 1) + (xcd - r) * q) + off; }
        const int nig = WGM * nN, gid = wgid / nig, fm = gid * WGM, gsz = (nM - fm) < WGM ? (nM - fm) : WGM;
        u.pm = fm + ((wgid % nig) % gsz); u.pn = (wgid % nig) / gsz; return true;
    }
    __device__ __forceinline__ void a_ready(const Unit&) const {}
    __device__ __forceinline__ void done(const Unit&) const {}
};

__device__ __forceinline__ unsigned cvt_pk_bf16(float lo, float hi) { unsigned r; asm volatile("v_cvt_pk_bf16_f32 %0, %1, %2" : "=v"(r) : "v"(lo), "v"(hi)); return r; }
typedef float f32x2 __attribute__((ext_vector_type(2)));
__device__ __forceinline__ f32x2 gelu_pk(f32x2 v) {
    const f32x2 av = __builtin_elementwise_abs(v), d = av * 0.2316418882f + 1.0f;
    f32x2 t; t.x = __builtin_amdgcn_rcpf(d.x); t.y = __builtin_amdgcn_rcpf(d.y);
    f32x2 q = t * 0.5307027145f + (-0.7265760135f); q = q * t + 0.7107068705f; q = q * t + (-0.142248368f); q = q * t + 0.127414796f; q = q * t;
    const f32x2 s = (v * v) * (-0.72134752044f);
    f32x2 e; e.x = __builtin_amdgcn_exp2f(s.x); e.y = __builtin_amdgcn_exp2f(s.y);
    const f32x2 m = v * (q * e), r = v - m;
    f32x2 o; o.x = v.x < 0.f ? m.x : r.x; o.y = v.y < 0.f ? m.y : r.y; return o;
}

template <int ACT  > struct EpiBf16 {
    static constexpr bool PERM = true, AFTER_DRAIN = false; static_assert(ACT == 0 || ACT == 1, "EpiBf16: ACT is 0 (none) or 1 (gelu_pk)");
    bf16_t* O; int ldc; const float* bias; int split_cols; size_t split_stride; float scale0;
    __device__ __forceinline__ void operator()(const f32x4 (&acc)[2][2][4][2], const Unit& u, int wr, int wc, int fr, int fq) const {
        const int row0 = u.pm * BM + wr * 64 + fr; int colt = u.pn * BM; bf16_t* base = O;
        float sc = 1.f; if (split_cols) { const int t = colt / split_cols; base += (size_t)t * split_stride; colt -= t * split_cols; if (t == 0) sc = scale0; }
        const int col0 = colt + wc * 32 + 8 * fq, bcol0 = u.pn * BM + wc * 32 + 8 * fq;
        f32x4 bv[2][2];
#pragma unroll
        for (int bj = 0; bj < 2; ++bj)
#pragma unroll
            for (int n = 0; n < 2; ++n) bv[bj][n] = bias ? *(const f32x4*)(bias + bcol0 + bj * HALF + 4 * n) : (f32x4){0.f, 0.f, 0.f, 0.f};
#pragma unroll
        for (int ai = 0; ai < 2; ++ai)
#pragma unroll
            for (int m = 0; m < 4; ++m) { bf16_t* rowp = base + (size_t)(row0 + ai * HALF + m * 16) * ldc + col0;
#pragma unroll
                for (int bj = 0; bj < 2; ++bj) { f32x4 v0 = acc[ai][bj][m][0] + bv[bj][0], v1 = acc[ai][bj][m][1] + bv[bj][1];
                    if (ACT == 1) { f32x2 a = gelu_pk((f32x2){v0[0], v0[1]}), b = gelu_pk((f32x2){v0[2], v0[3]}), c = gelu_pk((f32x2){v1[0], v1[1]}), d = gelu_pk((f32x2){v1[2], v1[3]});
                        v0 = (f32x4){a.x, a.y, b.x, b.y}; v1 = (f32x4){c.x, c.y, d.x, d.y}; }
                    v0 = v0 * sc; v1 = v1 * sc; u32x4 w; w.x = cvt_pk_bf16(v0[0], v0[1]); w.y = cvt_pk_bf16(v0[2], v0[3]); w.z = cvt_pk_bf16(v1[0], v1[1]); w.w = cvt_pk_bf16(v1[2], v1[3]);
                    *(u32x4*)(rowp + bj * HALF) = w; } }
    }
};
struct EpiResid {
    static constexpr bool PERM = false, AFTER_DRAIN = false;
    const float* base; float* out; int ldc; float* ssq;
    __device__ __forceinline__ void operator()(const f32x4 (&acc)[2][2][4][2], const Unit& u, int wr, int wc, int fr, int fq) const {
        const int row0 = u.pm * BM + wr * 64 + fr, col0 = u.pn * BM + wc * 32 + 4 * fq;
#pragma unroll
        for (int ai = 0; ai < 2; ++ai)
#pragma unroll
            for (int m = 0; m < 4; ++m) { const int row = row0 + ai * HALF + m * 16; const size_t off = (size_t)row * ldc + col0; float s = 0.f;
#pragma unroll
                for (int bj = 0; bj < 2; ++bj)
#pragma unroll
                    for (int n = 0; n < 2; ++n) { const f32x4 v = *(const f32x4*)(base + off + bj * HALF + n * 16) + acc[ai][bj][m][n];
                        *(f32x4*)(out + off + bj * HALF + n * 16) = v; s += (v[0] * v[0] + v[1] * v[1]) + (v[2] * v[2] + v[3] * v[3]); }
                s += __shfl_xor(s, 16); s += __shfl_xor(s, 32);
                if (fq == 0) atomicAdd(ssq + row, s);
                asm volatile("" ::: "memory"); }
    }
};
template <class Epi, class Sched, bool ALIGN_EPI = false, bool SP2 = false>
__device__ __forceinline__ void gemm_phase(PG8_LAS unsigned char* lds, const Gemm g, const Sched& S, const Epi& E) {
    const int tid = threadIdx.x, wid = __builtin_amdgcn_readfirstlane(tid >> 6), lane = tid & 63, wr = wid >> 2, wc = wid & 3, fr = lane & 15, fq = lane >> 4;
    const int K = g.K, nt = K / BK;
    unsigned voffA[2], voffB[2];
#pragma unroll
    for (int i = 0; i < 2; ++i) { int R, C; stage_rc(tid * 16 + i * 8192, R, C); const int Rb = Epi::PERM ? ((R & ~31) + perm32(R & 31)) : R;
        voffA[i] = (unsigned)(R * K + C) * 2u; voffB[i] = (unsigned)(Rb * K + C) * 2u; }
    const size_t kstep = (size_t)(BK * 2);
    const size_t hstep = (size_t)HALF * K * 2;
    const size_t tstep = 2 * hstep;
    const unsigned ldsw = (unsigned)wid * 1024u;
    const int aoff = lds_byte(wr * 64 + fr, fq * 8), boff = lds_byte(wc * 32 + fr, fq * 8);
#define PG8_SA(b, h) (((b) * 2 + (h)) * HTB)
#define PG8_SB(b, h) ((4 + (b) * 2 + (h)) * HTB)
#define PG8_STAGE(bufoff, gbase, voff) do { _Pragma("unroll") for (int _i = 0; _i < 2; ++_i) \
        __builtin_amdgcn_global_load_lds((const unsigned*)((const char*)(gbase) + (voff)[_i]), (PG8_LAS unsigned*)(lds + (bufoff) + ldsw + _i * 8192), 16, 0, 0); } while (0)
#define PG8_LDA(dst, b, h) do { _Pragma("unroll") for (int m = 0; m < 4; ++m) _Pragma("unroll") for (int k = 0; k < 2; ++k) dst[m][k] = *(const PG8_LAS bf16x8*)(lds + PG8_SA(b, h) + aoff + m * 2048 + k * 1024); } while (0)
#define PG8_LDB(dst, b, h) do { _Pragma("unroll") for (int n = 0; n < 2; ++n) _Pragma("unroll") for (int k = 0; k < 2; ++k) dst[n][k] = *(const PG8_LAS bf16x8*)(lds + PG8_SB(b, h) + boff + n * 2048 + k * 1024); } while (0)
#define PG8_MMA(ai, bj, At, Bt) do { __builtin_amdgcn_s_setprio(1); _Pragma("unroll") for (int m = 0; m < 4; ++m) _Pragma("unroll") for (int n = 0; n < 2; ++n) _Pragma("unroll") for (int k = 0; k < 2; ++k) \
        acc[ai][bj][m][n] = __builtin_amdgcn_mfma_f32_16x16x32_bf16(Bt[n][k], At[m][k], acc[ai][bj][m][n], 0, 0, 0); __builtin_amdgcn_s_setprio(0); } while (0)
#define PG8_WAIT_V(n) asm volatile("s_waitcnt vmcnt(" #n ")" ::: "memory")
#define PG8_WAIT_L(n) asm volatile("s_waitcnt lgkmcnt(" #n ")" ::: "memory")
#define PG8_BAR __builtin_amdgcn_s_barrier()
#define PG8_SCHED __builtin_amdgcn_sched_barrier(0)
    Unit cur, nxt; int ui = 0;
    if (!S.next(0, cur)) return;
    f32x4 acc[2][2][4][2];
#pragma unroll
    for (int a = 0; a < 2; ++a)
#pragma unroll
        for (int b = 0; b < 2; ++b)
#pragma unroll
            for (int m = 0; m < 4; ++m)
#pragma unroll
                for (int n = 0; n < 2; ++n) acc[a][b][m][n] = (f32x4){0.f, 0.f, 0.f, 0.f};
    bf16x8 At[4][2], B0[2][2], B1[2][2];
    const char* cA = (const char*)g.A + (size_t)cur.pm * tstep; const char* cB = (const char*)g.Bt + (size_t)cur.pn * tstep;
    S.a_ready(cur);
    if constexpr (SP2) {
        PG8_STAGE(PG8_SB(0, 0), cB, voffB); PG8_STAGE(PG8_SB(0, 1), cB + hstep, voffB); PG8_STAGE(PG8_SA(0, 0), cA, voffA); PG8_STAGE(PG8_SA(0, 1), cA + hstep, voffA);
        if (wr == 1) PG8_BAR;
        PG8_WAIT_V(2); PG8_BAR;
        PG8_STAGE(PG8_SB(1, 0), cB + kstep, voffB); PG8_STAGE(PG8_SA(1, 0), cA + kstep, voffA); PG8_STAGE(PG8_SB(1, 1), cB + hstep + kstep, voffB);
        PG8_WAIT_V(6); PG8_BAR;
    } else {
        PG8_STAGE(PG8_SB(0, 0), cB, voffB); PG8_STAGE(PG8_SA(0, 0), cA, voffA); PG8_STAGE(PG8_SB(0, 1), cB + hstep, voffB); PG8_STAGE(PG8_SA(0, 1), cA + hstep, voffA);
        if (wr == 1) PG8_BAR;
        PG8_WAIT_V(4); PG8_BAR;
        PG8_STAGE(PG8_SB(1, 0), cB + kstep, voffB); PG8_STAGE(PG8_SA(1, 0), cA + kstep, voffA); PG8_STAGE(PG8_SB(1, 1), cB + hstep + kstep, voffB);
        PG8_WAIT_V(6); PG8_BAR;
    }
    for (;;) {
        const bool has_next = S.next(ui + 1, nxt);
        const char* nA = has_next ? (const char*)g.A + (size_t)nxt.pm * tstep : cA; const char* nB = has_next ? (const char*)g.Bt + (size_t)nxt.pn * tstep : cB;
        for (int t = 0; t < nt; t += 2) {
            const bool last = (t == nt - 2);
            const char* a1 = cA + (size_t)(t + 1) * kstep;
            const char* a2 = last ? nA : cA + (size_t)(t + 2) * kstep; const char* b2 = last ? nB : cB + (size_t)(t + 2) * kstep;
            const char* a3 = a2 + kstep; const char* b3 = b2 + kstep;
            if (last && has_next) S.a_ready(nxt);
            if constexpr (SP2) {
            PG8_LDB(B0, 0, 0); PG8_LDB(B1, 0, 1); PG8_SCHED; PG8_LDA(At, 0, 0); PG8_STAGE(PG8_SA(1, 1), a1 + hstep, voffA);
            PG8_WAIT_V(8); PG8_WAIT_L(0); PG8_BAR; PG8_MMA(0, 0, At, B0); PG8_MMA(0, 1, At, B1); PG8_BAR; PG8_SCHED;
            PG8_LDA(At, 0, 1); PG8_STAGE(PG8_SB(0, 0), b2, voffB); PG8_STAGE(PG8_SB(0, 1), b2 + hstep, voffB); PG8_STAGE(PG8_SA(0, 0), a2, voffA);
            PG8_WAIT_V(8); PG8_WAIT_L(0); PG8_BAR; PG8_MMA(1, 0, At, B0); PG8_MMA(1, 1, At, B1); PG8_BAR; PG8_SCHED;
            PG8_LDB(B0, 1, 0); PG8_LDB(B1, 1, 1); PG8_SCHED; PG8_LDA(At, 1, 0); PG8_STAGE(PG8_SA(0, 1), a2 + hstep, voffA);
            PG8_WAIT_V(8); PG8_WAIT_L(0); PG8_BAR; PG8_MMA(0, 0, At, B0); PG8_MMA(0, 1, At, B1); PG8_BAR; PG8_SCHED;
            PG8_LDA(At, 1, 1); PG8_STAGE(PG8_SB(1, 0), b3, voffB); PG8_STAGE(PG8_SB(1, 1), b3 + hstep, voffB); PG8_STAGE(PG8_SA(1, 0), a3, voffA);
            PG8_WAIT_V(8); PG8_WAIT_L(0); PG8_BAR; PG8_MMA(1, 0, At, B0); PG8_MMA(1, 1, At, B1); PG8_BAR; PG8_SCHED;
            } else {
            PG8_LDB(B0, 0, 0); PG8_SCHED; PG8_LDA(At, 0, 0); PG8_STAGE(PG8_SA(1, 1), a1 + hstep, voffA);
            PG8_WAIT_L(8); PG8_BAR; PG8_WAIT_L(0); PG8_MMA(0, 0, At, B0); PG8_BAR; PG8_SCHED;
            PG8_LDB(B1, 0, 1); PG8_STAGE(PG8_SB(0, 0), b2, voffB);
            PG8_BAR; PG8_WAIT_L(0); PG8_MMA(0, 1, At, B1); PG8_BAR;
            PG8_LDA(At, 0, 1); PG8_STAGE(PG8_SA(0, 0), a2, voffA);
            PG8_BAR; PG8_WAIT_L(0); PG8_MMA(1, 0, At, B0); PG8_BAR; PG8_SCHED;
            PG8_STAGE(PG8_SB(0, 1), b2 + hstep, voffB);
            PG8_WAIT_V(6); PG8_BAR; PG8_MMA(1, 1, At, B1); PG8_BAR;
            PG8_LDB(B0, 1, 0); PG8_SCHED; PG8_LDA(At, 1, 0); PG8_STAGE(PG8_SA(0, 1), a2 + hstep, voffA);
            PG8_WAIT_L(8); PG8_BAR; PG8_WAIT_L(0); PG8_MMA(0, 0, At, B0); PG8_BAR; PG8_SCHED;
            PG8_LDB(B1, 1, 1); PG8_STAGE(PG8_SB(1, 0), b3, voffB);
            PG8_BAR; PG8_WAIT_L(0); PG8_MMA(0, 1, At, B1); PG8_BAR;
            PG8_LDA(At, 1, 1); PG8_STAGE(PG8_SA(1, 0), a3, voffA);
            PG8_BAR; PG8_WAIT_L(0); PG8_MMA(1, 0, At, B0); PG8_BAR; PG8_SCHED;
            PG8_STAGE(PG8_SB(1, 1), b3 + hstep, voffB);
            PG8_WAIT_V(6); PG8_BAR; PG8_MMA(1, 1, At, B1); PG8_BAR;
            }
        }
        if constexpr (ALIGN_EPI) { if (wr == 0) PG8_BAR; }
        if constexpr (!Epi::AFTER_DRAIN) { E(acc, cur, wr, wc, fr, fq); S.done(cur); }
        if (!has_next) break;
#pragma unroll
        for (int a = 0; a < 2; ++a)
#pragma unroll
            for (int b = 0; b < 2; ++b)
#pragma unroll
                for (int m = 0; m < 4; ++m)
#pragma unroll
                    for (int n = 0; n < 2; ++n) acc[a][b][m][n] = (f32x4){0.f, 0.f, 0.f, 0.f};
        cur = nxt; cA = nA; cB = nB; ++ui;
        if constexpr (ALIGN_EPI) { if (wr == 1) PG8_BAR; }
    }
    PG8_WAIT_V(0);
    if constexpr (!ALIGN_EPI) { if (wr == 0) PG8_BAR; }
    PG8_BAR;
    if constexpr (Epi::AFTER_DRAIN) { E.fused(acc, cur, wr, wc, fr, fq, lds, wid, lane); S.done(cur); }
#undef PG8_SA
#undef PG8_SB
#undef PG8_STAGE
#undef PG8_LDA
#undef PG8_LDB
#undef PG8_MMA
#undef PG8_WAIT_V
#undef PG8_WAIT_L
#undef PG8_BAR
#undef PG8_SCHED
}
}
#ifndef PG8_SP2
#define PG8_SP2 true
#endif
#ifndef PG8_ALIGN
#define PG8_ALIGN true
#endif

constexpr int NWAVES = 8, NTHREADS = NWAVES * 64;
constexpr int DM = 2048, NBATCH = 4, SEQ = 4096, M = NBATCH * SEQ;
constexpr int NPROJ_IN = 7184;
constexpr int NPJ = 7168;
constexpr int C_GQ = 0, C_GK = 512, C_GV = 1024, C_GG = 2048, C_HQ = 3072, C_HF = 4096, C_HI = 5120, C_HG = 6144;
constexpr int SRC_GLR = 3072;
constexpr float EPS = 1e-6f, QSCALE = 0.08838834764831845f, INV_TAU = 1.0f / 16.0f;
constexpr int CHUNK = 64, NCHUNK = SEQ / CHUNK;

constexpr size_t MiB = 1u << 20;
constexpr size_t WS_CTL = 0, CTL_ZERO_BYTES = 128 * 1024;
constexpr size_t WS_SSQ = 64 * 1024;
constexpr size_t WS_WINT = 2 * MiB;
constexpr size_t WS_WOUTT = 30 * MiB;
constexpr size_t WS_GLR = 39 * MiB;
constexpr size_t WS_HN = 64 * MiB;
constexpr size_t WS_MIX = 128 * MiB;
constexpr size_t WS_PJ = 192 * MiB;
constexpr size_t WS_END = 416 * MiB;

constexpr int LDS_BYTES = 155648;
constexpr int QK_STRIDE = 272, L_QT = 0, L_KT = 64 * QK_STRIDE, L_VR = 2 * 64 * QK_STRIDE, L_AM = L_VR + 64 * 528, L_TOT = L_AM + 64 * 144, L_FAC = L_TOT + 8 * 128 * 4, L_SS = L_FAC + 128 * 4, L_RS = L_SS + 8 * 64 * 4, L_LG = L_RS + 64 * 4, L_KS = L_LG + 64 * 128 * 4, L_SCAN_END = L_KS + 64 * 128 * 4;
static_assert(L_SCAN_END <= LDS_BYTES - 128, "scan LDS map");

#define LAS __attribute__((address_space(3)))
typedef unsigned short bf16;
typedef float f32x4 __attribute__((ext_vector_type(4)));
typedef float f32x2 __attribute__((ext_vector_type(2)));
typedef float f32x16 __attribute__((ext_vector_type(16)));
typedef short bf16x8 __attribute__((ext_vector_type(8)));
typedef short s16x4 __attribute__((ext_vector_type(4)));
typedef unsigned u32x4 __attribute__((ext_vector_type(4)));
typedef unsigned u32x2 __attribute__((ext_vector_type(2)));
typedef __bf16 bf16x2_t __attribute__((ext_vector_type(2)));
#define MFMA32(a, b, c) __builtin_amdgcn_mfma_f32_32x32x16_bf16((a), (b), (c), 0, 0, 0)

__device__ __forceinline__ unsigned pk2(float lo, float hi) { const bf16x2_t v = __builtin_convertvector((f32x2){lo, hi}, bf16x2_t); return __builtin_bit_cast(unsigned, v); }
__device__ __forceinline__ float bf_lo(unsigned u) { return __uint_as_float(u << 16); }
__device__ __forceinline__ float bf_hi(unsigned u) { return __uint_as_float(u & 0xffff0000u); }
__device__ __forceinline__ float bf_1(unsigned short u) { return __uint_as_float(((unsigned)u) << 16); }
__device__ __forceinline__ float wave_sum(float v) {
#pragma unroll
    for (int o = 1; o < 64; o <<= 1) v += __shfl_xor(v, o);
    return v;
}
__device__ __forceinline__ float sigmoidf_(float x) { return 1.0f / (1.0f + __expf(-x)); }

#define XB_TMO      128
#define XB_XCNT(j)  (256  + 64 * (j))
#define XB_XSUB(j)  (1280 + 64 * (j))
#define XB_XGEN(j)  (2304 + 64 * (j))
#define XB_TOP      3328
#define XB_TOPGEN   3392
#define XCD_BAR_WORDS 3456
#define XB_SPIN_CAP (1u << 18)

__device__ __forceinline__ unsigned xb_ld(unsigned* p)              { return __hip_atomic_load(p, __ATOMIC_RELAXED, __HIP_MEMORY_SCOPE_AGENT); }
__device__ __forceinline__ unsigned xb_add(unsigned* p, unsigned v) { return __hip_atomic_fetch_add(p, v, __ATOMIC_RELAXED, __HIP_MEMORY_SCOPE_AGENT); }
__device__ __forceinline__ unsigned xb_xcc_id() { return (unsigned)__builtin_amdgcn_s_getreg((3 << 11) | 20) & 0xFu; }
#define XB_SPIN(cond, bar) do { unsigned _sp = 0; while (cond) { __builtin_amdgcn_s_sleep(1); \
    if ((++_sp & 255u) == 0u) { if (xb_ld(&(bar)[XB_TMO])) break; if (_sp > XB_SPIN_CAP) { atomicAdd(&(bar)[XB_TMO], 1u); break; } } } } while (0)

struct XcdBarrier {
    unsigned* bar; unsigned x;
    volatile LAS unsigned* st;
};

__device__ __forceinline__ XcdBarrier xcd_barrier_post(unsigned* bar, volatile LAS unsigned* st) {
    XcdBarrier b; b.bar = bar; b.x = xb_xcc_id(); b.st = st;
    if (threadIdx.x == 0) (void)xb_add(&bar[XB_XCNT(b.x)], 1u);
    return b;
}
__device__ __forceinline__ void xcd_barrier_complete(unsigned* bar, unsigned x, unsigned& nloc, unsigned& nx) {
    const unsigned G = gridDim.x * gridDim.y * gridDim.z;
    unsigned sum, cnt, mine, sp = 0u;
    for (;;) {
        sum = 0u; cnt = 0u; mine = 0u;
#pragma unroll
        for (unsigned j = 0; j < 16; ++j) { const unsigned c = xb_ld(&bar[XB_XCNT(j)]); sum += c; cnt += (c > 0u) ? 1u : 0u; mine = (j == x) ? c : mine; }
        if (sum == G) break;
        __builtin_amdgcn_s_sleep(1);
        if ((++sp & 255u) == 0u) { if (xb_ld(&bar[XB_TMO])) break; if (sp > XB_SPIN_CAP) { atomicAdd(&bar[XB_TMO], 1u); break; } }
    }
    nloc = mine > 0u ? mine : 1u; nx = cnt > 0u ? cnt : 1u;
}

__device__ __forceinline__ void xcd_barrier(const XcdBarrier& b) {
    asm volatile("s_waitcnt vmcnt(0)" ::: "memory");
    __syncthreads();
    if (threadIdx.x == 0) {
        unsigned* bar = b.bar;
        __builtin_amdgcn_s_waitcnt(0);
        unsigned nloc = b.st[0], nx = b.st[1];
        if (nloc == 0u) { xcd_barrier_complete(bar, b.x, nloc, nx); b.st[0] = nloc; b.st[1] = nx; }
        const unsigned old = xb_add(&bar[XB_XSUB(b.x)], 1u);
        const unsigned gen = old / nloc;
        if (old + 1u == (gen + 1u) * nloc) {
            __builtin_amdgcn_fence(__ATOMIC_RELEASE, "agent");
            asm volatile("s_waitcnt vmcnt(0)" ::: "memory");
            const unsigned og = xb_add(&bar[XB_TOP], 1u);
            const unsigned tg = og / nx;
            if (og + 1u == (tg + 1u) * nx) xb_add(&bar[XB_TOPGEN], 1u);
            else XB_SPIN(xb_ld(&bar[XB_TOPGEN]) == tg, bar);
            __builtin_amdgcn_fence(__ATOMIC_ACQUIRE, "agent");
            xb_add(&bar[XB_XGEN(b.x)], 1u);
            asm volatile("s_waitcnt vmcnt(0)" ::: "memory");
        } else {
            XB_SPIN(xb_ld(&bar[XB_XGEN(b.x)]) == gen, bar);
            __builtin_amdgcn_fence(__ATOMIC_ACQUIRE, "agent");
            asm volatile("s_waitcnt vmcnt(0)" ::: "memory");
        }
    }
    __syncthreads();
}

constexpr int CW_BAR = 4096;
constexpr int MISC_OFF = LDS_BYTES - 128;

struct Frame {
    LAS unsigned char* lds;
    int tid, lane, wave, G, bid;
    const float *x, *norm_w, *w_in, *gla_w_up, *gla_b_up, *gla_norm_w, *hgrn_lb, *hgrn_norm_w, *w_out, *final_w;
    float* out;
    bf16 *WinT, *WoutT, *HN, *MIX, *PJ;
    float *GLR, *SSQ;
    unsigned char* ws;
};

__device__ __forceinline__ void p0_transpose_item(const float* W, int ldw, int src_col, bf16* WT, int K, int dst_row, int kb, LAS float* scr, int lane) {
    const int k0 = 64 * kb;
#pragma unroll 8
    for (int i = 0; i < 32; ++i) { const int kk = 2 * i + (lane >> 5); scr[kk * 33 + (lane & 31)] = W[(size_t)(k0 + kk) * ldw + src_col + (lane & 31)]; }
    asm volatile("s_waitcnt lgkmcnt(0)" ::: "memory");
    const int c = lane & 7;
#pragma unroll
    for (int j = 0; j < 4; ++j) { const int n = (lane >> 3) + 8 * j; const LAS float* s = scr + (8 * c) * 33 + n;
        u32x4 o; o.x = pk2(s[0 * 33], s[1 * 33]); o.y = pk2(s[2 * 33], s[3 * 33]); o.z = pk2(s[4 * 33], s[5 * 33]); o.w = pk2(s[6 * 33], s[7 * 33]);
        *(u32x4*)(WT + (size_t)(dst_row + n) * K + k0 + 8 * c) = o; }
    asm volatile("s_waitcnt lgkmcnt(0)" ::: "memory");
}

__device__ __forceinline__ void p0_prologue(Frame& F) {
    const int gw = F.bid * NWAVES + F.wave, NGW = F.G * NWAVES;
    {
        LAS float* scr = (LAS float*)(F.lds + F.wave * 16384);
        constexpr int KB = DM / 64;
        constexpr int I_IN = KB * (NPJ / 32), I_OUT = KB * (DM / 32);
        for (int it = gw; it < I_IN + I_OUT; it += NGW) {
            if (it < I_IN) { const int kb = it / (NPJ / 32), nb = it % (NPJ / 32), n0 = 32 * nb; const int src = n0 < SRC_GLR ? n0 : n0 + 16;
                p0_transpose_item(F.w_in, NPROJ_IN, src, F.WinT, DM, n0, kb, scr, F.lane); }
            else { const int r = it - I_IN, kb = r / (DM / 32), nb = r % (DM / 32);
                p0_transpose_item(F.w_out, DM, 32 * nb, F.WoutT, DM, 32 * nb, kb, scr, F.lane); }
        }
    }
    __syncthreads();
    LAS float* Wt = (LAS float*)F.lds;
    for (int k = F.tid; k < DM; k += NTHREADS) {
        const f32x4* src = (const f32x4*)(F.w_in + (size_t)k * NPROJ_IN + SRC_GLR);
#pragma unroll
        for (int q = 0; q < 4; ++q) { const f32x4 v = src[q]; Wt[(4 * q + 0) * DM + k] = v[0]; Wt[(4 * q + 1) * DM + k] = v[1]; Wt[(4 * q + 2) * DM + k] = v[2]; Wt[(4 * q + 3) * DM + k] = v[3]; }
    }
    __syncthreads();
    f32x4 nw[8];
#pragma unroll
    for (int j = 0; j < 8; ++j) nw[j] = ((const f32x4*)F.norm_w)[64 * j + F.lane];
    const LAS f32x4* Wt4 = (const LAS f32x4*)Wt;
    for (int m = gw; m < M; m += NGW) {
        const f32x4* xr = (const f32x4*)(F.x + (size_t)m * DM) + F.lane;
        f32x4 v[8]; float s = 0.f;
#pragma unroll
        for (int j = 0; j < 8; ++j) { v[j] = xr[64 * j]; s += (v[j][0] * v[j][0] + v[j][1] * v[j][1]) + (v[j][2] * v[j][2] + v[j][3] * v[j][3]); }
        const float rstd = 1.0f / sqrtf(wave_sum(s) * (1.0f / DM) + EPS);
        float a[16];
#pragma unroll
        for (int c = 0; c < 16; ++c) a[c] = 0.f;
        u32x2* o8 = (u32x2*)(F.HN + (size_t)m * DM) + F.lane;
#pragma unroll
        for (int j = 0; j < 8; ++j) {
            v[j] = v[j] * rstd * nw[j];
            u32x2 w; w.x = pk2(v[j][0], v[j][1]); w.y = pk2(v[j][2], v[j][3]); o8[64 * j] = w;
            asm volatile("" ::: "memory");
#pragma unroll
            for (int c = 0; c < 16; ++c) { const f32x4 wv = Wt4[c * (DM / 4) + 64 * j + F.lane]; a[c] += (v[j][0] * wv[0] + v[j][1] * wv[1]) + (v[j][2] * wv[2] + v[j][3] * wv[3]); }
        }
        float mine = 0.f;
#pragma unroll
        for (int c = 0; c < 16; ++c) { const float t = wave_sum(a[c]); mine = (F.lane == c) ? t : mine; }
        if (F.lane < 16) F.GLR[(size_t)m * 16 + F.lane] = mine;
    }
    __syncthreads();
}

constexpr int NSEG_G = 8, NSEG_H = 4;
constexpr size_t WS_LG = WS_HN, WS_LH = WS_HN + 16 * MiB, WS_DG = WS_HN + 48 * MiB, WS_DH = WS_HN + 49 * MiB;
static_assert(16 * NSEG_G * 131072 <= 16 * MiB && 32 * NSEG_H * 65536 <= 32 * MiB, "L buffers");

__device__ __forceinline__ bf16x8 tr_frag(LAS unsigned char* img, unsigned lanebase, unsigned stride, unsigned c, unsigned ks) {
    const unsigned a0 = lanebase + (16 * ks) * stride + 64 * c;
    const s16x4 lo = __builtin_amdgcn_ds_read_tr16_b64_v4i16((LAS s16x4*)(img + a0));
    const s16x4 hi = __builtin_amdgcn_ds_read_tr16_b64_v4i16((LAS s16x4*)(img + a0 + 4 * stride));
    return __builtin_shufflevector(lo, hi, 0, 1, 2, 3, 4, 5, 6, 7);
}

template <int GLA, int PASSB>
__device__ __forceinline__ void scan_item(Frame& F, const int b, const int h, const int seg) {
    constexpr int dv = GLA ? 256 : 128, nmw = dv / 32, NSEG = GLA ? NSEG_G : NSEG_H, NC = NCHUNK / NSEG;
    constexpr unsigned vstride = 2 * dv + 16;
    constexpr int NVL = 64 * (dv / 8) / NTHREADS;
    constexpr int CPR = dv / 8, RPP = NTHREADS / CPR;
    constexpr int OS = dv * 4;
    const int tid = F.tid, lane = F.lane, wave = F.wave;
    LAS unsigned char* lds = F.lds;
    LAS unsigned char* QT = lds + L_QT; LAS unsigned char* KT = lds + L_KT; LAS unsigned char* VR = lds + L_VR; LAS unsigned char* AM = lds + L_AM;
    LAS float* TOT = (LAS float*)(lds + L_TOT); LAS float* FAC = (LAS float*)(lds + L_FAC); LAS float* NW = (LAS float*)(lds + L_SS);
    LAS float* LG = (LAS float*)(lds + L_LG); LAS float* KS = (LAS float*)(lds + L_KS);
    LAS unsigned char* O32 = lds + (GLA ? L_LG : L_KS);
    const int qcol = GLA ? C_GQ + h * 128 : C_HQ + h * 128, kcol = GLA ? C_GK + h * 128 : C_HF + h * 128;
    const int vcol = GLA ? C_GV + h * 256 : C_HI + h * 128, gcol = GLA ? C_GG + h * 256 : C_HG + h * 128;
    const int mcol = GLA ? h * 256 : 1024 + h * 128;
    const float* normw = GLA ? F.gla_norm_w + h * 256 : F.hgrn_norm_w + h * 128;
    const int dp = tid & 63, d0 = 2 * dp;
    const int item = GLA ? (b * 4 + h) * NSEG + seg : (b * 8 + h) * NSEG + seg;
    float* Lbase = (float*)(F.ws + (GLA ? WS_LG : WS_LH)); float* Dbase = (float*)(F.ws + (GLA ? WS_DG : WS_DH));
    constexpr int LSZ = 128 * dv;
    float wub[8], bub = 0.f, lb0 = 0.f, lb1 = 0.f;
    if (GLA) {
        const int col = h * 128 + 32 * (wave & 3) + (lane & 31);
#pragma unroll
        for (int s = 0; s < 8; ++s) wub[s] = F.gla_w_up[(size_t)(2 * s + (lane >> 5)) * 512 + col];
        bub = F.gla_b_up[col];
    } else {
#pragma unroll
        for (int s = 0; s < 8; ++s) wub[s] = 0.f;
        const f32x2 l0 = *(const f32x2*)(F.hgrn_lb + h * 128 + d0), l1 = *(const f32x2*)(F.hgrn_lb + 1024 + h * 128 + d0);
        lb0 = __builtin_amdgcn_rcpf(1.0f + __expf(l1[0] - l0[0])); lb1 = __builtin_amdgcn_rcpf(1.0f + __expf(l1[1] - l0[1]));
    }
    if (PASSB && tid < dv) NW[tid] = normw[tid];
    float elp0 = 1.f, elp1 = 1.f, dsum0 = 0.f, dsum1 = 0.f;
    const unsigned r = lane & 31, hh = lane >> 5;
    const unsigned tq = (lane & 15) >> 2, tp = lane & 3, tblk = (lane >> 4) & 1;
    const unsigned trk = (8 * hh + tq) * QK_STRIDE + 32 * tblk + 8 * tp, trv = (8 * hh + tq) * vstride + 32 * tblk + 8 * tp;
    const size_t row0 = (size_t)b * SEQ + (size_t)seg * NC * CHUNK;

    f32x16 S[4];
#pragma unroll
    for (int i = 0; i < 4; ++i)
#pragma unroll
        for (int j = 0; j < 16; ++j) S[i][j] = 0.f;
    if (PASSB && wave < nmw) {
        for (int sp = 0; sp < seg; ++sp) {
            const float* Lp = Lbase + (size_t)(item - seg + sp) * LSZ; const float* Dp = Dbase + (size_t)(item - seg + sp) * 128;
#pragma unroll
            for (int db = 0; db < 4; ++db)
#pragma unroll
                for (int g4 = 0; g4 < 4; ++g4) { const f32x4 lv = *(const f32x4*)(Lp + (((wave * 4 + db) * 4 + g4) * 64 + lane) * 4); const f32x4 dvv = *(const f32x4*)(Dp + 32 * db + 8 * g4 + 4 * hh);
#pragma unroll
                    for (int e = 0; e < 4; ++e) S[db][4 * g4 + e] = S[db][4 * g4 + e] * dvv[e] + lv[e]; }
        }
    }
    const __amdgpu_buffer_rsrc_t rs_pj = __builtin_amdgcn_make_buffer_rsrc((void*)F.PJ, 0, (int)((size_t)M * NPJ * 2), 0x00020000);
    const __amdgpu_buffer_rsrc_t rs_glr = __builtin_amdgcn_make_buffer_rsrc((void*)F.GLR, 0, M * 16 * 4, 0x00020000);
    const __amdgpu_buffer_rsrc_t rs_mix = __builtin_amdgcn_make_buffer_rsrc((void*)F.MIX, 0, (int)((size_t)M * DM * 2), 0x00020000);
    const unsigned vo_qk = 4 * dp, vo_g = ((lane & 31) * 16 + (lane >> 5)) * 4, vo_v = (tid / CPR) * (NPJ * 2) + (tid % CPR) * 16, vo_m = (tid / CPR) * (DM * 2) + (tid % CPR) * 16;
    unsigned nq[8], nk[8]; float ng[8]; u32x4 vn[NVL], gt[NVL];
#define SCAN_PREFETCH(T0) do { const unsigned _sb = ((unsigned)(T0) + 8 * wave) * (NPJ * 2); \
        _Pragma("unroll") for (int i = 0; i < 8; ++i) { nk[i] = __builtin_amdgcn_raw_buffer_load_b32(rs_pj, vo_qk, _sb + i * (NPJ * 2) + kcol * 2, 0); if (PASSB) nq[i] = __builtin_amdgcn_raw_buffer_load_b32(rs_pj, vo_qk, _sb + i * (NPJ * 2) + qcol * 2, 0); } \
        if (GLA) { const unsigned _sg = ((unsigned)(T0) + 32 * (wave >> 2)) * 64; _Pragma("unroll") for (int s = 0; s < 8; ++s) ng[s] = __uint_as_float(__builtin_amdgcn_raw_buffer_load_b32(rs_glr, vo_g, _sg + 8 * s, 0)); } \
        { const unsigned _sv = (unsigned)(T0) * (NPJ * 2) + vcol * 2; _Pragma("unroll") for (int j = 0; j < NVL; ++j) vn[j] = __builtin_amdgcn_raw_buffer_load_b128(rs_pj, vo_v, _sv + j * (RPP * NPJ * 2), 0); } \
        } while (0)
#pragma unroll
    for (int i = 0; i < 8; ++i) { nq[i] = 0u; ng[i] = 0.f; }
    SCAN_PREFETCH(row0);

    for (int c = 0; c < NC; ++c) {
        const size_t t0 = row0 + (size_t)c * CHUNK;
        if (GLA) {
            f32x16 z;
#pragma unroll
            for (int j = 0; j < 16; ++j) z[j] = 0.f;
#pragma unroll
            for (int s = 0; s < 8; ++s) z = __builtin_amdgcn_mfma_f32_32x32x2f32(ng[s], wub[s], z, 0, 0, 0);
#pragma unroll
            for (int reg = 0; reg < 16; ++reg) { const float zz = z[reg] + bub; const int row = 32 * (wave >> 2) + (reg & 3) + 8 * (reg >> 2) + 4 * (lane >> 5);
                LG[row * 128 + 32 * (wave & 3) + (lane & 31)] = (fminf(zz, 0.f) - __logf(1.0f + __expf(-fabsf(zz)))) * INV_TAU; }
            __syncthreads();
        }
        {
            float cum0 = 0.f, cum1 = 0.f;
#pragma unroll
            for (int i = 0; i < 8; ++i) {
                LAS f32x2* lgp = (LAS f32x2*)(LG + (8 * wave + i) * 128 + d0);
                float lg0, lg1;
                if (GLA) { const f32x2 lgv = *lgp; lg0 = lgv[0]; lg1 = lgv[1]; }
                else {
                    const unsigned kv = nk[i];
                    const float s0 = __builtin_amdgcn_rcpf(1.0f + __expf(-bf_lo(kv))), s1 = __builtin_amdgcn_rcpf(1.0f + __expf(-bf_hi(kv)));
                    const float f0 = lb0 + (1.0f - lb0) * s0, f1 = lb1 + (1.0f - lb1) * s1;
                    lg0 = __logf(f0); lg1 = __logf(f1);
                    *(LAS f32x2*)(KS + (8 * wave + i) * 128 + d0) = (f32x2){1.0f - f0, 1.0f - f1};
                }
                cum0 += lg0; cum1 += lg1; *lgp = (f32x2){cum0, cum1};
            }
            *(LAS f32x2*)(TOT + wave * 128 + d0) = (f32x2){cum0, cum1};
        }
        __syncthreads();
        {
            float off0 = 0.f, off1 = 0.f, r0 = 0.f, r1 = 0.f, bl0 = 0.f, bl1 = 0.f;
#pragma unroll
            for (int g = 0; g < 8; ++g) { const f32x2 tv = *(const LAS f32x2*)(TOT + g * 128 + d0);
                if (g < wave) { off0 += tv[0]; off1 += tv[1]; } if (g < 4) { r0 += tv[0]; r1 += tv[1]; } bl0 += tv[0]; bl1 += tv[1]; }
            off0 -= r0; off1 -= r1;
#pragma unroll
            for (int i = 0; i < 8; ++i) {
                const f32x2 cv = *(const LAS f32x2*)(LG + (8 * wave + i) * 128 + d0);
                const float e0 = __expf(off0 + cv[0]), e1 = __expf(off1 + cv[1]);
                const unsigned o = (8 * wave + i) * QK_STRIDE + 4 * dp;
                if (PASSB) *(LAS unsigned*)(QT + o) = pk2(bf_lo(nq[i]) * QSCALE * e0, bf_hi(nq[i]) * QSCALE * e1);
                float kk0, kk1;
                if (GLA) { kk0 = bf_lo(nk[i]); kk1 = bf_hi(nk[i]); } else { const f32x2 kv = *(const LAS f32x2*)(KS + (8 * wave + i) * 128 + d0); kk0 = kv[0]; kk1 = kv[1]; }
                *(LAS unsigned*)(KT + o) = pk2(kk0 * __builtin_amdgcn_rcpf(e0), kk1 * __builtin_amdgcn_rcpf(e1));
            }
            if (wave == 0) { *(LAS f32x2*)(FAC + d0) = (f32x2){__expf(r0) * elp0, __expf(r1) * elp1}; elp0 = __expf(bl0 - r0); elp1 = __expf(bl1 - r1); dsum0 += bl0; dsum1 += bl1; }
        }
#pragma unroll
        for (int j = 0; j < NVL; ++j) *(LAS u32x4*)(VR + (tid / CPR + RPP * j) * vstride + 16 * (tid % CPR)) = vn[j];
        if (PASSB) { const unsigned _sv = (unsigned)t0 * (NPJ * 2) + gcol * 2;
#pragma unroll
            for (int j = 0; j < NVL; ++j) gt[j] = __builtin_amdgcn_raw_buffer_load_b128(rs_pj, vo_v, _sv + j * (RPP * NPJ * 2), 0); }
        if (c + 1 < NC) SCAN_PREFETCH(t0 + CHUNK);
        __syncthreads();
        f32x16 o[2];
        if (PASSB) {
            const int aw = GLA ? wave : wave - 4;
            if (aw >= 0 && aw < 3) {
                const int it = aw > 0, jt = aw > 1;
                f32x16 a;
#pragma unroll
                for (int j = 0; j < 16; ++j) a[j] = 0.f;
#pragma unroll
                for (int s = 0; s < 8; ++s) { const bf16x8 qa = *(const LAS bf16x8*)(QT + (32 * it + r) * QK_STRIDE + 32 * s + 16 * hh); const bf16x8 kb = *(const LAS bf16x8*)(KT + (32 * jt + r) * QK_STRIDE + 32 * s + 16 * hh); a = MFMA32(qa, kb, a); }
                const int jj = 32 * jt + r;
#pragma unroll
                for (int reg = 0; reg < 16; ++reg) { const int ii = 32 * it + (reg & 3) + 8 * (reg >> 2) + 4 * hh; const float v = (jj <= ii) ? a[reg] : 0.f;
                    *(LAS unsigned short*)(AM + ii * 144 + jj * 2) = (unsigned short)(pk2(v, 0.f) & 0xffffu); }
            }
        }
        if (wave < nmw) {
#pragma unroll
            for (int i = 0; i < 2; ++i)
#pragma unroll
                for (int j = 0; j < 16; ++j) o[i][j] = 0.f;
#pragma unroll
            for (int db = 0; db < 4; ++db) {
                asm volatile("" ::: "memory");
#pragma unroll
                for (int g4 = 0; g4 < 4; ++g4) { const f32x4 fv = *(const LAS f32x4*)(FAC + 32 * db + 8 * g4 + 4 * hh);
#pragma unroll
                    for (int e = 0; e < 4; ++e) S[db][4 * g4 + e] *= fv[e]; }
                if (PASSB) {
#pragma unroll
                    for (int s = 0; s < 2; ++s) {
                        u32x4 pb; pb.x = pk2(S[db][8 * s + 0], S[db][8 * s + 1]); pb.y = pk2(S[db][8 * s + 2], S[db][8 * s + 3]); pb.z = pk2(S[db][8 * s + 4], S[db][8 * s + 5]); pb.w = pk2(S[db][8 * s + 6], S[db][8 * s + 7]);
                        const bf16x8 bs = __builtin_bit_cast(bf16x8, pb);
#pragma unroll
                        for (int it = 0; it < 2; ++it) {
                            const LAS unsigned char* qp = QT + (32 * it + r) * QK_STRIDE + 64 * db + 32 * s + 8 * hh; const s16x4 lo = *(const LAS s16x4*)qp, hi = *(const LAS s16x4*)(qp + 16);
                            o[it] = MFMA32(__builtin_shufflevector(lo, hi, 0, 1, 2, 3, 4, 5, 6, 7), bs, o[it]);
                        }
                    }
                }
            }
        }
        if (PASSB) __syncthreads();
        if (wave < nmw) {
            bf16x8 vf[4];
#pragma unroll
            for (int ks = 0; ks < 4; ++ks) vf[ks] = tr_frag(VR, trv, vstride, wave, ks);
            if (PASSB) {
#pragma unroll
                for (int it = 0; it < 2; ++it)
#pragma unroll
                    for (int ks = 0; ks < 4; ++ks) { if (it == 0 && ks >= 2) continue;
                        const bf16x8 af = *(const LAS bf16x8*)(AM + (32 * it + r) * 144 + (16 * ks + 8 * hh) * 2); o[it] = MFMA32(af, vf[ks], o[it]); }
#pragma unroll
                for (int it = 0; it < 2; ++it)
#pragma unroll
                    for (int reg = 0; reg < 16; ++reg) *(LAS float*)(O32 + (32 * it + (reg & 3) + 8 * (reg >> 2) + 4 * hh) * OS + (32 * wave + r) * 4) = o[it][reg];
            }
#pragma unroll
            for (int db = 0; db < 4; ++db) {
                asm volatile("" ::: "memory");
#pragma unroll
                for (int ks = 0; ks < 4; ++ks) { const bf16x8 kf = tr_frag(KT, trk, QK_STRIDE, db, ks); S[db] = MFMA32(kf, vf[ks], S[db]); } }
            asm volatile("" ::: "memory");
        }
        if (PASSB) {
            __syncthreads();
#pragma unroll
            for (int j = 0; j < NVL; ++j) {
                const int row = tid / CPR + RPP * j, ch = tid % CPR;
                const f32x4 oa = *(const LAS f32x4*)(O32 + row * OS + ch * 32), ob = *(const LAS f32x4*)(O32 + row * OS + ch * 32 + 16);
                float sq = (oa[0] * oa[0] + oa[1] * oa[1]) + (oa[2] * oa[2] + oa[3] * oa[3]) + (ob[0] * ob[0] + ob[1] * ob[1]) + (ob[2] * ob[2] + ob[3] * ob[3]);
#pragma unroll
                for (int m = 1; m < CPR; m <<= 1) sq += __shfl_xor(sq, m);
                const float rstd = __builtin_amdgcn_rsqf(sq * (1.0f / dv) + EPS);
                const f32x4 wa = *(const LAS f32x4*)(NW + 8 * ch), wb = *(const LAS f32x4*)(NW + 8 * ch + 4);
                const u32x4 g = gt[j]; float res[8];
                const float gv[8] = {bf_lo(g.x), bf_hi(g.x), bf_lo(g.y), bf_hi(g.y), bf_lo(g.z), bf_hi(g.z), bf_lo(g.w), bf_hi(g.w)};
#pragma unroll
                for (int e = 0; e < 4; ++e) { res[e] = oa[e] * rstd * wa[e] * (gv[e] * __builtin_amdgcn_rcpf(1.0f + __expf(-gv[e]))); res[4 + e] = ob[e] * rstd * wb[e] * (gv[4 + e] * __builtin_amdgcn_rcpf(1.0f + __expf(-gv[4 + e]))); }
                u32x4 w; w.x = pk2(res[0], res[1]); w.y = pk2(res[2], res[3]); w.z = pk2(res[4], res[5]); w.w = pk2(res[6], res[7]);
                __builtin_amdgcn_raw_buffer_store_b128(w, rs_mix, vo_m, ((unsigned)t0 + RPP * j) * (DM * 2) + mcol * 2, 0);
            }
            __syncthreads();
        }
    }
    if (!PASSB) {
        __syncthreads();
        if (wave == 0) { *(LAS f32x2*)(FAC + d0) = (f32x2){elp0, elp1}; *(f32x2*)(Dbase + (size_t)item * 128 + d0) = (f32x2){__expf(dsum0), __expf(dsum1)}; }
        __syncthreads();
        if (wave < nmw) {
            float* Lp = Lbase + (size_t)item * LSZ;
#pragma unroll
            for (int db = 0; db < 4; ++db)
#pragma unroll
                for (int g4 = 0; g4 < 4; ++g4) { const f32x4 fv = *(const LAS f32x4*)(FAC + 32 * db + 8 * g4 + 4 * hh); f32x4 ov;
#pragma unroll
                    for (int e = 0; e < 4; ++e) ov[e] = S[db][4 * g4 + e] * fv[e];
                    *(f32x4*)(Lp + (((wave * 4 + db) * 4 + g4) * 64 + lane) * 4) = ov; }
        }
    }
    __syncthreads();
#undef SCAN_PREFETCH
}

__device__ __forceinline__ void p2a_scan(Frame& F) {
    constexpr int NG = 16 * (NSEG_G - 1), NH = 32 * (NSEG_H - 1);
    static_assert(NG + NH <= 256, "pass A items");
    const int it = F.bid;
    if (it < NG) { const int bh = it / (NSEG_G - 1), seg = it % (NSEG_G - 1); scan_item<1, 0>(F, bh >> 2, bh & 3, seg); }
    else if (it < NG + NH) { const int j = it - NG, bh = j / (NSEG_H - 1), seg = j % (NSEG_H - 1); scan_item<0, 0>(F, bh >> 3, bh & 7, seg); }
}
__device__ __forceinline__ void p2b_scan(Frame& F) {
    constexpr int NG = 16 * NSEG_G, NH = 32 * NSEG_H;
    static_assert(NG + NH <= 256, "pass B items");
    const int it = F.bid;
    if (it < NG) { const int bh = it / NSEG_G, seg = it % NSEG_G; scan_item<1, 1>(F, bh >> 2, bh & 3, seg); }
    else if (it < NG + NH) { const int j = it - NG, bh = j / NSEG_H, seg = j % NSEG_H; scan_item<0, 1>(F, bh >> 3, bh & 7, seg); }
}

__device__ __forceinline__ void p4_final(Frame& F) {
    const int gw = F.bid * NWAVES + F.wave, NGW = F.G * NWAVES;
    f32x4 fw[8];
#pragma unroll
    for (int j = 0; j < 8; ++j) fw[j] = ((const f32x4*)F.final_w)[64 * j + F.lane];
    for (int m = gw; m < M; m += NGW) {
        const float rstd = 1.0f / sqrtf(F.SSQ[m] * (1.0f / DM) + EPS);
        f32x4* orow = (f32x4*)(F.out + (size_t)m * DM) + F.lane;
        f32x4 v[8];
#pragma unroll
        for (int j = 0; j < 8; ++j) v[j] = orow[64 * j];
#pragma unroll
        for (int j = 0; j < 8; ++j) orow[64 * j] = v[j] * rstd * fw[j];
    }
}

struct Args { const float* in[10]; float* out; unsigned char* ws; int ph_lo, ph_hi; };
__global__ void __launch_bounds__(NTHREADS, 2) mk_fwd(Args args) {
    extern __shared__ __attribute__((aligned(16))) unsigned char lds_raw[];
    Frame F;
    F.lds = (LAS unsigned char*)lds_raw;
    F.tid = threadIdx.x; F.lane = F.tid & 63; F.wave = __builtin_amdgcn_readfirstlane(F.tid >> 6);
    F.G = gridDim.x; F.bid = blockIdx.x;
    F.x = args.in[0]; F.norm_w = args.in[1]; F.w_in = args.in[2]; F.gla_w_up = args.in[3]; F.gla_b_up = args.in[4]; F.gla_norm_w = args.in[5];
    F.hgrn_lb = args.in[6]; F.hgrn_norm_w = args.in[7]; F.w_out = args.in[8]; F.final_w = args.in[9]; F.out = args.out;
    unsigned char* ws = args.ws; F.ws = ws;
    F.WinT = (bf16*)(ws + WS_WINT); F.WoutT = (bf16*)(ws + WS_WOUTT); F.HN = (bf16*)(ws + WS_HN); F.MIX = (bf16*)(ws + WS_MIX); F.PJ = (bf16*)(ws + WS_PJ);
    F.GLR = (float*)(ws + WS_GLR); F.SSQ = (float*)(ws + WS_SSQ);
    const int lo = args.ph_lo, hi = args.ph_hi;
#if MK_ONE_LAUNCH
    if (F.tid < 32) ((LAS unsigned*)(F.lds + MISC_OFF))[F.tid] = 0u;
    __syncthreads();
    const XcdBarrier xbar = xcd_barrier_post((unsigned*)(ws + WS_CTL) + CW_BAR, (volatile LAS unsigned*)(F.lds + MISC_OFF));
#endif
#ifndef MK_PHASE_MASK
#define MK_PHASE_MASK 63
#endif
#define IN(k) (((MK_PHASE_MASK >> (k)) & 1) && lo <= (k) && (k) < hi)
#define BOTH(k) (IN(k) && IN((k) + 1))
#if MK_ONE_LAUNCH
#define GRID_BAR() do { xcd_barrier(xbar); } while (0)
#else
#define GRID_BAR() do { } while (0)
#endif
#ifndef MK_DUP
#define MK_DUP -1
#endif
    if (IN(0)) { p0_prologue(F); if (MK_DUP == 0) { GRID_BAR(); p0_prologue(F); } if (BOTH(0)) GRID_BAR(); }
    if (IN(1)) {
        pg8::Gemm g{F.HN, F.WinT, M, NPJ, DM}; pg8::StaticOrder S; S.init(M, NPJ, F.G, F.bid);
        pg8::EpiBf16<0> E{F.PJ, NPJ, nullptr, 0, 0, 1.f};
        pg8::gemm_phase<pg8::EpiBf16<0>, pg8::StaticOrder, PG8_ALIGN, PG8_SP2>(F.lds, g, S, E);
        if (MK_DUP == 1) { GRID_BAR(); pg8::gemm_phase<pg8::EpiBf16<0>, pg8::StaticOrder, PG8_ALIGN, PG8_SP2>(F.lds, g, S, E); }
        if (BOTH(1)) GRID_BAR();
    }
    if (IN(2)) { p2a_scan(F); if (MK_DUP == 2) { GRID_BAR(); p2a_scan(F); } if (BOTH(2)) GRID_BAR(); }
    if (IN(3)) { p2b_scan(F); if (MK_DUP == 3) { GRID_BAR(); p2b_scan(F); } if (BOTH(3)) GRID_BAR(); }
    if (IN(4)) {
        pg8::Gemm g{F.MIX, F.WoutT, M, DM, DM}; pg8::StaticOrder S; S.init(M, DM, F.G, F.bid);
        pg8::EpiResid E{F.x, F.out, DM, F.SSQ};
        pg8::gemm_phase<pg8::EpiResid, pg8::StaticOrder, PG8_ALIGN, PG8_SP2>(F.lds, g, S, E);
        if (BOTH(4)) GRID_BAR();
    }
    if (IN(5)) { p4_final(F); }
#undef IN
#undef BOTH
}

extern "C" void kernel_launch(void* const* d_in, const int* in_sizes, int n_in, void* d_out, int out_size, void* d_ws, size_t ws_size, hipStream_t stream) {
    static int grid = 0;
    if (grid == 0) {
        if (n_in != 10 || in_sizes[0] != M * DM || out_size != M * DM || ws_size < WS_END) { fprintf(stderr, "kernel_launch: unexpected shapes (n_in %d, in0 %d, out %d, ws %zu)\n", n_in, n_in > 0 ? in_sizes[0] : -1, out_size, ws_size); grid = -1; return; }
        int dev = 0, cus = 0, per_cu = 0;
        if (hipGetDevice(&dev) != hipSuccess || hipDeviceGetAttribute(&cus, hipDeviceAttributeMultiprocessorCount, dev) != hipSuccess) { grid = -1; return; }
        if (hipFuncSetAttribute((const void*)mk_fwd, hipFuncAttributeMaxDynamicSharedMemorySize, LDS_BYTES) != hipSuccess) { fprintf(stderr, "kernel_launch: hipFuncSetAttribute failed\n"); grid = -1; return; }
        if (hipOccupancyMaxActiveBlocksPerMultiprocessor(&per_cu, (const void*)mk_fwd, NTHREADS, LDS_BYTES) != hipSuccess || per_cu < 1) { fprintf(stderr, "kernel_launch: occupancy query says %d blocks per CU\n", per_cu); grid = -1; return; }
        (void)hipGetLastError();
        grid = cus;
        if (grid < 256) { fprintf(stderr, "kernel_launch: %d CUs; the scan phases need 256 workgroups\n", grid); grid = -1; return; }
        grid = 256;
    }
    if (grid < 0) return;
    (void)hipMemsetAsync((char*)d_ws + WS_CTL, 0, CTL_ZERO_BYTES, stream);
    Args a{};
    for (int i = 0; i < 10; ++i) a.in[i] = (const float*)d_in[i];
    a.out = (float*)d_out; a.ws = (unsigned char*)d_ws;
#if MK_ONE_LAUNCH
    a.ph_lo = 0; a.ph_hi = 6;
    void* kargs[] = {&a};
    hipError_t e = hipLaunchCooperativeKernel((const void*)mk_fwd, dim3(grid), dim3(NTHREADS), kargs, LDS_BYTES, stream);
    if (e != hipSuccess) fprintf(stderr, "kernel_launch: cooperative launch failed: %s (grid %d)\n", hipGetErrorString(e), grid);
#else
    for (int p = 0; p < 6; ++p) { a.ph_lo = p; a.ph_hi = p + 1; hipLaunchKernelGGL(mk_fwd, dim3(grid), dim3(NTHREADS), LDS_BYTES, stream, a); }
#endif
}
```

```cpp
#include <hip/hip_runtime.h>
#include <hip/hip_cooperative_groups.h>
#include <cstdio>
#include <cstdint>
namespace cg = cooperative_groups;
#ifndef MK_ONE_LAUNCH
#define MK_ONE_LAUNCH 1
#endif
namespace pg8 {
#define PG8_LAS __attribute__((address_space(3)))
typedef unsigned short bf16_t;
typedef short bf16x8 __attribute__((ext_vector_type(8)));
typedef float f32x4 __attribute__((ext_vector_type(4)));
typedef unsigned u32x4 __attribute__((ext_vector_type(4)));
constexpr int BM = 256, BK = 64, HALF = 128, HTB = HALF * BK * 2  , STAGE_BYTES = 8 * HTB, NXCD = 8, WGM = 8;

__host__ __device__ __forceinline__ int lds_byte(int r, int c) { const int st = (r >> 4) * 2 + (c >> 5), rr = r & 15, cc = c & 31, ob = rr * 64 + cc * 2; return st * 1024 + (ob ^ (((ob >> 9) & 1) << 5)); }
__host__ __device__ __forceinline__ void stage_rc(int b, int& R, int& C) { const int st = b / 1024, sb = b % 1024, swz = sb ^ (((sb >> 9) & 1) << 5); R = (st >> 1) * 16 + swz / 64; C = (st & 1) * 32 + (swz % 64) / 2; }
__host__ __device__ __forceinline__ int perm32(int rho) { const int n = rho >> 4, i = rho & 15; return 8 * (i >> 2) + 4 * n + (i & 3); }

struct Unit { int pm, pn; };
struct Gemm { const bf16_t* A; const bf16_t* Bt; int M, N, K; };

struct StaticOrder {
    int nM, nN, nwg, G, c;
    __host__ __device__ void init(int M, int N, int G_, int c_) { nM = M / BM; nN = N / BM; nwg = nM * nN; G = G_; c = c_; }
    __host__ __device__ bool next(int i, Unit& u) const {
        const long L = (long)i * G + c; if (L >= nwg) return false;
        int wgid = (int)L; { const int q = nwg / NXCD, r = nwg % NXCD, xcd = wgid % NXCD, off = wgid / NXCD; wgid = (xcd < r ? xcd * (q + 1) : r * (q + 1) + (xcd - r) * q) + off; }
        const int nig = WGM * nN, gid = wgid / nig, fm = gid * WGM, gsz = (nM - fm) < WGM ? (nM - fm) : WGM;
        u.pm = fm + ((wgid % nig) % gsz); u.pn = (wgid % nig) / gsz; return true;
    }
    __device__ __forceinline__ void a_ready(const Unit&) const {}
    __device__ __forceinline__ void done(const Unit&) const {}
};

__device__ __forceinline__ unsigned cvt_pk_bf16(float lo, float hi) { unsigned r; asm volatile("v_cvt_pk_bf16_f32 %0, %1, %2" : "=v"(r) : "v"(lo), "v"(hi)); return r; }
typedef float f32x2 __attribute__((ext_vector_type(2)));
__device__ __forceinline__ f32x2 gelu_pk(f32x2 v) {
    const f32x2 av = __builtin_elementwise_abs(v), d = av * 0.2316418882f + 1.0f;
    f32x2 t; t.x = __builtin_amdgcn_rcpf(d.x); t.y = __builtin_amdgcn_rcpf(d.y);
    f32x2 q = t * 0.5307027145f + (-0.7265760135f); q = q * t + 0.7107068705f; q = q * t + (-0.142248368f); q = q * t + 0.127414796f; q = q * t;
    const f32x2 s = (v * v) * (-0.72134752044f);
    f32x2 e; e.x = __builtin_amdgcn_exp2f(s.x); e.y = __builtin_amdgcn_exp2f(s.y);
    const f32x2 m = v * (q * e), r = v - m;
    f32x2 o; o.x = v.x < 0.f ? m.x : r.x; o.y = v.y < 0.f ? m.y : r.y; return o;
}

template <int ACT  > struct EpiBf16 {
    static constexpr bool PERM = true, AFTER_DRAIN = false; static_assert(ACT == 0 || ACT == 1, "EpiBf16: ACT is 0 (none) or 1 (gelu_pk)");
    bf16_t* O; int ldc; const float* bias; int split_cols; size_t split_stride; float scale0;
    __device__ __forceinline__ void operator()(const f32x4 (&acc)[2][2][4][2], const Unit& u, int wr, int wc, int fr, int fq) const {
        const int row0 = u.pm * BM + wr * 64 + fr; int colt = u.pn * BM; bf16_t* base = O;
        float sc = 1.f; if (split_cols) { const int t = colt / split_cols; base += (size_t)t * split_stride; colt -= t * split_cols; if (t == 0) sc = scale0; }
        const int col0 = colt + wc * 32 + 8 * fq, bcol0 = u.pn * BM + wc * 32 + 8 * fq;
        f32x4 bv[2][2];
#pragma unroll
        for (int bj = 0; bj < 2; ++bj)
#pragma unroll
            for (int n = 0; n < 2; ++n) bv[bj][n] = bias ? *(const f32x4*)(bias + bcol0 + bj * HALF + 4 * n) : (f32x4){0.f, 0.f, 0.f, 0.f};
#pragma unroll
        for (int ai = 0; ai < 2; ++ai)
#pragma unroll
            for (int m = 0; m < 4; ++m) { bf16_t* rowp = base + (size_t)(row0 + ai * HALF + m * 16) * ldc + col0;
#pragma unroll
                for (int bj = 0; bj < 2; ++bj) { f32x4 v0 = acc[ai][bj][m][0] + bv[bj][0], v1 = acc[ai][bj][m][1] + bv[bj][1];
                    if (ACT == 1) { f32x2 a = gelu_pk((f32x2){v0[0], v0[1]}), b = gelu_pk((f32x2){v0[2], v0[3]}), c = gelu_pk((f32x2){v1[0], v1[1]}), d = gelu_pk((f32x2){v1[2], v1[3]});
                        v0 = (f32x4){a.x, a.y, b.x, b.y}; v1 = (f32x4){c.x, c.y, d.x, d.y}; }
                    v0 = v0 * sc; v1 = v1 * sc; u32x4 w; w.x = cvt_pk_bf16(v0[0], v0[1]); w.y = cvt_pk_bf16(v0[2], v0[3]); w.z = cvt_pk_bf16(v1[0], v1[1]); w.w = cvt_pk_bf16(v1[2], v1[3]);
                    *(u32x4*)(rowp + bj * HALF) = w; } }
    }
};
struct EpiPJ {
    static constexpr bool PERM = true, AFTER_DRAIN = false;
    bf16_t* O; int ntn;
    __device__ __forceinline__ void operator()(const f32x4 (&acc)[2][2][4][2], const Unit& u, int wr, int wc, int fr, int fq) const {
        bf16_t* base = O + ((size_t)(u.pm * ntn + u.pn) << 16) + (wr * 64 + fr) * 256 + wc * 32 + 8 * fq;
#pragma unroll
        for (int ai = 0; ai < 2; ++ai)
#pragma unroll
            for (int m = 0; m < 4; ++m) { bf16_t* rowp = base + (ai * HALF + m * 16) * 256;
#pragma unroll
                for (int bj = 0; bj < 2; ++bj) { const f32x4 v0 = acc[ai][bj][m][0], v1 = acc[ai][bj][m][1];
                    u32x4 w; w.x = cvt_pk_bf16(v0[0], v0[1]); w.y = cvt_pk_bf16(v0[2], v0[3]); w.z = cvt_pk_bf16(v1[0], v1[1]); w.w = cvt_pk_bf16(v1[2], v1[3]);
                    *(u32x4*)(rowp + bj * HALF) = w; } }
    }
};
struct PanelOrder {
    int c;
    __device__ __forceinline__ bool next(int i, Unit& u) const { if (i >= 2) return false; const int x = c & 7, k = c >> 3; u.pm = 32 * i + 4 * x + (k & 3); u.pn = k >> 2; return true; }
    __device__ __forceinline__ void a_ready(const Unit&) const {}
    __device__ __forceinline__ void done(const Unit&) const {}
};
struct EpiFinal {
    static constexpr bool PERM = false, AFTER_DRAIN = false;
    const float* base; float* out; const float* fw; float* xch; unsigned* cnt; PG8_LAS unsigned char* lds;
    __device__ __forceinline__ void operator()(f32x4 (&acc)[2][2][4][2], const Unit& u, int wr, int wc, int fr, int fq) const {
        const int tid = threadIdx.x, wid = __builtin_amdgcn_readfirstlane(tid >> 6), lane = tid & 63;
        PG8_LAS float* P = (PG8_LAS float*)lds; PG8_LAS float* R = (PG8_LAS float*)(lds + 4096);
        const int row0 = u.pm * BM + wr * 64 + fr, col0 = u.pn * BM + wc * 32 + 4 * fq;
#pragma unroll
        for (int ai = 0; ai < 2; ++ai)
#pragma unroll
            for (int m = 0; m < 4; ++m) { const size_t off = (size_t)(row0 + ai * HALF + m * 16) * 2048 + col0; float s = 0.f;
#pragma unroll
                for (int bj = 0; bj < 2; ++bj)
#pragma unroll
                    for (int n = 0; n < 2; ++n) { const f32x4 v = *(const f32x4*)(base + off + bj * HALF + n * 16) + acc[ai][bj][m][n]; acc[ai][bj][m][n] = v; s += (v[0] * v[0] + v[1] * v[1]) + (v[2] * v[2] + v[3] * v[3]); }
                s += __shfl_xor(s, 16); s += __shfl_xor(s, 32);
                if (fq == 0) P[(ai * HALF + wr * 64 + m * 16 + fr) * 4 + wc] = s;
                asm volatile("" ::: "memory"); }
        asm volatile("s_waitcnt lgkmcnt(0)" ::: "memory"); __builtin_amdgcn_s_barrier(); asm volatile("" ::: "memory");
        if (wid < 4) {
            const f32x4 p = *(const PG8_LAS f32x4*)(P + tid * 4);
            __hip_atomic_store(xch + (size_t)(u.pm * 8 + u.pn) * 256 + tid, (p[0] + p[1]) + (p[2] + p[3]), __ATOMIC_RELAXED, __HIP_MEMORY_SCOPE_AGENT);
            asm volatile("s_waitcnt vmcnt(0)" ::: "memory");
            if (lane == 0) __hip_atomic_fetch_add(cnt + 64 * u.pm, 1u, __ATOMIC_RELAXED, __HIP_MEMORY_SCOPE_AGENT);
        }
        if (wid == 0) {
            unsigned sp = 0;
            while ((unsigned)__builtin_amdgcn_readfirstlane(__hip_atomic_load(cnt + 64 * u.pm, __ATOMIC_RELAXED, __HIP_MEMORY_SCOPE_AGENT)) < 32u) { __builtin_amdgcn_s_sleep(1); if (++sp > (1u << 22)) break; }
            __builtin_amdgcn_fence(__ATOMIC_ACQUIRE, "agent");
        }
        asm volatile("s_waitcnt vmcnt(0) lgkmcnt(0)" ::: "memory"); __builtin_amdgcn_s_barrier(); asm volatile("" ::: "memory");
        if (wid < 4) { float t = 0.f;
#pragma unroll
            for (int q = 0; q < 8; ++q) t += __hip_atomic_load(xch + (size_t)(u.pm * 8 + q) * 256 + tid, __ATOMIC_RELAXED, __HIP_MEMORY_SCOPE_AGENT);
            R[tid] = __builtin_amdgcn_rsqf(t * (1.0f / 2048.0f) + 1e-6f); }
        asm volatile("s_waitcnt lgkmcnt(0)" ::: "memory"); __builtin_amdgcn_s_barrier(); asm volatile("" ::: "memory");
        f32x4 wv[2][2];
#pragma unroll
        for (int bj = 0; bj < 2; ++bj)
#pragma unroll
            for (int n = 0; n < 2; ++n) wv[bj][n] = *(const f32x4*)(fw + col0 + bj * HALF + n * 16);
#pragma unroll
        for (int ai = 0; ai < 2; ++ai)
#pragma unroll
            for (int m = 0; m < 4; ++m) { const float rs = R[ai * HALF + wr * 64 + m * 16 + fr]; const size_t off = (size_t)(row0 + ai * HALF + m * 16) * 2048 + col0;
#pragma unroll
                for (int bj = 0; bj < 2; ++bj)
#pragma unroll
                    for (int n = 0; n < 2; ++n) *(f32x4*)(out + off + bj * HALF + n * 16) = acc[ai][bj][m][n] * rs * wv[bj][n]; }
    }
};
struct EpiResid {
    static constexpr bool PERM = false, AFTER_DRAIN = false;
    const float* base; float* out; int ldc; float* ssq;
    __device__ __forceinline__ void operator()(const f32x4 (&acc)[2][2][4][2], const Unit& u, int wr, int wc, int fr, int fq) const {
        const int row0 = u.pm * BM + wr * 64 + fr, col0 = u.pn * BM + wc * 32 + 4 * fq;
#pragma unroll
        for (int ai = 0; ai < 2; ++ai)
#pragma unroll
            for (int m = 0; m < 4; ++m) { const int row = row0 + ai * HALF + m * 16; const size_t off = (size_t)row * ldc + col0; float s = 0.f;
#pragma unroll
                for (int bj = 0; bj < 2; ++bj)
#pragma unroll
                    for (int n = 0; n < 2; ++n) { const f32x4 v = *(const f32x4*)(base + off + bj * HALF + n * 16) + acc[ai][bj][m][n];
                        *(f32x4*)(out + off + bj * HALF + n * 16) = v; s += (v[0] * v[0] + v[1] * v[1]) + (v[2] * v[2] + v[3] * v[3]); }
                s += __shfl_xor(s, 16); s += __shfl_xor(s, 32);
                if (fq == 0) atomicAdd(ssq + row, s);
                asm volatile("" ::: "memory"); }
    }
};
template <class Epi, class Sched, bool ALIGN_EPI = false, bool SP2 = false>
__device__ __forceinline__ void gemm_phase(PG8_LAS unsigned char* lds, const Gemm g, const Sched& S, const Epi& E) {
    const int tid = threadIdx.x, wid = __builtin_amdgcn_readfirstlane(tid >> 6), lane = tid & 63, wr = wid >> 2, wc = wid & 3, fr = lane & 15, fq = lane >> 4;
    const int K = g.K, nt = K / BK;
    unsigned voffA[2], voffB[2];
#pragma unroll
    for (int i = 0; i < 2; ++i) { int R, C; stage_rc(tid * 16 + i * 8192, R, C); const int Rb = Epi::PERM ? ((R & ~31) + perm32(R & 31)) : R;
        voffA[i] = (unsigned)(R * K + C) * 2u; voffB[i] = (unsigned)(Rb * K + C) * 2u; }
    const size_t kstep = (size_t)(BK * 2);
    const size_t hstep = (size_t)HALF * K * 2;
    const size_t tstep = 2 * hstep;
    const unsigned ldsw = (unsigned)wid * 1024u;
    const int aoff = lds_byte(wr * 64 + fr, fq * 8), boff = lds_byte(wc * 32 + fr, fq * 8);
#define PG8_SA(b, h) (((b) * 2 + (h)) * HTB)
#define PG8_SB(b, h) ((4 + (b) * 2 + (h)) * HTB)
#define PG8_STAGE(bufoff, gbase, voff) do { _Pragma("unroll") for (int _i = 0; _i < 2; ++_i) \
        __builtin_amdgcn_global_load_lds((const unsigned*)((const char*)(gbase) + (voff)[_i]), (PG8_LAS unsigned*)(lds + (bufoff) + ldsw + _i * 8192), 16, 0, 0); } while (0)
#define PG8_LDA(dst, b, h) do { _Pragma("unroll") for (int m = 0; m < 4; ++m) _Pragma("unroll") for (int k = 0; k < 2; ++k) dst[m][k] = *(const PG8_LAS bf16x8*)(lds + PG8_SA(b, h) + aoff + m * 2048 + k * 1024); } while (0)
#define PG8_LDB(dst, b, h) do { _Pragma("unroll") for (int n = 0; n < 2; ++n) _Pragma("unroll") for (int k = 0; k < 2; ++k) dst[n][k] = *(const PG8_LAS bf16x8*)(lds + PG8_SB(b, h) + boff + n * 2048 + k * 1024); } while (0)
#define PG8_MMA(ai, bj, At, Bt) do { __builtin_amdgcn_s_setprio(1); _Pragma("unroll") for (int m = 0; m < 4; ++m) _Pragma("unroll") for (int n = 0; n < 2; ++n) _Pragma("unroll") for (int k = 0; k < 2; ++k) \
        acc[ai][bj][m][n] = __builtin_amdgcn_mfma_f32_16x16x32_bf16(Bt[n][k], At[m][k], acc[ai][bj][m][n], 0, 0, 0); __builtin_amdgcn_s_setprio(0); } while (0)
#define PG8_WAIT_V(n) asm volatile("s_waitcnt vmcnt(" #n ")" ::: "memory")
#define PG8_WAIT_L(n) asm volatile("s_waitcnt lgkmcnt(" #n ")" ::: "memory")
#define PG8_BAR __builtin_amdgcn_s_barrier()
#define PG8_SCHED __builtin_amdgcn_sched_barrier(0)
    Unit cur, nxt; int ui = 0;
    if (!S.next(0, cur)) return;
    f32x4 acc[2][2][4][2];
#pragma unroll
    for (int a = 0; a < 2; ++a)
#pragma unroll
        for (int b = 0; b < 2; ++b)
#pragma unroll
            for (int m = 0; m < 4; ++m)
#pragma unroll
                for (int n = 0; n < 2; ++n) acc[a][b][m][n] = (f32x4){0.f, 0.f, 0.f, 0.f};
    bf16x8 At[4][2], B0[2][2], B1[2][2];
    const char* cA = (const char*)g.A + (size_t)cur.pm * tstep; const char* cB = (const char*)g.Bt + (size_t)cur.pn * tstep;
    S.a_ready(cur);
    if constexpr (SP2) {
        PG8_STAGE(PG8_SB(0, 0), cB, voffB); PG8_STAGE(PG8_SB(0, 1), cB + hstep, voffB); PG8_STAGE(PG8_SA(0, 0), cA, voffA); PG8_STAGE(PG8_SA(0, 1), cA + hstep, voffA);
        if (wr == 1) PG8_BAR;
        PG8_WAIT_V(2); PG8_BAR;
        PG8_STAGE(PG8_SB(1, 0), cB + kstep, voffB); PG8_STAGE(PG8_SA(1, 0), cA + kstep, voffA); PG8_STAGE(PG8_SB(1, 1), cB + hstep + kstep, voffB);
        PG8_WAIT_V(6); PG8_BAR;
    } else {
        PG8_STAGE(PG8_SB(0, 0), cB, voffB); PG8_STAGE(PG8_SA(0, 0), cA, voffA); PG8_STAGE(PG8_SB(0, 1), cB + hstep, voffB); PG8_STAGE(PG8_SA(0, 1), cA + hstep, voffA);
        if (wr == 1) PG8_BAR;
        PG8_WAIT_V(4); PG8_BAR;
        PG8_STAGE(PG8_SB(1, 0), cB + kstep, voffB); PG8_STAGE(PG8_SA(1, 0), cA + kstep, voffA); PG8_STAGE(PG8_SB(1, 1), cB + hstep + kstep, voffB);
        PG8_WAIT_V(6); PG8_BAR;
    }
    for (;;) {
        const bool has_next = S.next(ui + 1, nxt);
        const char* nA = has_next ? (const char*)g.A + (size_t)nxt.pm * tstep : cA; const char* nB = has_next ? (const char*)g.Bt + (size_t)nxt.pn * tstep : cB;
        for (int t = 0; t < nt; t += 2) {
            const bool last = (t == nt - 2);
            const char* a1 = cA + (size_t)(t + 1) * kstep;
            const char* a2 = last ? nA : cA + (size_t)(t + 2) * kstep; const char* b2 = last ? nB : cB + (size_t)(t + 2) * kstep;
            const char* a3 = a2 + kstep; const char* b3 = b2 + kstep;
            if (last && has_next) S.a_ready(nxt);
            if constexpr (SP2) {
            PG8_LDB(B0, 0, 0); PG8_LDB(B1, 0, 1); PG8_SCHED; PG8_LDA(At, 0, 0); PG8_STAGE(PG8_SA(1, 1), a1 + hstep, voffA);
            PG8_WAIT_V(8); PG8_WAIT_L(0); PG8_BAR; PG8_MMA(0, 0, At, B0); PG8_MMA(0, 1, At, B1); PG8_BAR; PG8_SCHED;
            PG8_LDA(At, 0, 1); PG8_STAGE(PG8_SB(0, 0), b2, voffB); PG8_STAGE(PG8_SB(0, 1), b2 + hstep, voffB); PG8_STAGE(PG8_SA(0, 0), a2, voffA);
            PG8_WAIT_V(8); PG8_WAIT_L(0); PG8_BAR; PG8_MMA(1, 0, At, B0); PG8_MMA(1, 1, At, B1); PG8_BAR; PG8_SCHED;
            PG8_LDB(B0, 1, 0); PG8_LDB(B1, 1, 1); PG8_SCHED; PG8_LDA(At, 1, 0); PG8_STAGE(PG8_SA(0, 1), a2 + hstep, voffA);
            PG8_WAIT_V(8); PG8_WAIT_L(0); PG8_BAR; PG8_MMA(0, 0, At, B0); PG8_MMA(0, 1, At, B1); PG8_BAR; PG8_SCHED;
            PG8_LDA(At, 1, 1); PG8_STAGE(PG8_SB(1, 0), b3, voffB); PG8_STAGE(PG8_SB(1, 1), b3 + hstep, voffB); PG8_STAGE(PG8_SA(1, 0), a3, voffA);
            PG8_WAIT_V(8); PG8_WAIT_L(0); PG8_BAR; PG8_MMA(1, 0, At, B0); PG8_MMA(1, 1, At, B1); PG8_BAR; PG8_SCHED;
            } else {
            PG8_LDB(B0, 0, 0); PG8_SCHED; PG8_LDA(At, 0, 0); PG8_STAGE(PG8_SA(1, 1), a1 + hstep, voffA);
            PG8_WAIT_L(8); PG8_BAR; PG8_WAIT_L(0); PG8_MMA(0, 0, At, B0); PG8_BAR; PG8_SCHED;
            PG8_LDB(B1, 0, 1); PG8_STAGE(PG8_SB(0, 0), b2, voffB);
            PG8_BAR; PG8_WAIT_L(0); PG8_MMA(0, 1, At, B1); PG8_BAR;
            PG8_LDA(At, 0, 1); PG8_STAGE(PG8_SA(0, 0), a2, voffA);
            PG8_BAR; PG8_WAIT_L(0); PG8_MMA(1, 0, At, B0); PG8_BAR; PG8_SCHED;
            PG8_STAGE(PG8_SB(0, 1), b2 + hstep, voffB);
            PG8_WAIT_V(6); PG8_BAR; PG8_MMA(1, 1, At, B1); PG8_BAR;
            PG8_LDB(B0, 1, 0); PG8_SCHED; PG8_LDA(At, 1, 0); PG8_STAGE(PG8_SA(0, 1), a2 + hstep, voffA);
            PG8_WAIT_L(8); PG8_BAR; PG8_WAIT_L(0); PG8_MMA(0, 0, At, B0); PG8_BAR; PG8_SCHED;
            PG8_LDB(B1, 1, 1); PG8_STAGE(PG8_SB(1, 0), b3, voffB);
            PG8_BAR; PG8_WAIT_L(0); PG8_MMA(0, 1, At, B1); PG8_BAR;
            PG8_LDA(At, 1, 1); PG8_STAGE(PG8_SA(1, 0), a3, voffA);
            PG8_BAR; PG8_WAIT_L(0); PG8_MMA(1, 0, At, B0); PG8_BAR; PG8_SCHED;
            PG8_STAGE(PG8_SB(1, 1), b3 + hstep, voffB);
            PG8_WAIT_V(6); PG8_BAR; PG8_MMA(1, 1, At, B1); PG8_BAR;
            }
        }
        if constexpr (ALIGN_EPI) { if (wr == 0) PG8_BAR; }
        if constexpr (!Epi::AFTER_DRAIN) { E(acc, cur, wr, wc, fr, fq); S.done(cur); }
        if (!has_next) break;
#pragma unroll
        for (int a = 0; a < 2; ++a)
#pragma unroll
            for (int b = 0; b < 2; ++b)
#pragma unroll
                for (int m = 0; m < 4; ++m)
#pragma unroll
                    for (int n = 0; n < 2; ++n) acc[a][b][m][n] = (f32x4){0.f, 0.f, 0.f, 0.f};
        cur = nxt; cA = nA; cB = nB; ++ui;
        if constexpr (ALIGN_EPI) { if (wr == 1) PG8_BAR; }
    }
    PG8_WAIT_V(0);
    if constexpr (!ALIGN_EPI) { if (wr == 0) PG8_BAR; }
    PG8_BAR;
    if constexpr (Epi::AFTER_DRAIN) { E.fused(acc, cur, wr, wc, fr, fq, lds, wid, lane); S.done(cur); }
#undef PG8_SA
#undef PG8_SB
#undef PG8_STAGE
#undef PG8_LDA
#undef PG8_LDB
#undef PG8_MMA
#undef PG8_WAIT_V
#undef PG8_WAIT_L
#undef PG8_BAR
#undef PG8_SCHED
}
}
#ifndef PG8_SP2
#define PG8_SP2 true
#endif
#ifndef PG8_ALIGN
#define PG8_ALIGN true
#endif

constexpr int NWAVES = 8, NTHREADS = NWAVES * 64;
constexpr int DM = 2048, NBATCH = 4, SEQ = 4096, M = NBATCH * SEQ;
constexpr int NPROJ_IN = 7184;
constexpr int NPJ = 7168;
constexpr int C_GQ = 0, C_GK = 512, C_GV = 1024, C_GG = 2048, C_HQ = 3072, C_HF = 4096, C_HI = 5120, C_HG = 6144;
constexpr int SRC_GLR = 3072;
constexpr float EPS = 1e-6f, QSCALE = 0.08838834764831845f, INV_TAU = 1.0f / 16.0f;
constexpr int CHUNK = 64, NCHUNK = SEQ / CHUNK;

constexpr size_t MiB = 1u << 20;
constexpr size_t WS_CTL = 0, CTL_ZERO_BYTES = 128 * 1024;
constexpr size_t WS_SSQ = 64 * 1024;
constexpr size_t WS_WINT = 2 * MiB;
constexpr size_t WS_WOUTT = 30 * MiB;
constexpr size_t WS_XCH = 40 * MiB;
constexpr size_t WS_GLR = 39 * MiB;
constexpr size_t WS_HN = 64 * MiB;
constexpr size_t WS_MIX = 128 * MiB;
constexpr size_t WS_PJ = 192 * MiB;
constexpr size_t WS_END = 416 * MiB;

constexpr int LDS_BYTES = 155648;
constexpr int QK_STRIDE = 272, L_QT = 0, L_KT = 64 * QK_STRIDE, L_VR = 2 * 64 * QK_STRIDE, L_AM = L_VR + 64 * 528, L_TOT = L_AM + 64 * 144, L_FAC = L_TOT + 8 * 128 * 4, L_SS = L_FAC + 128 * 4, L_RS = L_SS + 8 * 64 * 4, L_LG = L_RS + 64 * 4, L_KS = L_LG + 64 * 128 * 4, L_SCAN_END = L_KS + 64 * 128 * 4;
static_assert(L_SCAN_END <= LDS_BYTES - 128, "scan LDS map");

#define LAS __attribute__((address_space(3)))
typedef unsigned short bf16;
typedef float f32x4 __attribute__((ext_vector_type(4)));
typedef float f32x2 __attribute__((ext_vector_type(2)));
typedef float f32x16 __attribute__((ext_vector_type(16)));
typedef short bf16x8 __attribute__((ext_vector_type(8)));
typedef short s16x4 __attribute__((ext_vector_type(4)));
typedef unsigned u32x4 __attribute__((ext_vector_type(4)));
typedef unsigned u32x2 __attribute__((ext_vector_type(2)));
typedef __bf16 bf16x2_t __attribute__((ext_vector_type(2)));
#define MFMA32(a, b, c) __builtin_amdgcn_mfma_f32_32x32x16_bf16((a), (b), (c), 0, 0, 0)

__device__ __forceinline__ unsigned pk2(float lo, float hi) { const bf16x2_t v = __builtin_convertvector((f32x2){lo, hi}, bf16x2_t); return __builtin_bit_cast(unsigned, v); }
__device__ __forceinline__ float bf_lo(unsigned u) { return __uint_as_float(u << 16); }
__device__ __forceinline__ float bf_hi(unsigned u) { return __uint_as_float(u & 0xffff0000u); }
__device__ __forceinline__ float bf_1(unsigned short u) { return __uint_as_float(((unsigned)u) << 16); }
__device__ __forceinline__ float wave_sum(float v) {
#pragma unroll
    for (int o = 1; o < 64; o <<= 1) v += __shfl_xor(v, o);
    return v;
}
__device__ __forceinline__ float sigmoidf_(float x) { return 1.0f / (1.0f + __expf(-x)); }

#define XB_TMO      128
#define XB_XCNT(j)  (256  + 64 * (j))
#define XB_XSUB(j)  (1280 + 64 * (j))
#define XB_XGEN(j)  (2304 + 64 * (j))
#define XB_TOP      3328
#define XB_TOPGEN   3392
#define XCD_BAR_WORDS 3456
#define XB_SPIN_CAP (1u << 18)

__device__ __forceinline__ unsigned xb_ld(unsigned* p)              { return __hip_atomic_load(p, __ATOMIC_RELAXED, __HIP_MEMORY_SCOPE_AGENT); }
__device__ __forceinline__ unsigned xb_add(unsigned* p, unsigned v) { return __hip_atomic_fetch_add(p, v, __ATOMIC_RELAXED, __HIP_MEMORY_SCOPE_AGENT); }
__device__ __forceinline__ unsigned xb_xcc_id() { return (unsigned)__builtin_amdgcn_s_getreg((3 << 11) | 20) & 0xFu; }
#define XB_SPIN(cond, bar) do { unsigned _sp = 0; while (cond) { __builtin_amdgcn_s_sleep(1); \
    if ((++_sp & 255u) == 0u) { if (xb_ld(&(bar)[XB_TMO])) break; if (_sp > XB_SPIN_CAP) { atomicAdd(&(bar)[XB_TMO], 1u); break; } } } } while (0)

struct XcdBarrier {
    unsigned* bar; unsigned x;
    volatile LAS unsigned* st;
};

__device__ __forceinline__ XcdBarrier xcd_barrier_post(unsigned* bar, volatile LAS unsigned* st) {
    XcdBarrier b; b.bar = bar; b.x = xb_xcc_id(); b.st = st;
    if (threadIdx.x == 0) (void)xb_add(&bar[XB_XCNT(b.x)], 1u);
    return b;
}
__device__ __forceinline__ void xcd_barrier_complete(unsigned* bar, unsigned x, unsigned& nloc, unsigned& nx) {
    const unsigned G = gridDim.x * gridDim.y * gridDim.z;
    unsigned sum, cnt, mine, sp = 0u;
    for (;;) {
        sum = 0u; cnt = 0u; mine = 0u;
#pragma unroll
        for (unsigned j = 0; j < 16; ++j) { const unsigned c = xb_ld(&bar[XB_XCNT(j)]); sum += c; cnt += (c > 0u) ? 1u : 0u; mine = (j == x) ? c : mine; }
        if (sum == G) break;
        __builtin_amdgcn_s_sleep(1);
        if ((++sp & 255u) == 0u) { if (xb_ld(&bar[XB_TMO])) break; if (sp > XB_SPIN_CAP) { atomicAdd(&bar[XB_TMO], 1u); break; } }
    }
    nloc = mine > 0u ? mine : 1u; nx = cnt > 0u ? cnt : 1u;
}

__device__ __forceinline__ void xcd_barrier(const XcdBarrier& b) {
    asm volatile("s_waitcnt vmcnt(0)" ::: "memory");
    __syncthreads();
    if (threadIdx.x == 0) {
        unsigned* bar = b.bar;
        __builtin_amdgcn_s_waitcnt(0);
        unsigned nloc = b.st[0], nx = b.st[1];
        if (nloc == 0u) { xcd_barrier_complete(bar, b.x, nloc, nx); b.st[0] = nloc; b.st[1] = nx; }
        const unsigned old = xb_add(&bar[XB_XSUB(b.x)], 1u);
        const unsigned gen = old / nloc;
        if (old + 1u == (gen + 1u) * nloc) {
            __builtin_amdgcn_fence(__ATOMIC_RELEASE, "agent");
            asm volatile("s_waitcnt vmcnt(0)" ::: "memory");
            const unsigned og = xb_add(&bar[XB_TOP], 1u);
            const unsigned tg = og / nx;
            if (og + 1u == (tg + 1u) * nx) xb_add(&bar[XB_TOPGEN], 1u);
            else XB_SPIN(xb_ld(&bar[XB_TOPGEN]) == tg, bar);
            __builtin_amdgcn_fence(__ATOMIC_ACQUIRE, "agent");
            xb_add(&bar[XB_XGEN(b.x)], 1u);
            asm volatile("s_waitcnt vmcnt(0)" ::: "memory");
        } else {
            XB_SPIN(xb_ld(&bar[XB_XGEN(b.x)]) == gen, bar);
            __builtin_amdgcn_fence(__ATOMIC_ACQUIRE, "agent");
            asm volatile("s_waitcnt vmcnt(0)" ::: "memory");
        }
    }
    __syncthreads();
}

constexpr int CW_PANEL = 16384;
constexpr int CW_BAR = 4096;
constexpr int MISC_OFF = LDS_BYTES - 128;

struct Frame {
    LAS unsigned char* lds;
    int tid, lane, wave, G, bid;
    const float *x, *norm_w, *w_in, *gla_w_up, *gla_b_up, *gla_norm_w, *hgrn_lb, *hgrn_norm_w, *w_out, *final_w;
    float* out;
    bf16 *WinT, *WoutT, *HN, *MIX, *PJ;
    float *GLR, *SSQ;
    unsigned char* ws;
};

__device__ __forceinline__ void p0_transpose_item(const float* W, int ldw, int src_col, bf16* WT, int K, int dst_row, int kb, LAS float* scr, int lane) {
    const int k0 = 64 * kb;
#pragma unroll 8
    for (int i = 0; i < 32; ++i) { const int kk = 2 * i + (lane >> 5); scr[kk * 33 + (lane & 31)] = W[(size_t)(k0 + kk) * ldw + src_col + (lane & 31)]; }
    asm volatile("s_waitcnt lgkmcnt(0)" ::: "memory");
    const int c = lane & 7;
#pragma unroll
    for (int j = 0; j < 4; ++j) { const int n = (lane >> 3) + 8 * j; const LAS float* s = scr + (8 * c) * 33 + n;
        u32x4 o; o.x = pk2(s[0 * 33], s[1 * 33]); o.y = pk2(s[2 * 33], s[3 * 33]); o.z = pk2(s[4 * 33], s[5 * 33]); o.w = pk2(s[6 * 33], s[7 * 33]);
        *(u32x4*)(WT + (size_t)(dst_row + n) * K + k0 + 8 * c) = o; }
    asm volatile("s_waitcnt lgkmcnt(0)" ::: "memory");
}

__device__ __forceinline__ void p0_prologue(Frame& F) {
    const int gw = F.bid * NWAVES + F.wave, NGW = F.G * NWAVES;
    {
        LAS float* scr = (LAS float*)(F.lds + F.wave * 16384);
        constexpr int KB = DM / 64;
        constexpr int I_IN = KB * (NPJ / 32), I_OUT = KB * (DM / 32);
        for (int it = gw; it < I_IN + I_OUT; it += NGW) {
            if (it < I_IN) { const int kb = it / (NPJ / 32), nb = it % (NPJ / 32), n0 = 32 * nb; const int src = n0 < SRC_GLR ? n0 : n0 + 16;
                p0_transpose_item(F.w_in, NPROJ_IN, src, F.WinT, DM, n0, kb, scr, F.lane); }
            else { const int r = it - I_IN, kb = r / (DM / 32), nb = r % (DM / 32);
                p0_transpose_item(F.w_out, DM, 32 * nb, F.WoutT, DM, 32 * nb, kb, scr, F.lane); }
        }
    }
    __syncthreads();
    LAS float* Wt = (LAS float*)F.lds;
    for (int k = F.tid; k < DM; k += NTHREADS) {
        const f32x4* src = (const f32x4*)(F.w_in + (size_t)k * NPROJ_IN + SRC_GLR);
#pragma unroll
        for (int q = 0; q < 4; ++q) { const f32x4 v = src[q]; Wt[(4 * q + 0) * DM + k] = v[0]; Wt[(4 * q + 1) * DM + k] = v[1]; Wt[(4 * q + 2) * DM + k] = v[2]; Wt[(4 * q + 3) * DM + k] = v[3]; }
    }
    __syncthreads();
    f32x4 nw[8];
#pragma unroll
    for (int j = 0; j < 8; ++j) nw[j] = ((const f32x4*)F.norm_w)[64 * j + F.lane];
    const LAS f32x4* Wt4 = (const LAS f32x4*)Wt;
    for (int m = gw; m < M; m += NGW) {
        const f32x4* xr = (const f32x4*)(F.x + (size_t)m * DM) + F.lane;
        f32x4 v[8]; float s = 0.f;
#pragma unroll
        for (int j = 0; j < 8; ++j) { v[j] = xr[64 * j]; s += (v[j][0] * v[j][0] + v[j][1] * v[j][1]) + (v[j][2] * v[j][2] + v[j][3] * v[j][3]); }
        const float rstd = 1.0f / sqrtf(wave_sum(s) * (1.0f / DM) + EPS);
        float a[16];
#pragma unroll
        for (int c = 0; c < 16; ++c) a[c] = 0.f;
        u32x2* o8 = (u32x2*)(F.HN + (size_t)m * DM) + F.lane;
#pragma unroll
        for (int j = 0; j < 8; ++j) {
            v[j] = v[j] * rstd * nw[j];
            u32x2 w; w.x = pk2(v[j][0], v[j][1]); w.y = pk2(v[j][2], v[j][3]); o8[64 * j] = w;
            asm volatile("" ::: "memory");
#pragma unroll
            for (int c = 0; c < 16; ++c) { const f32x4 wv = Wt4[c * (DM / 4) + 64 * j + F.lane]; a[c] += (v[j][0] * wv[0] + v[j][1] * wv[1]) + (v[j][2] * wv[2] + v[j][3] * wv[3]); }
        }
        float mine = 0.f;
#pragma unroll
        for (int c = 0; c < 16; ++c) { const float t = wave_sum(a[c]); mine = (F.lane == c) ? t : mine; }
        if (F.lane < 16) F.GLR[(size_t)m * 16 + F.lane] = mine;
    }
    __syncthreads();
}

constexpr int NSEG_G = 8, NSEG_H = 4;
constexpr size_t WS_LG = WS_HN, WS_LH = WS_HN + 16 * MiB, WS_DG = WS_HN + 48 * MiB, WS_DH = WS_HN + 49 * MiB;
static_assert(16 * NSEG_G * 131072 <= 16 * MiB && 32 * NSEG_H * 65536 <= 32 * MiB, "L buffers");

__device__ __forceinline__ bf16x8 tr_frag(LAS unsigned char* img, unsigned lanebase, unsigned stride, unsigned c, unsigned ks) {
    const unsigned a0 = lanebase + (16 * ks) * stride + 64 * c;
    const s16x4 lo = __builtin_amdgcn_ds_read_tr16_b64_v4i16((LAS s16x4*)(img + a0));
    const s16x4 hi = __builtin_amdgcn_ds_read_tr16_b64_v4i16((LAS s16x4*)(img + a0 + 4 * stride));
    return __builtin_shufflevector(lo, hi, 0, 1, 2, 3, 4, 5, 6, 7);
}

template <int GLA, int PASSB>
__device__ __forceinline__ void scan_item(Frame& F, const int b, const int h, const int seg) {
    constexpr int dv = GLA ? 256 : 128, nmw = dv / 32, NSEG = GLA ? NSEG_G : NSEG_H, NC = NCHUNK / NSEG;
    constexpr unsigned vstride = 2 * dv + 16;
    constexpr int NVL = 64 * (dv / 8) / NTHREADS;
    constexpr int CPR = dv / 8, RPP = NTHREADS / CPR;
    constexpr int OS = dv * 4;
    const int tid = F.tid, lane = F.lane, wave = F.wave;
    LAS unsigned char* lds = F.lds;
    LAS unsigned char* QT = lds + L_QT; LAS unsigned char* KT = lds + L_KT; LAS unsigned char* VR = lds + L_VR; LAS unsigned char* AM = lds + L_AM;
    LAS float* TOT = (LAS float*)(lds + L_TOT); LAS float* FAC = (LAS float*)(lds + L_FAC); LAS float* NW = (LAS float*)(lds + L_SS);
    LAS float* LG = (LAS float*)(lds + L_LG); LAS float* KS = (LAS float*)(lds + L_KS);
    LAS unsigned char* O32 = lds + (GLA ? L_LG : L_KS);
    const int qcol = GLA ? C_GQ + h * 128 : C_HQ + h * 128, kcol = GLA ? C_GK + h * 128 : C_HF + h * 128;
    const int vcol = GLA ? C_GV + h * 256 : C_HI + h * 128, gcol = GLA ? C_GG + h * 256 : C_HG + h * 128;
    const int mcol = GLA ? h * 256 : 1024 + h * 128;
    const float* normw = GLA ? F.gla_norm_w + h * 256 : F.hgrn_norm_w + h * 128;
    const int dp = tid & 63, d0 = 2 * dp;
    const int item = GLA ? (b * 4 + h) * NSEG + seg : (b * 8 + h) * NSEG + seg;
    float* Lbase = (float*)(F.ws + (GLA ? WS_LG : WS_LH)); float* Dbase = (float*)(F.ws + (GLA ? WS_DG : WS_DH));
    constexpr int LSZ = 128 * dv;
    float wub[8], bub = 0.f, lb0 = 0.f, lb1 = 0.f;
    if (GLA) {
        const int col = h * 128 + 32 * (wave & 3) + (lane & 31);
#pragma unroll
        for (int s = 0; s < 8; ++s) wub[s] = F.gla_w_up[(size_t)(2 * s + (lane >> 5)) * 512 + col];
        bub = F.gla_b_up[col];
    } else {
#pragma unroll
        for (int s = 0; s < 8; ++s) wub[s] = 0.f;
        const f32x2 l0 = *(const f32x2*)(F.hgrn_lb + h * 128 + d0), l1 = *(const f32x2*)(F.hgrn_lb + 1024 + h * 128 + d0);
        lb0 = __builtin_amdgcn_rcpf(1.0f + __expf(l1[0] - l0[0])); lb1 = __builtin_amdgcn_rcpf(1.0f + __expf(l1[1] - l0[1]));
    }
    if (PASSB && tid < dv) NW[tid] = normw[tid];
    float elp0 = 1.f, elp1 = 1.f, dsum0 = 0.f, dsum1 = 0.f;
    const unsigned r = lane & 31, hh = lane >> 5;
    const unsigned tq = (lane & 15) >> 2, tp = lane & 3, tblk = (lane >> 4) & 1;
    const unsigned trk = (8 * hh + tq) * QK_STRIDE + 32 * tblk + 8 * tp, trv = (8 * hh + tq) * vstride + 32 * tblk + 8 * tp;
    const size_t row0 = (size_t)b * SEQ + (size_t)seg * NC * CHUNK;

    f32x16 S[4];
#pragma unroll
    for (int i = 0; i < 4; ++i)
#pragma unroll
        for (int j = 0; j < 16; ++j) S[i][j] = 0.f;
    if (PASSB && wave < nmw) {
        for (int sp = 0; sp < seg; ++sp) {
            const float* Lp = Lbase + (size_t)(item - seg + sp) * LSZ; const float* Dp = Dbase + (size_t)(item - seg + sp) * 128;
#pragma unroll
            for (int db = 0; db < 4; ++db)
#pragma unroll
                for (int g4 = 0; g4 < 4; ++g4) { const f32x4 lv = *(const f32x4*)(Lp + (((wave * 4 + db) * 4 + g4) * 64 + lane) * 4); const f32x4 dvv = *(const f32x4*)(Dp + 32 * db + 8 * g4 + 4 * hh);
#pragma unroll
                    for (int e = 0; e < 4; ++e) S[db][4 * g4 + e] = S[db][4 * g4 + e] * dvv[e] + lv[e]; }
        }
    }
    const __amdgpu_buffer_rsrc_t rs_pj = __builtin_amdgcn_make_buffer_rsrc((void*)F.PJ, 0, (int)((size_t)M * NPJ * 2), 0x00020000);
    const __amdgpu_buffer_rsrc_t rs_glr = __builtin_amdgcn_make_buffer_rsrc((void*)F.GLR, 0, M * 16 * 4, 0x00020000);
    const __amdgpu_buffer_rsrc_t rs_mix = __builtin_amdgcn_make_buffer_rsrc((void*)F.MIX, 0, (int)((size_t)M * DM * 2), 0x00020000);
    const unsigned vo_qk = 4 * dp, vo_g = ((lane & 31) * 16 + (lane >> 5)) * 4, vo_v = (tid / CPR) * 512 + (tid % CPR) * 16, vo_m = (tid / CPR) * (DM * 2) + (tid % CPR) * 16;
#define PJB(T, COL) ((((((unsigned)(T)) >> 8) * (unsigned)(NPJ / 256) + (((unsigned)(COL)) >> 8)) << 17) + ((((unsigned)(T)) & 255u) << 9) + ((((unsigned)(COL)) & 255u) << 1))
    unsigned nq[8], nk[8]; float ng[8]; u32x4 vn[NVL], gt[NVL];
#define SCAN_PREFETCH(T0) do { const unsigned _sk = PJB(T0, kcol) + 8 * wave * 512, _sq = PJB(T0, qcol) + 8 * wave * 512; \
        _Pragma("unroll") for (int i = 0; i < 8; ++i) { nk[i] = __builtin_amdgcn_raw_buffer_load_b32(rs_pj, vo_qk, _sk + i * 512, 0); if (PASSB) nq[i] = __builtin_amdgcn_raw_buffer_load_b32(rs_pj, vo_qk, _sq + i * 512, 0); } \
        if (GLA) { const unsigned _sg = ((unsigned)(T0) + 32 * (wave >> 2)) * 64; _Pragma("unroll") for (int s = 0; s < 8; ++s) ng[s] = __uint_as_float(__builtin_amdgcn_raw_buffer_load_b32(rs_glr, vo_g, _sg + 8 * s, 0)); } \
        { const unsigned _sv = PJB(T0, vcol); _Pragma("unroll") for (int j = 0; j < NVL; ++j) vn[j] = __builtin_amdgcn_raw_buffer_load_b128(rs_pj, vo_v, _sv + j * (RPP * 512), 0); } \
        } while (0)
#pragma unroll
    for (int i = 0; i < 8; ++i) { nq[i] = 0u; ng[i] = 0.f; }
    SCAN_PREFETCH(row0);

    for (int c = 0; c < NC; ++c) {
        const size_t t0 = row0 + (size_t)c * CHUNK;
        if (GLA) {
            f32x16 z;
#pragma unroll
            for (int j = 0; j < 16; ++j) z[j] = 0.f;
#pragma unroll
            for (int s = 0; s < 8; ++s) z = __builtin_amdgcn_mfma_f32_32x32x2f32(ng[s], wub[s], z, 0, 0, 0);
#pragma unroll
            for (int reg = 0; reg < 16; ++reg) { const float zz = z[reg] + bub; const int row = 32 * (wave >> 2) + (reg & 3) + 8 * (reg >> 2) + 4 * (lane >> 5);
                LG[row * 128 + 32 * (wave & 3) + (lane & 31)] = (fminf(zz, 0.f) - __logf(1.0f + __expf(-fabsf(zz)))) * INV_TAU; }
            __syncthreads();
        }
        {
            float cum0 = 0.f, cum1 = 0.f;
#pragma unroll
            for (int i = 0; i < 8; ++i) {
                LAS f32x2* lgp = (LAS f32x2*)(LG + (8 * wave + i) * 128 + d0);
                float lg0, lg1;
                if (GLA) { const f32x2 lgv = *lgp; lg0 = lgv[0]; lg1 = lgv[1]; }
                else {
                    const unsigned kv = nk[i];
                    const float s0 = __builtin_amdgcn_rcpf(1.0f + __expf(-bf_lo(kv))), s1 = __builtin_amdgcn_rcpf(1.0f + __expf(-bf_hi(kv)));
                    const float f0 = lb0 + (1.0f - lb0) * s0, f1 = lb1 + (1.0f - lb1) * s1;
                    lg0 = __logf(f0); lg1 = __logf(f1);
                    *(LAS f32x2*)(KS + (8 * wave + i) * 128 + d0) = (f32x2){1.0f - f0, 1.0f - f1};
                }
                cum0 += lg0; cum1 += lg1; *lgp = (f32x2){cum0, cum1};
            }
            *(LAS f32x2*)(TOT + wave * 128 + d0) = (f32x2){cum0, cum1};
        }
        __syncthreads();
        {
            float off0 = 0.f, off1 = 0.f, r0 = 0.f, r1 = 0.f, bl0 = 0.f, bl1 = 0.f;
#pragma unroll
            for (int g = 0; g < 8; ++g) { const f32x2 tv = *(const LAS f32x2*)(TOT + g * 128 + d0);
                if (g < wave) { off0 += tv[0]; off1 += tv[1]; } if (g < 4) { r0 += tv[0]; r1 += tv[1]; } bl0 += tv[0]; bl1 += tv[1]; }
            off0 -= r0; off1 -= r1;
#pragma unroll
            for (int i = 0; i < 8; ++i) {
                const f32x2 cv = *(const LAS f32x2*)(LG + (8 * wave + i) * 128 + d0);
                const float e0 = __expf(off0 + cv[0]), e1 = __expf(off1 + cv[1]);
                const unsigned o = (8 * wave + i) * QK_STRIDE + 4 * dp;
                if (PASSB) *(LAS unsigned*)(QT + o) = pk2(bf_lo(nq[i]) * QSCALE * e0, bf_hi(nq[i]) * QSCALE * e1);
                float kk0, kk1;
                if (GLA) { kk0 = bf_lo(nk[i]); kk1 = bf_hi(nk[i]); } else { const f32x2 kv = *(const LAS f32x2*)(KS + (8 * wave + i) * 128 + d0); kk0 = kv[0]; kk1 = kv[1]; }
                *(LAS unsigned*)(KT + o) = pk2(kk0 * __builtin_amdgcn_rcpf(e0), kk1 * __builtin_amdgcn_rcpf(e1));
            }
            if (wave == 0) { *(LAS f32x2*)(FAC + d0) = (f32x2){__expf(r0) * elp0, __expf(r1) * elp1}; elp0 = __expf(bl0 - r0); elp1 = __expf(bl1 - r1); dsum0 += bl0; dsum1 += bl1; }
        }
#pragma unroll
        for (int j = 0; j < NVL; ++j) *(LAS u32x4*)(VR + (tid / CPR + RPP * j) * vstride + 16 * (tid % CPR)) = vn[j];
        if (PASSB) { const unsigned _sv = PJB(t0, gcol);
#pragma unroll
            for (int j = 0; j < NVL; ++j) gt[j] = __builtin_amdgcn_raw_buffer_load_b128(rs_pj, vo_v, _sv + j * (RPP * 512), 0); }
        if (c + 1 < NC) SCAN_PREFETCH(t0 + CHUNK);
        __syncthreads();
        f32x16 o[2];
        if (PASSB) {
            const int aw = GLA ? wave : wave - 4;
            if (aw >= 0 && aw < 3) {
                const int it = aw > 0, jt = aw > 1;
                f32x16 a;
#pragma unroll
                for (int j = 0; j < 16; ++j) a[j] = 0.f;
#pragma unroll
                for (int s = 0; s < 8; ++s) { const bf16x8 qa = *(const LAS bf16x8*)(QT + (32 * it + r) * QK_STRIDE + 32 * s + 16 * hh); const bf16x8 kb = *(const LAS bf16x8*)(KT + (32 * jt + r) * QK_STRIDE + 32 * s + 16 * hh); a = MFMA32(qa, kb, a); }
                const int jj = 32 * jt + r;
#pragma unroll
                for (int reg = 0; reg < 16; ++reg) { const int ii = 32 * it + (reg & 3) + 8 * (reg >> 2) + 4 * hh; const float v = (jj <= ii) ? a[reg] : 0.f;
                    *(LAS unsigned short*)(AM + ii * 144 + jj * 2) = (unsigned short)(pk2(v, 0.f) & 0xffffu); }
            }
        }
        if (wave < nmw) {
#pragma unroll
            for (int i = 0; i < 2; ++i)
#pragma unroll
                for (int j = 0; j < 16; ++j) o[i][j] = 0.f;
#pragma unroll
            for (int db = 0; db < 4; ++db) {
                asm volatile("" ::: "memory");
#pragma unroll
                for (int g4 = 0; g4 < 4; ++g4) { const f32x4 fv = *(const LAS f32x4*)(FAC + 32 * db + 8 * g4 + 4 * hh);
#pragma unroll
                    for (int e = 0; e < 4; ++e) S[db][4 * g4 + e] *= fv[e]; }
                if (PASSB) {
#pragma unroll
                    for (int s = 0; s < 2; ++s) {
                        u32x4 pb; pb.x = pk2(S[db][8 * s + 0], S[db][8 * s + 1]); pb.y = pk2(S[db][8 * s + 2], S[db][8 * s + 3]); pb.z = pk2(S[db][8 * s + 4], S[db][8 * s + 5]); pb.w = pk2(S[db][8 * s + 6], S[db][8 * s + 7]);
                        const bf16x8 bs = __builtin_bit_cast(bf16x8, pb);
#pragma unroll
                        for (int it = 0; it < 2; ++it) {
                            const LAS unsigned char* qp = QT + (32 * it + r) * QK_STRIDE + 64 * db + 32 * s + 8 * hh; const s16x4 lo = *(const LAS s16x4*)qp, hi = *(const LAS s16x4*)(qp + 16);
                            o[it] = MFMA32(__builtin_shufflevector(lo, hi, 0, 1, 2, 3, 4, 5, 6, 7), bs, o[it]);
                        }
                    }
                }
            }
        }
        if (PASSB) __syncthreads();
        if (wave < nmw) {
            bf16x8 vf[4];
#pragma unroll
            for (int ks = 0; ks < 4; ++ks) vf[ks] = tr_frag(VR, trv, vstride, wave, ks);
            if (PASSB) {
#pragma unroll
                for (int it = 0; it < 2; ++it)
#pragma unroll
                    for (int ks = 0; ks < 4; ++ks) { if (it == 0 && ks >= 2) continue;
                        const bf16x8 af = *(const LAS bf16x8*)(AM + (32 * it + r) * 144 + (16 * ks + 8 * hh) * 2); o[it] = MFMA32(af, vf[ks], o[it]); }
#pragma unroll
                for (int it = 0; it < 2; ++it)
#pragma unroll
                    for (int reg = 0; reg < 16; ++reg) *(LAS float*)(O32 + (32 * it + (reg & 3) + 8 * (reg >> 2) + 4 * hh) * OS + (32 * wave + r) * 4) = o[it][reg];
            }
#pragma unroll
            for (int db = 0; db < 4; ++db) {
                asm volatile("" ::: "memory");
#pragma unroll
                for (int ks = 0; ks < 4; ++ks) { const bf16x8 kf = tr_frag(KT, trk, QK_STRIDE, db, ks); S[db] = MFMA32(kf, vf[ks], S[db]); } }
            asm volatile("" ::: "memory");
        }
        if (PASSB) {
            __syncthreads();
#pragma unroll
            for (int j = 0; j < NVL; ++j) {
                const int row = tid / CPR + RPP * j, ch = tid % CPR;
                const f32x4 oa = *(const LAS f32x4*)(O32 + row * OS + ch * 32), ob = *(const LAS f32x4*)(O32 + row * OS + ch * 32 + 16);
                float sq = (oa[0] * oa[0] + oa[1] * oa[1]) + (oa[2] * oa[2] + oa[3] * oa[3]) + (ob[0] * ob[0] + ob[1] * ob[1]) + (ob[2] * ob[2] + ob[3] * ob[3]);
#pragma unroll
                for (int m = 1; m < CPR; m <<= 1) sq += __shfl_xor(sq, m);
                const float rstd = __builtin_amdgcn_rsqf(sq * (1.0f / dv) + EPS);
                const f32x4 wa = *(const LAS f32x4*)(NW + 8 * ch), wb = *(const LAS f32x4*)(NW + 8 * ch + 4);
                const u32x4 g = gt[j]; float res[8];
                const float gv[8] = {bf_lo(g.x), bf_hi(g.x), bf_lo(g.y), bf_hi(g.y), bf_lo(g.z), bf_hi(g.z), bf_lo(g.w), bf_hi(g.w)};
#pragma unroll
                for (int e = 0; e < 4; ++e) { res[e] = oa[e] * rstd * wa[e] * (gv[e] * __builtin_amdgcn_rcpf(1.0f + __expf(-gv[e]))); res[4 + e] = ob[e] * rstd * wb[e] * (gv[4 + e] * __builtin_amdgcn_rcpf(1.0f + __expf(-gv[4 + e]))); }
                u32x4 w; w.x = pk2(res[0], res[1]); w.y = pk2(res[2], res[3]); w.z = pk2(res[4], res[5]); w.w = pk2(res[6], res[7]);
                __builtin_amdgcn_raw_buffer_store_b128(w, rs_mix, vo_m, ((unsigned)t0 + RPP * j) * (DM * 2) + mcol * 2, 0);
            }
            __syncthreads();
        }
    }
    if (!PASSB) {
        __syncthreads();
        if (wave == 0) { *(LAS f32x2*)(FAC + d0) = (f32x2){elp0, elp1}; *(f32x2*)(Dbase + (size_t)item * 128 + d0) = (f32x2){__expf(dsum0), __expf(dsum1)}; }
        __syncthreads();
        if (wave < nmw) {
            float* Lp = Lbase + (size_t)item * LSZ;
#pragma unroll
            for (int db = 0; db < 4; ++db)
#pragma unroll
                for (int g4 = 0; g4 < 4; ++g4) { const f32x4 fv = *(const LAS f32x4*)(FAC + 32 * db + 8 * g4 + 4 * hh); f32x4 ov;
#pragma unroll
                    for (int e = 0; e < 4; ++e) ov[e] = S[db][4 * g4 + e] * fv[e];
                    *(f32x4*)(Lp + (((wave * 4 + db) * 4 + g4) * 64 + lane) * 4) = ov; }
        }
    }
    __syncthreads();
#undef SCAN_PREFETCH
#undef PJB
}

__device__ __forceinline__ void p2a_scan(Frame& F) {
    constexpr int NG = 16 * (NSEG_G - 1), NH = 32 * (NSEG_H - 1);
    static_assert(NG + NH <= 256, "pass A items");
    const int it = F.bid;
    if (it < NG) { const int bh = it / (NSEG_G - 1), seg = it % (NSEG_G - 1); scan_item<1, 0>(F, bh >> 2, bh & 3, seg); }
    else if (it < NG + NH) { const int j = it - NG, bh = j / (NSEG_H - 1), seg = j % (NSEG_H - 1); scan_item<0, 0>(F, bh >> 3, bh & 7, seg); }
}
__device__ __forceinline__ void p2b_scan(Frame& F) {
    constexpr int NG = 16 * NSEG_G, NH = 32 * NSEG_H;
    static_assert(NG + NH <= 256, "pass B items");
    const int it = F.bid;
    if (it < NG) { const int bh = it / NSEG_G, seg = it % NSEG_G; scan_item<1, 1>(F, bh >> 2, bh & 3, seg); }
    else if (it < NG + NH) { const int j = it - NG, bh = j / NSEG_H, seg = j % NSEG_H; scan_item<0, 1>(F, bh >> 3, bh & 7, seg); }
}

__device__ __forceinline__ void p4_final(Frame& F) {
    const int gw = F.bid * NWAVES + F.wave, NGW = F.G * NWAVES;
    f32x4 fw[8];
#pragma unroll
    for (int j = 0; j < 8; ++j) fw[j] = ((const f32x4*)F.final_w)[64 * j + F.lane];
    for (int m = gw; m < M; m += NGW) {
        const float rstd = 1.0f / sqrtf(F.SSQ[m] * (1.0f / DM) + EPS);
        f32x4* orow = (f32x4*)(F.out + (size_t)m * DM) + F.lane;
        f32x4 v[8];
#pragma unroll
        for (int j = 0; j < 8; ++j) v[j] = orow[64 * j];
#pragma unroll
        for (int j = 0; j < 8; ++j) orow[64 * j] = v[j] * rstd * fw[j];
    }
}

struct Args { const float* in[10]; float* out; unsigned char* ws; int ph_lo, ph_hi; };
__global__ void __launch_bounds__(NTHREADS, 2) mk_fwd(Args args) {
    extern __shared__ __attribute__((aligned(16))) unsigned char lds_raw[];
    Frame F;
    F.lds = (LAS unsigned char*)lds_raw;
    F.tid = threadIdx.x; F.lane = F.tid & 63; F.wave = __builtin_amdgcn_readfirstlane(F.tid >> 6);
    F.G = gridDim.x; F.bid = blockIdx.x;
    F.x = args.in[0]; F.norm_w = args.in[1]; F.w_in = args.in[2]; F.gla_w_up = args.in[3]; F.gla_b_up = args.in[4]; F.gla_norm_w = args.in[5];
    F.hgrn_lb = args.in[6]; F.hgrn_norm_w = args.in[7]; F.w_out = args.in[8]; F.final_w = args.in[9]; F.out = args.out;
    unsigned char* ws = args.ws; F.ws = ws;
    F.WinT = (bf16*)(ws + WS_WINT); F.WoutT = (bf16*)(ws + WS_WOUTT); F.HN = (bf16*)(ws + WS_HN); F.MIX = (bf16*)(ws + WS_MIX); F.PJ = (bf16*)(ws + WS_PJ);
    F.GLR = (float*)(ws + WS_GLR); F.SSQ = (float*)(ws + WS_SSQ);
    const int lo = args.ph_lo, hi = args.ph_hi;
#if MK_ONE_LAUNCH
    if (F.tid < 32) ((LAS unsigned*)(F.lds + MISC_OFF))[F.tid] = 0u;
    __syncthreads();
    const XcdBarrier xbar = xcd_barrier_post((unsigned*)(ws + WS_CTL) + CW_BAR, (volatile LAS unsigned*)(F.lds + MISC_OFF));
#endif
#ifndef MK_PHASE_MASK
#define MK_PHASE_MASK 63
#endif
#define IN(k) (((MK_PHASE_MASK >> (k)) & 1) && lo <= (k) && (k) < hi)
#define BOTH(k) (IN(k) && IN((k) + 1))
#if MK_ONE_LAUNCH
#define GRID_BAR() do { xcd_barrier(xbar); } while (0)
#else
#define GRID_BAR() do { } while (0)
#endif
#ifndef MK_DUP
#define MK_DUP -1
#endif
    if (IN(0)) { p0_prologue(F); if (MK_DUP == 0) { GRID_BAR(); p0_prologue(F); } if (BOTH(0)) GRID_BAR(); }
    if (IN(1)) {
        pg8::Gemm g{F.HN, F.WinT, M, NPJ, DM}; pg8::StaticOrder S; S.init(M, NPJ, F.G, F.bid);
        pg8::EpiPJ E{F.PJ, NPJ / 256};
        pg8::gemm_phase<pg8::EpiPJ, pg8::StaticOrder, PG8_ALIGN, PG8_SP2>(F.lds, g, S, E);
        if (MK_DUP == 1) { GRID_BAR(); pg8::gemm_phase<pg8::EpiPJ, pg8::StaticOrder, PG8_ALIGN, PG8_SP2>(F.lds, g, S, E); }
        if (BOTH(1)) GRID_BAR();
    }
    if (IN(2)) { p2a_scan(F); if (MK_DUP == 2) { GRID_BAR(); p2a_scan(F); } if (BOTH(2)) GRID_BAR(); }
    if (IN(3)) { p2b_scan(F); if (MK_DUP == 3) { GRID_BAR(); p2b_scan(F); } if (BOTH(3)) GRID_BAR(); }
    if (IN(4)) {
        pg8::Gemm g{F.MIX, F.WoutT, M, DM, DM}; pg8::PanelOrder S{F.bid};
        pg8::EpiFinal E{F.x, F.out, F.final_w, (float*)(ws + WS_XCH), (unsigned*)(ws + WS_CTL) + CW_PANEL, F.lds + 131072};
        pg8::gemm_phase<pg8::EpiFinal, pg8::PanelOrder, true, PG8_SP2>(F.lds, g, S, E);
    }
#undef IN
#undef BOTH
}

extern "C" void kernel_launch(void* const* d_in, const int* in_sizes, int n_in, void* d_out, int out_size, void* d_ws, size_t ws_size, hipStream_t stream) {
    static int grid = 0;
    if (grid == 0) {
        if (n_in != 10 || in_sizes[0] != M * DM || out_size != M * DM || ws_size < WS_END) { fprintf(stderr, "kernel_launch: unexpected shapes (n_in %d, in0 %d, out %d, ws %zu)\n", n_in, n_in > 0 ? in_sizes[0] : -1, out_size, ws_size); grid = -1; return; }
        int dev = 0, cus = 0, per_cu = 0;
        if (hipGetDevice(&dev) != hipSuccess || hipDeviceGetAttribute(&cus, hipDeviceAttributeMultiprocessorCount, dev) != hipSuccess) { grid = -1; return; }
        if (hipFuncSetAttribute((const void*)mk_fwd, hipFuncAttributeMaxDynamicSharedMemorySize, LDS_BYTES) != hipSuccess) { fprintf(stderr, "kernel_launch: hipFuncSetAttribute failed\n"); grid = -1; return; }
        if (hipOccupancyMaxActiveBlocksPerMultiprocessor(&per_cu, (const void*)mk_fwd, NTHREADS, LDS_BYTES) != hipSuccess || per_cu < 1) { fprintf(stderr, "kernel_launch: occupancy query says %d blocks per CU\n", per_cu); grid = -1; return; }
        (void)hipGetLastError();
        grid = cus;
        if (grid < 256) { fprintf(stderr, "kernel_launch: %d CUs; the scan phases need 256 workgroups\n", grid); grid = -1; return; }
        grid = 256;
    }
    if (grid < 0) return;
    (void)hipMemsetAsync((char*)d_ws + WS_CTL, 0, CTL_ZERO_BYTES, stream);
    Args a{};
    for (int i = 0; i < 10; ++i) a.in[i] = (const float*)d_in[i];
    a.out = (float*)d_out; a.ws = (unsigned char*)d_ws;
#if MK_ONE_LAUNCH
    a.ph_lo = 0; a.ph_hi = 5;
    void* kargs[] = {&a};
    hipError_t e = hipLaunchCooperativeKernel((const void*)mk_fwd, dim3(grid), dim3(NTHREADS), kargs, LDS_BYTES, stream);
    if (e != hipSuccess) fprintf(stderr, "kernel_launch: cooperative launch failed: %s (grid %d)\n", hipGetErrorString(e), grid);
#else
    for (int p = 0; p < 5; ++p) { a.ph_lo = p; a.ph_hi = p + 1; hipLaunchKernelGGL(mk_fwd, dim3(grid), dim3(NTHREADS), LDS_BYTES, stream, a); }
#endif
}
```

```cpp
#include <hip/hip_runtime.h>
#include <cstdio>
#include <cstdint>
#ifndef MK_ONE_LAUNCH
#define MK_ONE_LAUNCH 1
#ifndef MK_ASTEP
#define MK_ASTEP 256
#endif
#endif
namespace pg8 {
#define PG8_LAS __attribute__((address_space(3)))
typedef unsigned short bf16_t;
typedef short bf16x8 __attribute__((ext_vector_type(8)));
typedef float f32x4 __attribute__((ext_vector_type(4)));
typedef unsigned u32x4 __attribute__((ext_vector_type(4)));
constexpr int BM = 256, BK = 64, HALF = 128, HTB = HALF * BK * 2  , STAGE_BYTES = 8 * HTB, NXCD = 8, WGM = 8;

__host__ __device__ __forceinline__ int lds_byte(int r, int c) { const int st = (r >> 4) * 2 + (c >> 5), rr = r & 15, cc = c & 31, ob = rr * 64 + cc * 2; return st * 1024 + (ob ^ (((ob >> 9) & 1) << 5)); }
__host__ __device__ __forceinline__ void stage_rc(int b, int& R, int& C) { const int st = b / 1024, sb = b % 1024, swz = sb ^ (((sb >> 9) & 1) << 5); R = (st >> 1) * 16 + swz / 64; C = (st & 1) * 32 + (swz % 64) / 2; }
__host__ __device__ __forceinline__ int perm32(int rho) { const int n = rho >> 4, i = rho & 15; return 8 * (i >> 2) + 4 * n + (i & 3); }

struct Unit { int pm, pn; };
struct Gemm { const bf16_t* A; const bf16_t* Bt; int M, N, K; };

struct StaticOrder {
    int nM, nN, nwg, G, c;
    __host__ __device__ void init(int M, int N, int G_, int c_) { nM = M / BM; nN = N / BM; nwg = nM * nN; G = G_; c = c_; }
    __host__ __device__ bool next(int i, Unit& u) const {
        const long L = (long)i * G + c; if (L >= nwg) return false;
        int wgid = (int)L; { const int q = nwg / NXCD, r = nwg % NXCD, xcd = wgid % NXCD, off = wgid / NXCD; wgid = (xcd < r ? xcd * (q + 1) : r * (q + 1) + (xcd - r) * q) + off; }
        const int nig = WGM * nN, gid = wgid / nig, fm = gid * WGM, gsz = (nM - fm) < WGM ? (nM - fm) : WGM;
        u.pm = fm + ((wgid % nig) % gsz); u.pn = (wgid % nig) / gsz;
        if (nN == 28) u.pn = (int)((0x1540362u >> (4 * (u.pn >> 2))) & 15u) * 4 + (u.pn & 3);
        return true;
    }
    __device__ __forceinline__ void a_ready(const Unit&) const {}
    __device__ __forceinline__ void done(const Unit&) const {}
};

__device__ __forceinline__ unsigned cvt_pk_bf16(float lo, float hi) { unsigned r; asm volatile("v_cvt_pk_bf16_f32 %0, %1, %2" : "=v"(r) : "v"(lo), "v"(hi)); return r; }
typedef float f32x2 __attribute__((ext_vector_type(2)));
struct EpiPJ {
    static constexpr bool PERM = true, AFTER_DRAIN = false;
    bf16_t* O; int ntn;
    __device__ __forceinline__ void operator()(const f32x4 (&acc)[2][2][4][2], const Unit& u, int wr, int wc, int fr, int fq) const {
        bf16_t* base = O + ((size_t)(u.pm * ntn + u.pn) << 16) + (wr * 64 + fr) * 256 + wc * 32 + 8 * fq;
#pragma unroll
        for (int ai = 0; ai < 2; ++ai)
#pragma unroll
            for (int m = 0; m < 4; ++m) { bf16_t* rowp = base + (ai * HALF + m * 16) * 256;
#pragma unroll
                for (int bj = 0; bj < 2; ++bj) { const f32x4 v0 = acc[ai][bj][m][0], v1 = acc[ai][bj][m][1];
                    u32x4 w; w.x = cvt_pk_bf16(v0[0], v0[1]); w.y = cvt_pk_bf16(v0[2], v0[3]); w.z = cvt_pk_bf16(v1[0], v1[1]); w.w = cvt_pk_bf16(v1[2], v1[3]);
                    *(u32x4*)(rowp + bj * HALF) = w; } }
    }
};
struct PanelOrder {
    int c;
    __device__ __forceinline__ bool next(int i, Unit& u) const { if (i >= 2) return false; const int x = c & 7, k = c >> 3; u.pm = 32 * i + 4 * x + (k & 3); u.pn = k >> 2; return true; }
    __device__ __forceinline__ void a_ready(const Unit&) const {}
    __device__ __forceinline__ void done(const Unit&) const {}
};
struct EpiFinal {
    static constexpr bool PERM = false, AFTER_DRAIN = false;
    const float* base; float* out; const float* fw; float* xch; unsigned* cnt; PG8_LAS unsigned char* lds;
    __device__ __forceinline__ void operator()(f32x4 (&acc)[2][2][4][2], const Unit& u, int wr, int wc, int fr, int fq) const {
        const int tid = threadIdx.x, wid = __builtin_amdgcn_readfirstlane(tid >> 6), lane = tid & 63;
        PG8_LAS float* P = (PG8_LAS float*)lds; PG8_LAS float* R = (PG8_LAS float*)(lds + 4096);
        const int row0 = u.pm * BM + wr * 64 + fr, col0 = u.pn * BM + wc * 32 + 4 * fq;
#pragma unroll
        for (int ai = 0; ai < 2; ++ai)
#pragma unroll
            for (int m = 0; m < 4; ++m) { const size_t off = (size_t)(row0 + ai * HALF + m * 16) * 2048 + col0; float s = 0.f;
#pragma unroll
                for (int bj = 0; bj < 2; ++bj)
#pragma unroll
                    for (int n = 0; n < 2; ++n) { const f32x4 v = *(const f32x4*)(base + off + bj * HALF + n * 16) + acc[ai][bj][m][n]; acc[ai][bj][m][n] = v; s += (v[0] * v[0] + v[1] * v[1]) + (v[2] * v[2] + v[3] * v[3]); }
                s += __shfl_xor(s, 16); s += __shfl_xor(s, 32);
                if (fq == 0) P[(ai * HALF + wr * 64 + m * 16 + fr) * 4 + wc] = s;
                asm volatile("" ::: "memory"); }
        asm volatile("s_waitcnt lgkmcnt(0)" ::: "memory"); __builtin_amdgcn_s_barrier(); asm volatile("" ::: "memory");
        if (wid < 4) {
            const f32x4 p = *(const PG8_LAS f32x4*)(P + tid * 4);
            __hip_atomic_store(xch + (size_t)(u.pm * 8 + u.pn) * 256 + tid, (p[0] + p[1]) + (p[2] + p[3]), __ATOMIC_RELAXED, __HIP_MEMORY_SCOPE_AGENT);
            asm volatile("s_waitcnt vmcnt(0)" ::: "memory");
            if (lane == 0) __hip_atomic_fetch_add(cnt + 64 * u.pm, 1u, __ATOMIC_RELAXED, __HIP_MEMORY_SCOPE_AGENT);
        }
        if (wid == 0) {
            unsigned sp = 0;
            while ((unsigned)__builtin_amdgcn_readfirstlane(__hip_atomic_load(cnt + 64 * u.pm, __ATOMIC_RELAXED, __HIP_MEMORY_SCOPE_AGENT)) < 32u) { __builtin_amdgcn_s_sleep(1); if (++sp > (1u << 22)) break; }
            __builtin_amdgcn_fence(__ATOMIC_ACQUIRE, "agent");
        }
        asm volatile("s_waitcnt vmcnt(0) lgkmcnt(0)" ::: "memory"); __builtin_amdgcn_s_barrier(); asm volatile("" ::: "memory");
        if (wid < 4) { float t = 0.f;
#pragma unroll
            for (int q = 0; q < 8; ++q) t += __hip_atomic_load(xch + (size_t)(u.pm * 8 + q) * 256 + tid, __ATOMIC_RELAXED, __HIP_MEMORY_SCOPE_AGENT);
            R[tid] = __builtin_amdgcn_rsqf(t * (1.0f / 2048.0f) + 1e-6f); }
        asm volatile("s_waitcnt lgkmcnt(0)" ::: "memory"); __builtin_amdgcn_s_barrier(); asm volatile("" ::: "memory");
        f32x4 wv[2][2];
#pragma unroll
        for (int bj = 0; bj < 2; ++bj)
#pragma unroll
            for (int n = 0; n < 2; ++n) wv[bj][n] = *(const f32x4*)(fw + col0 + bj * HALF + n * 16);
#pragma unroll
        for (int ai = 0; ai < 2; ++ai)
#pragma unroll
            for (int m = 0; m < 4; ++m) { const float rs = R[ai * HALF + wr * 64 + m * 16 + fr]; const size_t off = (size_t)(row0 + ai * HALF + m * 16) * 2048 + col0;
#pragma unroll
                for (int bj = 0; bj < 2; ++bj)
#pragma unroll
                    for (int n = 0; n < 2; ++n) *(f32x4*)(out + off + bj * HALF + n * 16) = acc[ai][bj][m][n] * rs * wv[bj][n]; }
    }
};
template <class Epi, class Sched, bool ALIGN_EPI = false, bool SP2 = false>
__device__ __forceinline__ void gemm_phase(PG8_LAS unsigned char* lds, const Gemm g, const Sched& S, const Epi& E) {
    const int tid = threadIdx.x, wid = __builtin_amdgcn_readfirstlane(tid >> 6), lane = tid & 63, wr = wid >> 2, wc = wid & 3, fr = lane & 15, fq = lane >> 4;
    const int K = g.K, nt = K / BK;
    unsigned voffA[2], voffB[2];
#pragma unroll
    for (int i = 0; i < 2; ++i) { int R, C; stage_rc(tid * 16 + i * 8192, R, C); const int Rb = Epi::PERM ? ((R & ~31) + perm32(R & 31)) : R;
        voffA[i] = (unsigned)(R * K + C) * 2u; voffB[i] = (unsigned)(Rb * K + C) * 2u; }
    const size_t kstep = (size_t)(BK * 2);
    const size_t hstep = (size_t)HALF * K * 2;
    const size_t tstep = 2 * hstep;
    const unsigned ldsw = (unsigned)wid * 1024u;
    const int aoff = lds_byte(wr * 64 + fr, fq * 8), boff = lds_byte(wc * 32 + fr, fq * 8);
#define PG8_SA(b, h) (((b) * 2 + (h)) * HTB)
#define PG8_SB(b, h) ((4 + (b) * 2 + (h)) * HTB)
#define PG8_STAGE(bufoff, gbase, voff) do { _Pragma("unroll") for (int _i = 0; _i < 2; ++_i) \
        __builtin_amdgcn_global_load_lds((const unsigned*)((const char*)(gbase) + (voff)[_i]), (PG8_LAS unsigned*)(lds + (bufoff) + ldsw + _i * 8192), 16, 0, 0); } while (0)
#define PG8_LDA(dst, b, h) do { _Pragma("unroll") for (int m = 0; m < 4; ++m) _Pragma("unroll") for (int k = 0; k < 2; ++k) dst[m][k] = *(const PG8_LAS bf16x8*)(lds + PG8_SA(b, h) + aoff + m * 2048 + k * 1024); } while (0)
#define PG8_LDB(dst, b, h) do { _Pragma("unroll") for (int n = 0; n < 2; ++n) _Pragma("unroll") for (int k = 0; k < 2; ++k) dst[n][k] = *(const PG8_LAS bf16x8*)(lds + PG8_SB(b, h) + boff + n * 2048 + k * 1024); } while (0)
#define PG8_MMA(ai, bj, At, Bt) do { __builtin_amdgcn_s_setprio(1); _Pragma("unroll") for (int m = 0; m < 4; ++m) _Pragma("unroll") for (int n = 0; n < 2; ++n) _Pragma("unroll") for (int k = 0; k < 2; ++k) \
        acc[ai][bj][m][n] = __builtin_amdgcn_mfma_f32_16x16x32_bf16(Bt[n][k], At[m][k], acc[ai][bj][m][n], 0, 0, 0); __builtin_amdgcn_s_setprio(0); } while (0)
#define PG8_WAIT_V(n) asm volatile("s_waitcnt vmcnt(" #n ")" ::: "memory")
#define PG8_WAIT_L(n) asm volatile("s_waitcnt lgkmcnt(" #n ")" ::: "memory")
#define PG8_BAR __builtin_amdgcn_s_barrier()
#define PG8_SCHED __builtin_amdgcn_sched_barrier(0)
    Unit cur, nxt; int ui = 0;
    if (!S.next(0, cur)) return;
    f32x4 acc[2][2][4][2];
#pragma unroll
    for (int a = 0; a < 2; ++a)
#pragma unroll
        for (int b = 0; b < 2; ++b)
#pragma unroll
            for (int m = 0; m < 4; ++m)
#pragma unroll
                for (int n = 0; n < 2; ++n) acc[a][b][m][n] = (f32x4){0.f, 0.f, 0.f, 0.f};
    bf16x8 At[4][2], B0[2][2], B1[2][2];
    const char* cA = (const char*)g.A + (size_t)cur.pm * tstep; const char* cB = (const char*)g.Bt + (size_t)cur.pn * tstep;
    S.a_ready(cur);
    if constexpr (SP2) {
        PG8_STAGE(PG8_SB(0, 0), cB, voffB); PG8_STAGE(PG8_SB(0, 1), cB + hstep, voffB); PG8_STAGE(PG8_SA(0, 0), cA, voffA); PG8_STAGE(PG8_SA(0, 1), cA + hstep, voffA);
        if (wr == 1) PG8_BAR;
        PG8_WAIT_V(2); PG8_BAR;
        PG8_STAGE(PG8_SB(1, 0), cB + kstep, voffB); PG8_STAGE(PG8_SA(1, 0), cA + kstep, voffA); PG8_STAGE(PG8_SB(1, 1), cB + hstep + kstep, voffB);
        PG8_WAIT_V(6); PG8_BAR;
    } else {
        PG8_STAGE(PG8_SB(0, 0), cB, voffB); PG8_STAGE(PG8_SA(0, 0), cA, voffA); PG8_STAGE(PG8_SB(0, 1), cB + hstep, voffB); PG8_STAGE(PG8_SA(0, 1), cA + hstep, voffA);
        if (wr == 1) PG8_BAR;
        PG8_WAIT_V(4); PG8_BAR;
        PG8_STAGE(PG8_SB(1, 0), cB + kstep, voffB); PG8_STAGE(PG8_SA(1, 0), cA + kstep, voffA); PG8_STAGE(PG8_SB(1, 1), cB + hstep + kstep, voffB);
        PG8_WAIT_V(6); PG8_BAR;
    }
    for (;;) {
        const bool has_next = S.next(ui + 1, nxt);
        const char* nA = has_next ? (const char*)g.A + (size_t)nxt.pm * tstep : cA; const char* nB = has_next ? (const char*)g.Bt + (size_t)nxt.pn * tstep : cB;
        for (int t = 0; t < nt; t += 2) {
            const bool last = (t == nt - 2);
            const char* a1 = cA + (size_t)(t + 1) * kstep;
            const char* a2 = last ? nA : cA + (size_t)(t + 2) * kstep; const char* b2 = last ? nB : cB + (size_t)(t + 2) * kstep;
            const char* a3 = a2 + kstep; const char* b3 = b2 + kstep;
            if (last && has_next) S.a_ready(nxt);
            if constexpr (SP2) {
            PG8_LDB(B0, 0, 0); PG8_LDB(B1, 0, 1); PG8_SCHED; PG8_LDA(At, 0, 0); PG8_STAGE(PG8_SA(1, 1), a1 + hstep, voffA);
            PG8_WAIT_V(8); PG8_WAIT_L(0); PG8_BAR; PG8_MMA(0, 0, At, B0); PG8_MMA(0, 1, At, B1); PG8_BAR; PG8_SCHED;
            PG8_LDA(At, 0, 1); PG8_STAGE(PG8_SB(0, 0), b2, voffB); PG8_STAGE(PG8_SB(0, 1), b2 + hstep, voffB); PG8_STAGE(PG8_SA(0, 0), a2, voffA);
            PG8_WAIT_V(8); PG8_WAIT_L(0); PG8_BAR; PG8_MMA(1, 0, At, B0); PG8_MMA(1, 1, At, B1); PG8_BAR; PG8_SCHED;
            PG8_LDB(B0, 1, 0); PG8_LDB(B1, 1, 1); PG8_SCHED; PG8_LDA(At, 1, 0); PG8_STAGE(PG8_SA(0, 1), a2 + hstep, voffA);
            PG8_WAIT_V(8); PG8_WAIT_L(0); PG8_BAR; PG8_MMA(0, 0, At, B0); PG8_MMA(0, 1, At, B1); PG8_BAR; PG8_SCHED;
            PG8_LDA(At, 1, 1); PG8_STAGE(PG8_SB(1, 0), b3, voffB); PG8_STAGE(PG8_SB(1, 1), b3 + hstep, voffB); PG8_STAGE(PG8_SA(1, 0), a3, voffA);
            PG8_WAIT_V(8); PG8_WAIT_L(0); PG8_BAR; PG8_MMA(1, 0, At, B0); PG8_MMA(1, 1, At, B1); PG8_BAR; PG8_SCHED;
            } else {
            PG8_LDB(B0, 0, 0); PG8_SCHED; PG8_LDA(At, 0, 0); PG8_STAGE(PG8_SA(1, 1), a1 + hstep, voffA);
            PG8_WAIT_L(8); PG8_BAR; PG8_WAIT_L(0); PG8_MMA(0, 0, At, B0); PG8_BAR; PG8_SCHED;
            PG8_LDB(B1, 0, 1); PG8_STAGE(PG8_SB(0, 0), b2, voffB);
            PG8_BAR; PG8_WAIT_L(0); PG8_MMA(0, 1, At, B1); PG8_BAR;
            PG8_LDA(At, 0, 1); PG8_STAGE(PG8_SA(0, 0), a2, voffA);
            PG8_BAR; PG8_WAIT_L(0); PG8_MMA(1, 0, At, B0); PG8_BAR; PG8_SCHED;
            PG8_STAGE(PG8_SB(0, 1), b2 + hstep, voffB);
            PG8_WAIT_V(6); PG8_BAR; PG8_MMA(1, 1, At, B1); PG8_BAR;
            PG8_LDB(B0, 1, 0); PG8_SCHED; PG8_LDA(At, 1, 0); PG8_STAGE(PG8_SA(0, 1), a2 + hstep, voffA);
            PG8_WAIT_L(8); PG8_BAR; PG8_WAIT_L(0); PG8_MMA(0, 0, At, B0); PG8_BAR; PG8_SCHED;
            PG8_LDB(B1, 1, 1); PG8_STAGE(PG8_SB(1, 0), b3, voffB);
            PG8_BAR; PG8_WAIT_L(0); PG8_MMA(0, 1, At, B1); PG8_BAR;
            PG8_LDA(At, 1, 1); PG8_STAGE(PG8_SA(1, 0), a3, voffA);
            PG8_BAR; PG8_WAIT_L(0); PG8_MMA(1, 0, At, B0); PG8_BAR; PG8_SCHED;
            PG8_STAGE(PG8_SB(1, 1), b3 + hstep, voffB);
            PG8_WAIT_V(6); PG8_BAR; PG8_MMA(1, 1, At, B1); PG8_BAR;
            }
        }
        if constexpr (ALIGN_EPI) { if (wr == 0) PG8_BAR; }
        if constexpr (!Epi::AFTER_DRAIN) { E(acc, cur, wr, wc, fr, fq); S.done(cur); }
        if (!has_next) break;
#pragma unroll
        for (int a = 0; a < 2; ++a)
#pragma unroll
            for (int b = 0; b < 2; ++b)
#pragma unroll
                for (int m = 0; m < 4; ++m)
#pragma unroll
                    for (int n = 0; n < 2; ++n) acc[a][b][m][n] = (f32x4){0.f, 0.f, 0.f, 0.f};
        cur = nxt; cA = nA; cB = nB; ++ui;
        if constexpr (ALIGN_EPI) { if (wr == 1) PG8_BAR; }
    }
    PG8_WAIT_V(0);
    if constexpr (!ALIGN_EPI) { if (wr == 0) PG8_BAR; }
    PG8_BAR;
    if constexpr (Epi::AFTER_DRAIN) { E.fused(acc, cur, wr, wc, fr, fq, lds, wid, lane); S.done(cur); }
#undef PG8_SA
#undef PG8_SB
#undef PG8_STAGE
#undef PG8_LDA
#undef PG8_LDB
#undef PG8_MMA
#undef PG8_WAIT_V
#undef PG8_WAIT_L
#undef PG8_BAR
#undef PG8_SCHED
}
}
#ifndef PG8_SP2
#define PG8_SP2 true
#endif
#ifndef PG8_ALIGN
#define PG8_ALIGN true
#endif

constexpr int NWAVES = 8, NTHREADS = NWAVES * 64;
constexpr int DM = 2048, NBATCH = 4, SEQ = 4096, M = NBATCH * SEQ;
constexpr int NPROJ_IN = 7184;
constexpr int NPJ = 7168;
constexpr int C_GQ = 0, C_GK = 512, C_GV = 1024, C_GG = 2048, C_HQ = 3072, C_HF = 4096, C_HI = 5120, C_HG = 6144;
constexpr int SRC_GLR = 3072;
constexpr float EPS = 1e-6f, QSCALE = 0.08838834764831845f, INV_TAU = 1.0f / 16.0f;
constexpr int CHUNK = 64, NCHUNK = SEQ / CHUNK;

constexpr size_t MiB = 1u << 20;
constexpr size_t WS_CTL = 0, CTL_ZERO_BYTES = 128 * 1024;
constexpr size_t WS_WINT = 2 * MiB;
constexpr size_t WS_WOUTT = 30 * MiB;
constexpr size_t WS_XCH = 40 * MiB;
constexpr size_t WS_GLR = 39 * MiB;
constexpr size_t WS_HN = 64 * MiB;
constexpr size_t WS_MIX = 128 * MiB;
constexpr size_t WS_PJ = 192 * MiB;
constexpr size_t WS_END = 416 * MiB;

constexpr int LDS_BYTES = 163840;
constexpr int QK_STRIDE = 272, KT_STRIDE = 320, L_QT = 0, L_KT = 64 * QK_STRIDE, L_VR = L_KT + 64 * KT_STRIDE, L_AM = L_VR + 64 * 576;
constexpr int L_TOT = L_AM + 64 * 144, L_FAC = L_TOT + 8 * 128 * 4, L_SS = L_FAC + 128 * 4, L_RS = L_SS + 8 * 64 * 4, L_LG = L_RS + 64 * 4, L_KS = L_LG + 64 * 128 * 4, L_SCAN_END = L_KS + 64 * 128 * 4;
static_assert(L_SCAN_END <= LDS_BYTES - 128, "scan LDS map");

#define LAS __attribute__((address_space(3)))
typedef unsigned short bf16;
typedef float f32x4 __attribute__((ext_vector_type(4)));
typedef float f32x2 __attribute__((ext_vector_type(2)));
typedef float f32x16 __attribute__((ext_vector_type(16)));
typedef short bf16x8 __attribute__((ext_vector_type(8)));
typedef short s16x4 __attribute__((ext_vector_type(4)));
typedef unsigned u32x4 __attribute__((ext_vector_type(4)));
typedef unsigned u32x2 __attribute__((ext_vector_type(2)));
typedef __bf16 bf16x2_t __attribute__((ext_vector_type(2)));
#define MFMA32(a, b, c) __builtin_amdgcn_mfma_f32_32x32x16_bf16((a), (b), (c), 0, 0, 0)

__device__ __forceinline__ unsigned pk2(float lo, float hi) { const bf16x2_t v = __builtin_convertvector((f32x2){lo, hi}, bf16x2_t); return __builtin_bit_cast(unsigned, v); }
__device__ __forceinline__ float bf_lo(unsigned u) { return __uint_as_float(u << 16); }
__device__ __forceinline__ float bf_hi(unsigned u) { return __uint_as_float(u & 0xffff0000u); }
__device__ __forceinline__ float wave_sum(float v) {
#pragma unroll
    for (int o = 1; o < 64; o <<= 1) v += __shfl_xor(v, o);
    return v;
}
constexpr float LOG2E = 1.4426950408889634f, LOG2_QSCALE = -3.5f;
__device__ __forceinline__ void split_bf16(const float (&x)[8], bf16x8& hi, bf16x8& lo) {
    u32x4 h, l;
#pragma unroll
    for (int p = 0; p < 4; ++p) { const unsigned hp = pk2(x[2 * p], x[2 * p + 1]); h[p] = hp; l[p] = pk2(x[2 * p] - bf_lo(hp), x[2 * p + 1] - bf_hi(hp)); }
    hi = __builtin_bit_cast(bf16x8, h); lo = __builtin_bit_cast(bf16x8, l);
}
__device__ __forceinline__ float row16_allsum(float x) {
    x += __builtin_bit_cast(float, __builtin_amdgcn_update_dpp(0, __builtin_bit_cast(int, x), 0x121, 0xf, 0xf, false));
    x += __builtin_bit_cast(float, __builtin_amdgcn_update_dpp(0, __builtin_bit_cast(int, x), 0x122, 0xf, 0xf, false));
    x += __builtin_bit_cast(float, __builtin_amdgcn_update_dpp(0, __builtin_bit_cast(int, x), 0x124, 0xf, 0xf, false));
    x += __builtin_bit_cast(float, __builtin_amdgcn_update_dpp(0, __builtin_bit_cast(int, x), 0x128, 0xf, 0xf, false));
    return x;
}
__device__ __forceinline__ void bstore128_wt(u32x4 w, __amdgpu_buffer_rsrc_t rs, unsigned voff, unsigned soff) {
    __builtin_amdgcn_raw_buffer_store_b128(w, rs, voff, soff, 16);
    asm volatile("s_nop 1" :: "v"(w));
}
__device__ __forceinline__ void bstore128(u32x4 w, __amdgpu_buffer_rsrc_t rs, unsigned voff, unsigned soff) {
    __builtin_amdgcn_raw_buffer_store_b128(w, rs, voff, soff, 0);
    asm volatile("s_nop 1" :: "v"(w));
}
__device__ __forceinline__ float ex2(float x) { return __builtin_amdgcn_exp2f(x); }
__device__ __forceinline__ float lg2(float x) { return __builtin_amdgcn_logf(x); }
__device__ __forceinline__ float fsig(float x) { return __builtin_amdgcn_rcpf(1.0f + ex2(-LOG2E * x)); }

#define XB_TMO      128
#define XB_XCNT(j)  (256  + 64 * (j))
#define XB_XSUB(j)  (1280 + 64 * (j))
#define XB_XGEN(j)  (2304 + 64 * (j))
#define XB_TOP      3328
#define XB_TOPGEN   3392
#define XCD_BAR_WORDS 3456
#define XB_SPIN_CAP (1u << 18)

__device__ __forceinline__ unsigned xb_ld(unsigned* p)              { return __hip_atomic_load(p, __ATOMIC_RELAXED, __HIP_MEMORY_SCOPE_AGENT); }
__device__ __forceinline__ unsigned xb_add(unsigned* p, unsigned v) { return __hip_atomic_fetch_add(p, v, __ATOMIC_RELAXED, __HIP_MEMORY_SCOPE_AGENT); }
__device__ __forceinline__ unsigned xb_xcc_id() { return (unsigned)__builtin_amdgcn_s_getreg((3 << 11) | 20) & 0xFu; }
#define XB_SPIN(cond, bar) do { unsigned _sp = 0; while (cond) { __builtin_amdgcn_s_sleep(1); \
    if ((++_sp & 255u) == 0u) { if (xb_ld(&(bar)[XB_TMO])) break; if (_sp > XB_SPIN_CAP) { atomicAdd(&(bar)[XB_TMO], 1u); break; } } } } while (0)

struct XcdBarrier {
    unsigned* bar; unsigned x;
    volatile LAS unsigned* st;
};

__device__ __forceinline__ XcdBarrier xcd_barrier_post(unsigned* bar, volatile LAS unsigned* st) {
    XcdBarrier b; b.bar = bar; b.x = xb_xcc_id(); b.st = st;
    if (threadIdx.x == 0) (void)xb_add(&bar[XB_XCNT(b.x)], 1u);
    return b;
}
__device__ __forceinline__ void xcd_barrier_complete(unsigned* bar, unsigned x, unsigned& nloc, unsigned& nx) {
    const unsigned G = gridDim.x * gridDim.y * gridDim.z;
    unsigned sum, cnt, mine, sp = 0u;
    for (;;) {
        sum = 0u; cnt = 0u; mine = 0u;
#pragma unroll
        for (unsigned j = 0; j < 16; ++j) { const unsigned c = xb_ld(&bar[XB_XCNT(j)]); sum += c; cnt += (c > 0u) ? 1u : 0u; mine = (j == x) ? c : mine; }
        if (sum == G) break;
        __builtin_amdgcn_s_sleep(1);
        if ((++sp & 255u) == 0u) { if (xb_ld(&bar[XB_TMO])) break; if (sp > XB_SPIN_CAP) { atomicAdd(&bar[XB_TMO], 1u); break; } }
    }
    nloc = mine > 0u ? mine : 1u; nx = cnt > 0u ? cnt : 1u;
}

__device__ __forceinline__ void xcd_barrier(const XcdBarrier& b) {
    asm volatile("s_waitcnt vmcnt(0)" ::: "memory");
    __syncthreads();
    if (threadIdx.x == 0) {
        unsigned* bar = b.bar;
        __builtin_amdgcn_s_waitcnt(0);
        unsigned nloc = b.st[0], nx = b.st[1];
        if (nloc == 0u) { xcd_barrier_complete(bar, b.x, nloc, nx); b.st[0] = nloc; b.st[1] = nx; }
        const unsigned old = xb_add(&bar[XB_XSUB(b.x)], 1u);
        const unsigned gen = old / nloc;
        if (old + 1u == (gen + 1u) * nloc) {
            __builtin_amdgcn_fence(__ATOMIC_RELEASE, "agent");
            asm volatile("s_waitcnt vmcnt(0)" ::: "memory");
            const unsigned og = xb_add(&bar[XB_TOP], 1u);
            const unsigned tg = og / nx;
            if (og + 1u == (tg + 1u) * nx) xb_add(&bar[XB_TOPGEN], 1u);
            else XB_SPIN(xb_ld(&bar[XB_TOPGEN]) == tg, bar);
            __builtin_amdgcn_fence(__ATOMIC_ACQUIRE, "agent");
            xb_add(&bar[XB_XGEN(b.x)], 1u);
            asm volatile("s_waitcnt vmcnt(0)" ::: "memory");
        } else {
            XB_SPIN(xb_ld(&bar[XB_XGEN(b.x)]) == gen, bar);
            __builtin_amdgcn_fence(__ATOMIC_ACQUIRE, "agent");
            asm volatile("s_waitcnt vmcnt(0)" ::: "memory");
        }
    }
    __syncthreads();
}

constexpr int CW_PANEL = 16384;
constexpr int CW_SEQ = 24576;
constexpr int CW_BAR = 4096;
constexpr int MISC_OFF = LDS_BYTES - 128;

struct Frame {
    LAS unsigned char* lds;
    int tid, lane, wave, G, bid;
    const float *x, *norm_w, *w_in, *gla_w_up, *gla_b_up, *gla_norm_w, *hgrn_lb, *hgrn_norm_w, *w_out, *final_w;
    float* out;
    bf16 *WinT, *WoutT, *HN, *MIX, *PJ;
    float* GLR;
    unsigned char* ws;
};

__device__ __forceinline__ void p0_transpose_item(const float* W, int ldw, int src_col, bf16* WT, int K, int dst_row, int kb, LAS float* scr, int lane) {
    const int k0 = 64 * kb;
#pragma unroll 8
    for (int i = 0; i < 32; ++i) { const int kk = 2 * i + (lane >> 5); scr[kk * 33 + (lane & 31)] = W[(size_t)(k0 + kk) * ldw + src_col + (lane & 31)]; }
    asm volatile("s_waitcnt lgkmcnt(0)" ::: "memory");
    const int c = lane & 7;
#pragma unroll
    for (int j = 0; j < 4; ++j) { const int n = (lane >> 3) + 8 * j; const LAS float* s = scr + (8 * c) * 33 + n;
        u32x4 o; o.x = pk2(s[0 * 33], s[1 * 33]); o.y = pk2(s[2 * 33], s[3 * 33]); o.z = pk2(s[4 * 33], s[5 * 33]); o.w = pk2(s[6 * 33], s[7 * 33]);
        *(u32x4*)(WT + (size_t)(dst_row + n) * K + k0 + 8 * c) = o; }
    asm volatile("s_waitcnt lgkmcnt(0)" ::: "memory");
}

__device__ __forceinline__ void p0_prologue(Frame& F) {
    const int gw = F.bid * NWAVES + F.wave, NGW = F.G * NWAVES;
    LAS float* Wt = (LAS float*)F.lds;
    for (int k = F.tid; k < DM; k += NTHREADS) {
        const f32x4* src = (const f32x4*)(F.w_in + (size_t)k * NPROJ_IN + SRC_GLR);
#pragma unroll
        for (int q = 0; q < 4; ++q) { const f32x4 v = src[q]; Wt[(4 * q + 0) * DM + k] = v[0]; Wt[(4 * q + 1) * DM + k] = v[1]; Wt[(4 * q + 2) * DM + k] = v[2]; Wt[(4 * q + 3) * DM + k] = v[3]; }
    }
    __syncthreads();
    f32x4 nw[8];
#pragma unroll
    for (int j = 0; j < 8; ++j) nw[j] = ((const f32x4*)F.norm_w)[64 * j + F.lane];
    const LAS f32x4* Wt4 = (const LAS f32x4*)Wt;
    for (int m = gw; m < M; m += NGW) {
        const f32x4* xr = (const f32x4*)(F.x + (size_t)m * DM) + F.lane;
        f32x4 v[8]; float s = 0.f;
#pragma unroll
        for (int j = 0; j < 8; ++j) { v[j] = xr[64 * j]; s += (v[j][0] * v[j][0] + v[j][1] * v[j][1]) + (v[j][2] * v[j][2] + v[j][3] * v[j][3]); }
        const float rstd = 1.0f / sqrtf(wave_sum(s) * (1.0f / DM) + EPS);
        float a[16];
#pragma unroll
        for (int c = 0; c < 16; ++c) a[c] = 0.f;
        u32x2* o8 = (u32x2*)(F.HN + (size_t)m * DM) + F.lane;
#pragma unroll
        for (int j = 0; j < 8; ++j) {
            v[j] = v[j] * rstd * nw[j];
            u32x2 w; w.x = pk2(v[j][0], v[j][1]); w.y = pk2(v[j][2], v[j][3]); o8[64 * j] = w;
            asm volatile("" ::: "memory");
#pragma unroll
            for (int c = 0; c < 16; ++c) { const f32x4 wv = Wt4[c * (DM / 4) + 64 * j + F.lane]; a[c] += (v[j][0] * wv[0] + v[j][1] * wv[1]) + (v[j][2] * wv[2] + v[j][3] * wv[3]); }
        }
        float mine = 0.f;
#pragma unroll
        for (int c = 0; c < 16; ++c) { const float t = wave_sum(a[c]); mine = (F.lane == c) ? t : mine; }
        if (F.lane < 16) F.GLR[(size_t)m * 16 + F.lane] = mine;
    }
    __syncthreads();
    {
        LAS float* scr = (LAS float*)(F.lds + F.wave * 16384);
        constexpr int KB = DM / 64;
        constexpr int I_IN = KB * (NPJ / 32), I_OUT = KB * (DM / 32);
        for (int it = gw; it < I_IN + (MK_ONE_LAUNCH ? 0 : I_OUT); it += NGW) {
            if (it < I_IN) { const int kb = it / (NPJ / 32), nb = it % (NPJ / 32), n0 = 32 * nb; const int src = n0 < SRC_GLR ? n0 : n0 + 16;
                p0_transpose_item(F.w_in, NPROJ_IN, src, F.WinT, DM, n0, kb, scr, F.lane); }
            else { const int r = it - I_IN, kb = r / (DM / 32), nb = r % (DM / 32);
                p0_transpose_item(F.w_out, DM, 32 * nb, F.WoutT, DM, 32 * nb, kb, scr, F.lane); }
        }
    }
    __syncthreads();
}

constexpr int NSEG_G = 8, NSEG_H = 4;
constexpr size_t WS_LG = WS_HN, WS_LH = WS_HN + 16 * MiB, WS_DG = WS_HN + 48 * MiB, WS_DH = WS_HN + 49 * MiB;
static_assert(16 * NSEG_G * 131072 <= 16 * MiB && 32 * NSEG_H * 65536 <= 32 * MiB, "L buffers");

__device__ __forceinline__ bf16x8 tr_frag(LAS unsigned char* img, unsigned lanebase, unsigned stride, unsigned c, unsigned ks) {
    const unsigned a0 = lanebase + (16 * ks) * stride + 64 * c;
    const s16x4 lo = __builtin_amdgcn_ds_read_tr16_b64_v4i16((LAS s16x4*)(img + a0));
    const s16x4 hi = __builtin_amdgcn_ds_read_tr16_b64_v4i16((LAS s16x4*)(img + a0 + 4 * stride));
    return __builtin_shufflevector(lo, hi, 0, 1, 2, 3, 4, 5, 6, 7);
}

template <int GLA, int PASSB>
__device__ __forceinline__ void scan_item(Frame& F, const int b, const int h, const int seg) {
    constexpr int dv = GLA ? 256 : 128, nmw = dv / 32, NSEG = GLA ? NSEG_G : NSEG_H, NC = NCHUNK / NSEG;
    constexpr unsigned vstride = 2 * dv + 64;
    constexpr int NVL = 64 * (dv / 8) / NTHREADS;
    constexpr int CPR = dv / 8, RPP = NTHREADS / CPR;
    constexpr int OS = dv * 4;
    const int tid = F.tid, lane = F.lane, wave = F.wave;
    LAS unsigned char* lds = F.lds;
    LAS unsigned char* QT = lds + L_QT; LAS unsigned char* KT = lds + L_KT; LAS unsigned char* VR = lds + L_VR; LAS unsigned char* AM = lds + L_AM;
    LAS float* TOT = (LAS float*)(lds + L_TOT); LAS float* FAC = (LAS float*)(lds + L_FAC); LAS float* NW = (LAS float*)(lds + L_SS);
    LAS float* LG = (LAS float*)(lds + L_LG); LAS float* KS = (LAS float*)(lds + L_KS);
    LAS unsigned char* O32 = lds + (GLA ? L_LG : L_KS);
    const int qcol = GLA ? C_GQ + h * 128 : C_HQ + h * 128, kcol = GLA ? C_GK + h * 128 : C_HF + h * 128;
    const int vcol = GLA ? C_GV + h * 256 : C_HI + h * 128, gcol = GLA ? C_GG + h * 256 : C_HG + h * 128;
    const int mcol = GLA ? h * 256 : 1024 + h * 128;
    const float* normw = GLA ? F.gla_norm_w + h * 256 : F.hgrn_norm_w + h * 128;
    const int dp = tid & 63, d0 = 2 * dp;
    const int item = GLA ? (b * 4 + h) * NSEG + seg : (b * 8 + h) * NSEG + seg;
    float* Lbase = (float*)(F.ws + (GLA ? WS_LG : WS_LH)); float* Dbase = (float*)(F.ws + (GLA ? WS_DG : WS_DH));
    constexpr int LSZ = 128 * dv;
    float lb0 = 0.f, lb1 = 0.f;
    if (!GLA) {
        const f32x2 l0 = *(const f32x2*)(F.hgrn_lb + h * 128 + d0), l1 = *(const f32x2*)(F.hgrn_lb + 1024 + h * 128 + d0);
        lb0 = 1.0f / (1.0f + __expf(l1[0] - l0[0])); lb1 = 1.0f / (1.0f + __expf(l1[1] - l0[1]));
    }
    unsigned warm = 0u;
    if (PASSB && seg > 0) {
        const unsigned t_row0 = (unsigned)(b * SEQ + seg * NC * CHUNK);
        const __amdgpu_buffer_rsrc_t rs_w = __builtin_amdgcn_make_buffer_rsrc((void*)F.PJ, 0, (int)((size_t)M * NPJ * 2), 0x00020000);
#define WPJB(T, COL) ((((((unsigned)(T)) >> 8) * (unsigned)(NPJ / 256) + (((unsigned)(COL)) >> 8)) << 17) + ((((unsigned)(T)) & 255u) << 9) + ((((unsigned)(COL)) & 255u) << 1))
        const unsigned wr_ = (unsigned)(tid & 63), wp = (unsigned)(tid >> 6);
        if (GLA) {
            const unsigned c1 = wp < 2 ? (unsigned)qcol : wp < 4 ? (unsigned)kcol : (unsigned)vcol, l1 = wp < 4 ? (wp & 1u) : wp - 4u;
            warm += __builtin_amdgcn_raw_buffer_load_b32(rs_w, wr_ * 512u + l1 * 128u, WPJB(t_row0, c1), 0);
            if (wp < 4) warm += __builtin_amdgcn_raw_buffer_load_b32(rs_w, wr_ * 512u + wp * 128u, WPJB(t_row0, gcol), 0);
            else if (wp == 4) warm += __float_as_uint(F.GLR[(size_t)(t_row0 + wr_) * 16]);
        } else {
            const unsigned c1 = wp < 2 ? (unsigned)qcol : wp < 4 ? (unsigned)kcol : wp < 6 ? (unsigned)vcol : (unsigned)gcol;
            warm += __builtin_amdgcn_raw_buffer_load_b32(rs_w, wr_ * 512u + (wp & 1u) * 128u, WPJB(t_row0, c1), 0);
        }
#undef WPJB
    }
    if (PASSB && seg > 0) {
        if (tid == 0) { unsigned* flag = (unsigned*)(F.ws + WS_CTL) + CW_SEQ + 64 * (GLA ? b * 4 + h : 16 + b * 8 + h); unsigned sp = 0;
            while (__hip_atomic_load(flag, __ATOMIC_RELAXED, __HIP_MEMORY_SCOPE_AGENT) < (unsigned)(NSEG - 1)) { __builtin_amdgcn_s_sleep(2); if (++sp > (1u << 21)) break; }
            __builtin_amdgcn_fence(__ATOMIC_ACQUIRE, "agent");
            asm volatile("s_waitcnt vmcnt(0)" ::: "memory"); }
        __syncthreads();
    }
    if (PASSB && tid < dv) NW[tid] = normw[tid];
    float elp0 = 1.f, elp1 = 1.f, dsum0 = GLA ? 0.f : 1.f, dsum1 = dsum0;
    const unsigned r = lane & 31, hh = lane >> 5;
    const unsigned tq = (lane & 15) >> 2, tp = lane & 3, tblk = (lane >> 4) & 1;
    const unsigned trk = (8 * hh + tq) * KT_STRIDE + 32 * tblk + 8 * tp, trv = (8 * hh + tq) * vstride + 32 * tblk + 8 * tp;
    const size_t row0 = (size_t)b * SEQ + (size_t)seg * NC * CHUNK;

    f32x16 S[4];
#pragma unroll
    for (int i = 0; i < 4; ++i)
#pragma unroll
        for (int j = 0; j < 16; ++j) S[i][j] = 0.f;
    if (PASSB) {
        constexpr int NS = NSEG - 1, BS = 3;
        LAS float* DS = (LAS float*)AM;
        const __amdgpu_buffer_rsrc_t rs_l = __builtin_amdgcn_make_buffer_rsrc((void*)Lbase, 0, (GLA ? 16 : 32) * NSEG * LSZ * 2, 0x00020000);
        u32x4 lv[BS][8];
#define FOLD_LD(SP0) do { _Pragma("unroll") for (int jj = 0; jj < BS; ++jj) { const int sp = (SP0) + jj; const bool ok = sp < seg; \
            const unsigned vo = (unsigned)lane * 16u + (ok ? 0u : 0x40000000u); const unsigned so = (unsigned)((item - seg + (ok ? sp : 0)) * (LSZ * 2) + wave * 8 * 1024); \
            _Pragma("unroll") for (int q = 0; q < 8; ++q) lv[jj][q] = __builtin_amdgcn_raw_buffer_load_b128(rs_l, vo, so + q * 1024, 0); } } while (0)
#define FOLD_FMA(SP0) do { _Pragma("unroll") for (int jj = 0; jj < BS; ++jj) { const int j = ((SP0) + jj < NS) ? (SP0) + jj : NS; \
            _Pragma("unroll") for (int db = 0; db < 4; ++db) _Pragma("unroll") for (int g2 = 0; g2 < 2; ++g2) { const u32x4 l = lv[jj][db * 2 + g2]; \
                const f32x4 da = *(const LAS f32x4*)(DS + j * 128 + 32 * db + 16 * g2 + 4 * hh), dbv = *(const LAS f32x4*)(DS + j * 128 + 32 * db + 16 * g2 + 8 + 4 * hh); \
                const float lf[8] = {bf_lo(l.x), bf_hi(l.x), bf_lo(l.y), bf_hi(l.y), bf_lo(l.z), bf_hi(l.z), bf_lo(l.w), bf_hi(l.w)}; \
                _Pragma("unroll") for (int e = 0; e < 4; ++e) { S[db][8 * g2 + e] = S[db][8 * g2 + e] * da[e] + lf[e]; S[db][8 * g2 + 4 + e] = S[db][8 * g2 + 4 + e] * dbv[e] + lf[4 + e]; } } } } while (0)
        float dreg[2];
#pragma unroll
        for (int q = 0; q < 2; ++q) { const int i = tid + q * NTHREADS, sp = i >> 7; dreg[q] = (sp < seg) ? Dbase[(size_t)(item - seg + sp) * 128 + (i & 127)] : 1.0f; }
        if (wave < nmw && seg > 0) FOLD_LD(0);
#pragma unroll
        for (int q = 0; q < 2; ++q) { const int i = tid + q * NTHREADS; if (i < (NS + 1) * 128) DS[i] = dreg[q]; }
        __syncthreads();
        if (wave < nmw && seg > 0) {
            FOLD_FMA(0);
            for (int sp0 = BS; sp0 < seg; sp0 += BS) { FOLD_LD(sp0); FOLD_FMA(sp0); }
        }
#undef FOLD_LD
#undef FOLD_FMA
    }
    asm volatile("" :: "v"(warm));
    bf16x8 wbh = {0, 0, 0, 0, 0, 0, 0, 0}, wbl = {0, 0, 0, 0, 0, 0, 0, 0}; float bub = 0.f;
    if (GLA) {
        if (PASSB && MK_ONE_LAUNCH && seg > 0) {
            const LAS unsigned* ST = (const LAS unsigned*)(lds + L_KS);
            u32x4 a, c2; a.x = ST[0 * NTHREADS + tid]; a.y = ST[1 * NTHREADS + tid]; a.z = ST[2 * NTHREADS + tid]; a.w = ST[3 * NTHREADS + tid];
            c2.x = ST[4 * NTHREADS + tid]; c2.y = ST[5 * NTHREADS + tid]; c2.z = ST[6 * NTHREADS + tid]; c2.w = ST[7 * NTHREADS + tid];
            wbh = __builtin_bit_cast(bf16x8, a); wbl = __builtin_bit_cast(bf16x8, c2); bub = __uint_as_float(ST[8 * NTHREADS + tid]);
        } else {
            const int col = h * 128 + 32 * (wave & 3) + (lane & 31);
            float wv[8];
#pragma unroll
            for (int j = 0; j < 8; ++j) wv[j] = F.gla_w_up[(size_t)(8 * (lane >> 5) + j) * 512 + col];
            split_bf16(wv, wbh, wbl);
            bub = F.gla_b_up[col];
        }
    }
    const __amdgpu_buffer_rsrc_t rs_pj = __builtin_amdgcn_make_buffer_rsrc((void*)F.PJ, 0, (int)((size_t)M * NPJ * 2), 0x00020000);
    const __amdgpu_buffer_rsrc_t rs_glr = __builtin_amdgcn_make_buffer_rsrc((void*)F.GLR, 0, M * 16 * 4, 0x00020000);
    const __amdgpu_buffer_rsrc_t rs_mix = __builtin_amdgcn_make_buffer_rsrc((void*)F.MIX, 0, (int)((size_t)M * DM * 2), 0x00020000);
    const unsigned vo_qk = 4 * dp, vo_g = ((lane & 31) * 16 + 8 * (lane >> 5)) * 4, vo_v = (tid / CPR) * 512 + (tid % CPR) * 16, vo_m = (tid / CPR) * (DM * 2) + (tid % CPR) * 16;
#define PJB(T, COL) ((((((unsigned)(T)) >> 8) * (unsigned)(NPJ / 256) + (((unsigned)(COL)) >> 8)) << 17) + ((((unsigned)(T)) & 255u) << 9) + ((((unsigned)(COL)) & 255u) << 1))
    unsigned nq[8], nk[8]; u32x4 ng[2]; u32x4 vn[NVL], gt[NVL], gn[NVL];
#define PF_K(T0) do { const unsigned _sk = PJB(T0, kcol) + 8 * wave * 512; _Pragma("unroll") for (int i = 0; i < 8; ++i) nk[i] = __builtin_amdgcn_raw_buffer_load_b32(rs_pj, vo_qk, _sk + i * 512, 0); } while (0)
#define PF_Q(T0) do { const unsigned _sq = PJB(T0, qcol) + 8 * wave * 512; _Pragma("unroll") for (int i = 0; i < 8; ++i) nq[i] = __builtin_amdgcn_raw_buffer_load_b32(rs_pj, vo_qk, _sq + i * 512, 0); } while (0)
#define PF_G(T0) do { const unsigned _sg = ((unsigned)(T0) + 32 * (wave >> 2)) * 64; ng[0] = __builtin_amdgcn_raw_buffer_load_b128(rs_glr, vo_g, _sg, 0); ng[1] = __builtin_amdgcn_raw_buffer_load_b128(rs_glr, vo_g, _sg + 16, 0); } while (0)
#define PF_V(T0) do { const unsigned _sv = PJB(T0, vcol); _Pragma("unroll") for (int j = 0; j < NVL; ++j) vn[j] = __builtin_amdgcn_raw_buffer_load_b128(rs_pj, vo_v, _sv + j * (RPP * 512), 0); } while (0)
#pragma unroll
    for (int i = 0; i < 8; ++i) nq[i] = 0u;
    ng[0] = (u32x4){0u, 0u, 0u, 0u}; ng[1] = ng[0];
    if (GLA) PF_G(row0); PF_K(row0); if (PASSB) PF_Q(row0); PF_V(row0);
    if (PASSB) { const unsigned _sv = PJB(row0, gcol);
#pragma unroll
        for (int j = 0; j < NVL; ++j) gt[j] = __builtin_amdgcn_raw_buffer_load_b128(rs_pj, vo_v, _sv + j * (RPP * 512), 0); }
    float lgr[16];
#pragma unroll
    for (int j = 0; j < 16; ++j) lgr[j] = 0.f;
#define GLA_Z() do { f32x16 z; _Pragma("unroll") for (int j = 0; j < 16; ++j) z[j] = 0.f; \
        { const float gv[8] = {__uint_as_float(ng[0].x), __uint_as_float(ng[0].y), __uint_as_float(ng[0].z), __uint_as_float(ng[0].w), __uint_as_float(ng[1].x), __uint_as_float(ng[1].y), __uint_as_float(ng[1].z), __uint_as_float(ng[1].w)}; \
          bf16x8 ah, al; split_bf16(gv, ah, al); \
          z = MFMA32(al, wbh, z); z = MFMA32(ah, wbl, z); z = MFMA32(ah, wbh, z); }     \
        _Pragma("unroll") for (int reg = 0; reg < 16; ++reg) { const float zz = z[reg] + bub; lgr[reg] = (fminf(zz, 0.f) * LOG2E - lg2(1.0f + ex2(-LOG2E * fabsf(zz)))) * INV_TAU; } } while (0)
    if (GLA) { GLA_Z(); PF_G(NC > 1 ? row0 + CHUNK : row0); }

    for (int c = 0; c < NC; ++c) {
        const size_t t0 = row0 + (size_t)c * CHUNK;
        const size_t tn = (c + 1 < NC) ? t0 + CHUNK : t0;
        if (PASSB) { const unsigned _sv = PJB(tn, gcol);
#pragma unroll
            for (int j = 0; j < NVL; ++j) gn[j] = __builtin_amdgcn_raw_buffer_load_b128(rs_pj, vo_v, _sv + j * (RPP * 512), 0); }
        float hk0[8], hk1[8], hc0[8], hc1[8];
        if (GLA) {
#pragma unroll
            for (int reg = 0; reg < 16; ++reg) { const int row = 32 * (wave >> 2) + (reg & 3) + 8 * (reg >> 2) + 4 * (lane >> 5);
                LG[row * 128 + 32 * (wave & 3) + (lane & 31)] = lgr[reg]; }
            __syncthreads();
        }
        {
            if (PASSB) {
#pragma unroll
                for (int j = 0; j < NVL; ++j) { const u32x4 g = gt[j]; u32x4 w;
                    w.x = pk2(bf_lo(g.x) * fsig(bf_lo(g.x)), bf_hi(g.x) * fsig(bf_hi(g.x))); w.y = pk2(bf_lo(g.y) * fsig(bf_lo(g.y)), bf_hi(g.y) * fsig(bf_hi(g.y)));
                    w.z = pk2(bf_lo(g.z) * fsig(bf_lo(g.z)), bf_hi(g.z) * fsig(bf_hi(g.z))); w.w = pk2(bf_lo(g.w) * fsig(bf_lo(g.w)), bf_hi(g.w) * fsig(bf_hi(g.w)));
                    gt[j] = w; asm volatile("" : "+v"(gt[j])); }
            }
            float cum0 = GLA ? 0.f : 1.f, cum1 = cum0;
#pragma unroll
            for (int i = 0; i < 8; ++i) {
                LAS f32x2* lgp = (LAS f32x2*)(LG + (8 * wave + i) * 128 + d0);
                if (GLA) { const f32x2 lgv = *lgp; cum0 += lgv[0]; cum1 += lgv[1]; *lgp = (f32x2){cum0, cum1}; }
                else if (PASSB) {
                    const unsigned kv = nk[i];
                    const float s0 = fsig(bf_lo(kv)), s1 = fsig(bf_hi(kv));
                    const float f0 = lb0 + (1.0f - lb0) * s0, f1 = lb1 + (1.0f - lb1) * s1;
                    cum0 *= f0; cum1 *= f1;
                    hk0[i] = 1.0f - f0; hk1[i] = 1.0f - f1; hc0[i] = cum0; hc1[i] = cum1;
                }
            }
            if (!GLA && !PASSB) {
#pragma unroll
                for (int i = 7; i >= 0; --i) {
                    const unsigned kv = nk[i];
                    const float s0 = fsig(bf_lo(kv)), s1 = fsig(bf_hi(kv));
                    const float f0 = lb0 + (1.0f - lb0) * s0, f1 = lb1 + (1.0f - lb1) * s1;
                    *(LAS f32x2*)(KS + (8 * wave + i) * 128 + d0) = (f32x2){(1.0f - f0) * cum0, (1.0f - f1) * cum1};
                    cum0 *= f0; cum1 *= f1;
                }
            }
            *(LAS f32x2*)(TOT + wave * 128 + d0) = (f32x2){cum0, cum1};
        }
        if (!GLA) PF_K(tn);
        __syncthreads();
        if (!GLA && !PASSB) {
            float off0 = 1.f, off1 = 1.f, bl0 = 1.f, bl1 = 1.f;
#pragma unroll
            for (int g = 0; g < 8; ++g) { const f32x2 tv = *(const LAS f32x2*)(TOT + g * 128 + d0);
                if (g > wave) { off0 *= tv[0]; off1 *= tv[1]; } bl0 *= tv[0]; bl1 *= tv[1]; }
#pragma unroll
            for (int i = 0; i < 8; ++i) { const f32x2 kv = *(const LAS f32x2*)(KS + (8 * wave + i) * 128 + d0);
                *(LAS unsigned*)(KT + (8 * wave + i) * KT_STRIDE + 4 * dp) = pk2(kv[0] * off0, kv[1] * off1); }
            if (wave == 0) { *(LAS f32x2*)(FAC + d0) = (f32x2){bl0, bl1}; dsum0 *= bl0; dsum1 *= bl1; }
        } else if (!GLA) {
            float off0 = 1.f, off1 = 1.f, r0 = 1.f, r1 = 1.f, bl0 = 1.f, bl1 = 1.f;
#pragma unroll
            for (int g = 0; g < 8; ++g) { const f32x2 tv = *(const LAS f32x2*)(TOT + g * 128 + d0);
                if (g < wave) { off0 *= tv[0]; off1 *= tv[1]; } if (g < 4) { r0 *= tv[0]; r1 *= tv[1]; } bl0 *= tv[0]; bl1 *= tv[1]; }
            const float ir0 = __builtin_amdgcn_rcpf(r0), ir1 = __builtin_amdgcn_rcpf(r1);
            off0 *= ir0; off1 *= ir1;
#pragma unroll
            for (int i = 0; i < 8; ++i) {
                const float p0 = off0 * hc0[i], p1 = off1 * hc1[i];
                const unsigned o = (8 * wave + i) * QK_STRIDE + 4 * dp, ok = (8 * wave + i) * KT_STRIDE + 4 * dp;
                if (PASSB) *(LAS unsigned*)(QT + o) = pk2(bf_lo(nq[i]) * (QSCALE * p0), bf_hi(nq[i]) * (QSCALE * p1));
                *(LAS unsigned*)(KT + ok) = pk2(hk0[i] * __builtin_amdgcn_rcpf(p0), hk1[i] * __builtin_amdgcn_rcpf(p1));
            }
            if (wave == 0) { *(LAS f32x2*)(FAC + d0) = (f32x2){r0 * elp0, r1 * elp1}; elp0 = bl0 * ir0; elp1 = bl1 * ir1; dsum0 *= bl0; dsum1 *= bl1; }
        } else {
            float off0 = 0.f, off1 = 0.f, r0 = 0.f, r1 = 0.f, bl0 = 0.f, bl1 = 0.f;
#pragma unroll
            for (int g = 0; g < 8; ++g) { const f32x2 tv = *(const LAS f32x2*)(TOT + g * 128 + d0);
                if (g < wave) { off0 += tv[0]; off1 += tv[1]; } if (g < 4) { r0 += tv[0]; r1 += tv[1]; } bl0 += tv[0]; bl1 += tv[1]; }
            off0 -= r0; off1 -= r1;
#pragma unroll
            for (int i = 0; i < 8; ++i) {
                const f32x2 cv = *(const LAS f32x2*)(LG + (8 * wave + i) * 128 + d0);
                const float e0 = ex2(off0 + cv[0] + LOG2_QSCALE), e1 = ex2(off1 + cv[1] + LOG2_QSCALE);
                const unsigned o = (8 * wave + i) * QK_STRIDE + 4 * dp, ok = (8 * wave + i) * KT_STRIDE + 4 * dp;
                if (PASSB) *(LAS unsigned*)(QT + o) = pk2(bf_lo(nq[i]) * e0, bf_hi(nq[i]) * e1);
                float kk0, kk1;
                if (GLA) { kk0 = bf_lo(nk[i]); kk1 = bf_hi(nk[i]); } else { const f32x2 kv = *(const LAS f32x2*)(KS + (8 * wave + i) * 128 + d0); kk0 = kv[0]; kk1 = kv[1]; }
                *(LAS unsigned*)(KT + ok) = pk2(kk0 * ex2(-(off0 + cv[0])), kk1 * ex2(-(off1 + cv[1])));
            }
            if (wave == 0) { *(LAS f32x2*)(FAC + d0) = (f32x2){ex2(r0) * elp0, ex2(r1) * elp1}; elp0 = ex2(bl0 - r0); elp1 = ex2(bl1 - r1); dsum0 += bl0; dsum1 += bl1; }
        }
#pragma unroll
        for (int j = 0; j < NVL; ++j) *(LAS u32x4*)(VR + (tid / CPR + RPP * j) * vstride + 16 * (tid % CPR)) = vn[j];
        { if (GLA) PF_K(tn); if (PASSB) PF_Q(tn); PF_V(tn); }
        __syncthreads();
        f32x16 o[2];
        if (PASSB) {
            const int aw = GLA ? wave : wave - 4;
            if (aw >= 0 && aw < 3) {
                const int it = aw > 0, jt = aw > 1;
                f32x16 a;
#pragma unroll
                for (int j = 0; j < 16; ++j) a[j] = 0.f;
#pragma unroll
                for (int s = 0; s < 8; ++s) { const bf16x8 qa = *(const LAS bf16x8*)(QT + (32 * it + r) * QK_STRIDE + 32 * s + 16 * hh); const bf16x8 kb = *(const LAS bf16x8*)(KT + (32 * jt + r) * KT_STRIDE + 32 * s + 16 * hh); a = MFMA32(kb, qa, a); }
                const int ii = 32 * it + r;
#pragma unroll
                for (int g4 = 0; g4 < 4; ++g4) { const int j0 = 32 * jt + 8 * g4 + 4 * hh; float v[4];
#pragma unroll
                    for (int e = 0; e < 4; ++e) v[e] = (j0 + e <= ii) ? a[4 * g4 + e] : 0.f;
                    *(LAS u32x2*)(AM + ii * 144 + j0 * 2) = (u32x2){pk2(v[0], v[1]), pk2(v[2], v[3])}; }
            }
        }
        if (wave < nmw) {
#pragma unroll
            for (int i = 0; i < 2; ++i)
#pragma unroll
                for (int j = 0; j < 16; ++j) o[i][j] = 0.f;
#pragma unroll
            for (int db = 0; db < 4; ++db) {
                asm volatile("" ::: "memory");
#pragma unroll
                for (int g4 = 0; g4 < 4; ++g4) { const f32x4 fv = *(const LAS f32x4*)(FAC + 32 * db + 8 * g4 + 4 * hh);
#pragma unroll
                    for (int e = 0; e < 4; ++e) S[db][4 * g4 + e] *= fv[e]; }
                if (PASSB) {
#pragma unroll
                    for (int s = 0; s < 2; ++s) {
                        u32x4 pb; pb.x = pk2(S[db][8 * s + 0], S[db][8 * s + 1]); pb.y = pk2(S[db][8 * s + 2], S[db][8 * s + 3]); pb.z = pk2(S[db][8 * s + 4], S[db][8 * s + 5]); pb.w = pk2(S[db][8 * s + 6], S[db][8 * s + 7]);
                        const bf16x8 bs = __builtin_bit_cast(bf16x8, pb);
#pragma unroll
                        for (int it = 0; it < 2; ++it) {
                            const LAS unsigned char* qp = QT + (32 * it + r) * QK_STRIDE + 64 * db + 32 * s + 8 * hh; const s16x4 lo = *(const LAS s16x4*)qp, hi = *(const LAS s16x4*)(qp + 16);
                            o[it] = MFMA32(__builtin_shufflevector(lo, hi, 0, 1, 2, 3, 4, 5, 6, 7), bs, o[it]);
                        }
                    }
                }
            }
        }
        if (PASSB) __syncthreads();
        if (wave < nmw) {
            bf16x8 vf[4];
#pragma unroll
            for (int ks = 0; ks < 4; ++ks) vf[ks] = tr_frag(VR, trv, vstride, wave, ks);
            if (PASSB) {
#pragma unroll
                for (int it = 0; it < 2; ++it)
#pragma unroll
                    for (int ks = 0; ks < 4; ++ks) { if (it == 0 && ks >= 2) continue;
                        const bf16x8 af = *(const LAS bf16x8*)(AM + (32 * it + r) * 144 + (16 * ks + 8 * hh) * 2); o[it] = MFMA32(af, vf[ks], o[it]); }
#pragma unroll
                for (int it = 0; it < 2; ++it)
#pragma unroll
                    for (int reg = 0; reg < 16; ++reg) *(LAS float*)(O32 + (32 * it + (reg & 3) + 8 * (reg >> 2) + 4 * hh) * OS + (32 * wave + r) * 4) = o[it][reg];
            }
#pragma unroll
            for (int db = 0; db < 4; ++db) {
                asm volatile("" ::: "memory");
#pragma unroll
                for (int ks = 0; ks < 4; ++ks) { const bf16x8 kf = tr_frag(KT, trk, KT_STRIDE, db, ks); S[db] = MFMA32(kf, vf[ks], S[db]); } }
            asm volatile("" ::: "memory");
        }
        if (PASSB) {
            __syncthreads();
#pragma unroll
            for (int j = 0; j < NVL; ++j) {
                const int row = tid / CPR + RPP * j, ch = tid % CPR;
                const f32x4 oa = *(const LAS f32x4*)(O32 + row * OS + ch * 32), ob = *(const LAS f32x4*)(O32 + row * OS + ch * 32 + 16);
                float sq = (oa[0] * oa[0] + oa[1] * oa[1]) + (oa[2] * oa[2] + oa[3] * oa[3]) + (ob[0] * ob[0] + ob[1] * ob[1]) + (ob[2] * ob[2] + ob[3] * ob[3]);
                sq = row16_allsum(sq); if (CPR == 32) sq += __builtin_bit_cast(float, __builtin_amdgcn_ds_swizzle(__builtin_bit_cast(int, sq), 0x401F));
                const float rstd = __builtin_amdgcn_rsqf(sq * (1.0f / dv) + EPS);
                const f32x4 wa = *(const LAS f32x4*)(NW + 8 * ch), wb = *(const LAS f32x4*)(NW + 8 * ch + 4);
                const u32x4 g = gt[j]; float res[8];
                const float gv[8] = {bf_lo(g.x), bf_hi(g.x), bf_lo(g.y), bf_hi(g.y), bf_lo(g.z), bf_hi(g.z), bf_lo(g.w), bf_hi(g.w)};
#pragma unroll
                for (int e = 0; e < 4; ++e) { res[e] = oa[e] * rstd * wa[e] * gv[e]; res[4 + e] = ob[e] * rstd * wb[e] * gv[4 + e]; }
                u32x4 w; w.x = pk2(res[0], res[1]); w.y = pk2(res[2], res[3]); w.z = pk2(res[4], res[5]); w.w = pk2(res[6], res[7]);
                bstore128(w, rs_mix, vo_m, ((unsigned)t0 + RPP * j) * (DM * 2) + mcol * 2);
            }
            if (GLA) { GLA_Z(); PF_G((c + 2 < NC) ? t0 + 2 * CHUNK : t0); }
            if (GLA) __syncthreads();
#pragma unroll
            for (int j = 0; j < NVL; ++j) gt[j] = gn[j];
        }
    }
    if (!PASSB) {
        __syncthreads();
        if (wave == 0) { *(LAS f32x2*)(FAC + d0) = (f32x2){elp0, elp1};
            const f32x2 dv2 = GLA ? (f32x2){ex2(dsum0), ex2(dsum1)} : (f32x2){dsum0, dsum1};
            __hip_atomic_store(Dbase + (size_t)item * 128 + d0, dv2[0], __ATOMIC_RELAXED, __HIP_MEMORY_SCOPE_AGENT); __hip_atomic_store(Dbase + (size_t)item * 128 + d0 + 1, dv2[1], __ATOMIC_RELAXED, __HIP_MEMORY_SCOPE_AGENT); }
        __syncthreads();
        if (wave < nmw) {
            const __amdgpu_buffer_rsrc_t rs_lw = __builtin_amdgcn_make_buffer_rsrc((void*)Lbase, 0, (GLA ? 16 : 32) * NSEG * LSZ * 2, 0x00020000);
#pragma unroll
            for (int db = 0; db < 4; ++db)
#pragma unroll
                for (int g2 = 0; g2 < 2; ++g2) { const f32x4 fa = *(const LAS f32x4*)(FAC + 32 * db + 16 * g2 + 4 * hh), fb = *(const LAS f32x4*)(FAC + 32 * db + 16 * g2 + 8 + 4 * hh); u32x4 ov;
                    ov.x = pk2(S[db][8 * g2 + 0] * fa[0], S[db][8 * g2 + 1] * fa[1]); ov.y = pk2(S[db][8 * g2 + 2] * fa[2], S[db][8 * g2 + 3] * fa[3]);
                    ov.z = pk2(S[db][8 * g2 + 4] * fb[0], S[db][8 * g2 + 5] * fb[1]); ov.w = pk2(S[db][8 * g2 + 6] * fb[2], S[db][8 * g2 + 7] * fb[3]);
                    bstore128_wt(ov, rs_lw, (unsigned)lane * 16u, (unsigned)(item * (LSZ * 2) + ((wave * 4 + db) * 2 + g2) * 1024)); }
        }
    }
    if (!PASSB) asm volatile("s_waitcnt vmcnt(0)" ::: "memory");
    __syncthreads();
    if (!PASSB && tid == 0) __hip_atomic_fetch_add((unsigned*)(F.ws + WS_CTL) + CW_SEQ + 64 * (GLA ? b * 4 + h : 16 + b * 8 + h), 1u, __ATOMIC_RELAXED, __HIP_MEMORY_SCOPE_AGENT);
#undef PF_K
#undef PF_Q
#undef PF_G
#undef GLA_Z
#undef PF_V
#undef PJB
}


__device__ __forceinline__ void hgrn_passA_steps(Frame& F, const int b, const int h, const int seg) {
    constexpr int STEP = MK_ASTEP, RW = STEP / 8, NSEG = NSEG_H, NST = (NCHUNK / NSEG) * CHUNK / STEP, KST = STEP == 256 ? 288 : 320, VST = KST, LSZ = 128 * 128;
    constexpr int A_KT = 0, A_VR = A_KT + STEP * KST, A_TOT = A_VR + STEP * VST, A_FAC = A_TOT + 8 * 128 * 4;
    static_assert(A_FAC + 512 <= LDS_BYTES - 128, "pass A LDS map");
    const int tid = F.tid, lane = F.lane, wave = F.wave;
    LAS unsigned char* lds = F.lds;
    LAS unsigned char* KT = lds + A_KT; LAS unsigned char* VR = lds + A_VR;
    LAS float* TOT = (LAS float*)(lds + A_TOT); LAS float* FAC = (LAS float*)(lds + A_FAC);
    const int kcol = C_HF + h * 128, vcol = C_HI + h * 128;
    const int dp = tid & 63, d0 = 2 * dp;
    const int item = (b * 8 + h) * NSEG + seg;
    float* Lbase = (float*)(F.ws + WS_LH); float* Dbase = (float*)(F.ws + WS_DH);
    const f32x2 l0 = *(const f32x2*)(F.hgrn_lb + h * 128 + d0), l1 = *(const f32x2*)(F.hgrn_lb + 1024 + h * 128 + d0);
    const float lb0 = 1.0f / (1.0f + __expf(l1[0] - l0[0])), lb1 = 1.0f / (1.0f + __expf(l1[1] - l0[1]));
    const unsigned hh = lane >> 5;
    const unsigned tq = (lane & 15) >> 2, tp = lane & 3, tblk = (lane >> 4) & 1;
    const unsigned trk = (8 * hh + tq) * KST + 32 * tblk + 8 * tp, trv = (8 * hh + tq) * VST + 32 * tblk + 8 * tp;
    const size_t row0 = (size_t)b * SEQ + (size_t)seg * (NCHUNK / NSEG) * CHUNK;
    float dprod0 = 1.f, dprod1 = 1.f;
    f32x16 S[4];
#pragma unroll
    for (int i = 0; i < 4; ++i)
#pragma unroll
        for (int j = 0; j < 16; ++j) S[i][j] = 0.f;
    const __amdgpu_buffer_rsrc_t rs_pj = __builtin_amdgcn_make_buffer_rsrc((void*)F.PJ, 0, (int)((size_t)M * NPJ * 2), 0x00020000);
    const unsigned vo_k = 4 * dp, vo_v = (tid / 16) * 512 + (tid % 16) * 16;
#define PJB(T, COL) ((((((unsigned)(T)) >> 8) * (unsigned)(NPJ / 256) + (((unsigned)(COL)) >> 8)) << 17) + ((((unsigned)(T)) & 255u) << 9) + ((((unsigned)(COL)) & 255u) << 1))
    unsigned nk[RW]; u32x4 vn[STEP / 32];
#define A_PF_K(T0) do { const unsigned _sk = PJB(T0, kcol) + RW * wave * 512; _Pragma("unroll") for (int i = 0; i < RW; ++i) nk[i] = __builtin_amdgcn_raw_buffer_load_b32(rs_pj, vo_k, _sk + i * 512, 0); } while (0)
#define A_PF_V(T0) do { const unsigned _sv = PJB(T0, vcol); _Pragma("unroll") for (int j = 0; j < STEP / 32; ++j) vn[j] = __builtin_amdgcn_raw_buffer_load_b128(rs_pj, vo_v, _sv + j * (32 * 512), 0); } while (0)
    A_PF_K(row0); A_PF_V(row0);
    for (int c = 0; c < NST; ++c) {
        const size_t t0 = row0 + (size_t)c * STEP;
        const size_t tn = (c + 1 < NST) ? t0 + STEP : t0;
        float kk0[RW], kk1[RW]; float cum0 = 1.f, cum1 = 1.f;
#pragma unroll
        for (int i = RW - 1; i >= 0; --i) {
            const unsigned kv = nk[i];
            const float s0 = fsig(bf_lo(kv)), s1 = fsig(bf_hi(kv));
            const float f0 = lb0 + (1.0f - lb0) * s0, f1 = lb1 + (1.0f - lb1) * s1;
            kk0[i] = (1.0f - f0) * cum0; kk1[i] = (1.0f - f1) * cum1;
            cum0 *= f0; cum1 *= f1;
        }
        *(LAS f32x2*)(TOT + wave * 128 + d0) = (f32x2){cum0, cum1};
        A_PF_K(tn);
        __syncthreads();
        {
            float off0 = 1.f, off1 = 1.f, bl0 = 1.f, bl1 = 1.f;
#pragma unroll
            for (int g = 0; g < 8; ++g) { const f32x2 tv = *(const LAS f32x2*)(TOT + g * 128 + d0);
                if (g > wave) { off0 *= tv[0]; off1 *= tv[1]; } bl0 *= tv[0]; bl1 *= tv[1]; }
#pragma unroll
            for (int i = 0; i < RW; ++i) *(LAS unsigned*)(KT + (RW * wave + i) * KST + 4 * dp) = pk2(kk0[i] * off0, kk1[i] * off1);
            if (wave == 0) { *(LAS f32x2*)(FAC + d0) = (f32x2){bl0, bl1}; dprod0 *= bl0; dprod1 *= bl1; }
        }
#pragma unroll
        for (int j = 0; j < STEP / 32; ++j) *(LAS u32x4*)(VR + (tid / 16 + 32 * j) * VST + 16 * (tid % 16)) = vn[j];
        A_PF_V(tn);
        __syncthreads();
        if (wave < 4) {
#pragma unroll
            for (int db = 0; db < 4; ++db)
#pragma unroll
                for (int g4 = 0; g4 < 4; ++g4) { const f32x4 fv = *(const LAS f32x4*)(FAC + 32 * db + 8 * g4 + 4 * hh);
#pragma unroll
                    for (int e = 0; e < 4; ++e) S[db][4 * g4 + e] *= fv[e]; }
#pragma unroll
            for (int k4 = 0; k4 < STEP / 64; ++k4) {
                bf16x8 vf[4];
#pragma unroll
                for (int q = 0; q < 4; ++q) vf[q] = tr_frag(VR, trv, VST, wave, 4 * k4 + q);
#pragma unroll
                for (int db = 0; db < 4; ++db) {
                    asm volatile("" ::: "memory");
#pragma unroll
                    for (int q = 0; q < 4; ++q) { const bf16x8 kf = tr_frag(KT, trk, KST, db, 4 * k4 + q); S[db] = MFMA32(kf, vf[q], S[db]); } }
            }
            asm volatile("" ::: "memory");
        }
    }
    if (wave == 0) { __hip_atomic_store(Dbase + (size_t)item * 128 + d0, dprod0, __ATOMIC_RELAXED, __HIP_MEMORY_SCOPE_AGENT); __hip_atomic_store(Dbase + (size_t)item * 128 + d0 + 1, dprod1, __ATOMIC_RELAXED, __HIP_MEMORY_SCOPE_AGENT); }
    if (wave < 4) {
        const __amdgpu_buffer_rsrc_t rs_lw = __builtin_amdgcn_make_buffer_rsrc((void*)Lbase, 0, 32 * NSEG * LSZ * 2, 0x00020000);
#pragma unroll
        for (int db = 0; db < 4; ++db)
#pragma unroll
            for (int g2 = 0; g2 < 2; ++g2) { u32x4 ov;
                ov.x = pk2(S[db][8 * g2 + 0], S[db][8 * g2 + 1]); ov.y = pk2(S[db][8 * g2 + 2], S[db][8 * g2 + 3]); ov.z = pk2(S[db][8 * g2 + 4], S[db][8 * g2 + 5]); ov.w = pk2(S[db][8 * g2 + 6], S[db][8 * g2 + 7]);
                bstore128_wt(ov, rs_lw, (unsigned)lane * 16u, (unsigned)(item * (LSZ * 2) + ((wave * 4 + db) * 2 + g2) * 1024)); }
    }
    asm volatile("s_waitcnt vmcnt(0)" ::: "memory");
    __syncthreads();
    if (tid == 0) __hip_atomic_fetch_add((unsigned*)(F.ws + WS_CTL) + CW_SEQ + 64 * (16 + b * 8 + h), 1u, __ATOMIC_RELAXED, __HIP_MEMORY_SCOPE_AGENT);
#undef A_PF_K
#undef A_PF_V
#undef PJB
}

__device__ __forceinline__ void gla_passA_steps(Frame& F, const int b, const int h, const int seg) {
    constexpr int STEP = 128, RW = STEP / 8, NSEG = NSEG_G, NST = (NCHUNK / NSEG) * CHUNK / STEP, KST = 320, VST = 576, LSZ = 128 * 256;
    constexpr int A_KT = 0, A_VR = A_KT + STEP * KST, A_TOT = A_VR + STEP * VST, A_FAC = A_TOT + 8 * 128 * 4;
    static_assert(A_FAC + 512 <= LDS_BYTES - 128 && STEP * 128 * 4 <= STEP * VST, "GLA pass A LDS map");
    const int tid = F.tid, lane = F.lane, wave = F.wave;
    LAS unsigned char* lds = F.lds;
    LAS unsigned char* KT = lds + A_KT; LAS unsigned char* VR = lds + A_VR; LAS float* LG = (LAS float*)(lds + A_VR);
    LAS float* TOT = (LAS float*)(lds + A_TOT); LAS float* FAC = (LAS float*)(lds + A_FAC);
    const int kcol = C_GK + h * 128, vcol = C_GV + h * 256;
    const int dp = tid & 63, d0 = 2 * dp;
    const int item = (b * 4 + h) * NSEG + seg;
    float* Lbase = (float*)(F.ws + WS_LG); float* Dbase = (float*)(F.ws + WS_DG);
    bf16x8 wbh, wbl; float bub;
    { const int col = h * 128 + 32 * (wave & 3) + (lane & 31); float wv[8];
#pragma unroll
      for (int j = 0; j < 8; ++j) wv[j] = F.gla_w_up[(size_t)(8 * (lane >> 5) + j) * 512 + col];
      split_bf16(wv, wbh, wbl); bub = F.gla_b_up[col]; }
    const unsigned hh = lane >> 5;
    const unsigned tq = (lane & 15) >> 2, tp = lane & 3, tblk = (lane >> 4) & 1;
    const unsigned trk = (8 * hh + tq) * KST + 32 * tblk + 8 * tp, trv = (8 * hh + tq) * VST + 32 * tblk + 8 * tp;
    const size_t row0 = (size_t)b * SEQ + (size_t)seg * (NCHUNK / NSEG) * CHUNK;
    float dsum0 = 0.f, dsum1 = 0.f;
    f32x16 S[4];
#pragma unroll
    for (int i = 0; i < 4; ++i)
#pragma unroll
        for (int j = 0; j < 16; ++j) S[i][j] = 0.f;
    const __amdgpu_buffer_rsrc_t rs_pj = __builtin_amdgcn_make_buffer_rsrc((void*)F.PJ, 0, (int)((size_t)M * NPJ * 2), 0x00020000);
    const __amdgpu_buffer_rsrc_t rs_glr = __builtin_amdgcn_make_buffer_rsrc((void*)F.GLR, 0, M * 16 * 4, 0x00020000);
    const unsigned vo_k = 4 * dp, vo_g = ((lane & 31) * 16 + 8 * (lane >> 5)) * 4, vo_v = (tid / 32) * 512 + (tid % 32) * 16;
#define PJB(T, COL) ((((((unsigned)(T)) >> 8) * (unsigned)(NPJ / 256) + (((unsigned)(COL)) >> 8)) << 17) + ((((unsigned)(T)) & 255u) << 9) + ((((unsigned)(COL)) & 255u) << 1))
    unsigned nk[RW]; u32x4 vn[STEP / 16]; u32x4 ng[2][2];
#define G_PF_K(T0) do { const unsigned _sk = PJB(T0, kcol) + RW * wave * 512; _Pragma("unroll") for (int i = 0; i < RW; ++i) nk[i] = __builtin_amdgcn_raw_buffer_load_b32(rs_pj, vo_k, _sk + i * 512, 0); } while (0)
#define G_PF_V(T0) do { const unsigned _sv = PJB(T0, vcol); _Pragma("unroll") for (int j = 0; j < STEP / 16; ++j) vn[j] = __builtin_amdgcn_raw_buffer_load_b128(rs_pj, vo_v, _sv + j * (16 * 512), 0); } while (0)
#define G_PF_G(T0) do { _Pragma("unroll") for (int hf = 0; hf < 2; ++hf) { const unsigned _sg = ((unsigned)(T0) + 64 * hf + 32 * (wave >> 2)) * 64; ng[hf][0] = __builtin_amdgcn_raw_buffer_load_b128(rs_glr, vo_g, _sg, 0); ng[hf][1] = __builtin_amdgcn_raw_buffer_load_b128(rs_glr, vo_g, _sg + 16, 0); } } while (0)
    float lgr[2][16];
#define G_Z() do { _Pragma("unroll") for (int hf = 0; hf < 2; ++hf) { f32x16 z; _Pragma("unroll") for (int j = 0; j < 16; ++j) z[j] = 0.f; \
        { const float gv[8] = {__uint_as_float(ng[hf][0].x), __uint_as_float(ng[hf][0].y), __uint_as_float(ng[hf][0].z), __uint_as_float(ng[hf][0].w), __uint_as_float(ng[hf][1].x), __uint_as_float(ng[hf][1].y), __uint_as_float(ng[hf][1].z), __uint_as_float(ng[hf][1].w)}; \
          bf16x8 ah, al; split_bf16(gv, ah, al); \
          z = MFMA32(al, wbh, z); z = MFMA32(ah, wbl, z); z = MFMA32(ah, wbh, z); } \
        _Pragma("unroll") for (int reg = 0; reg < 16; ++reg) { const float zz = z[reg] + bub; lgr[hf][reg] = (fminf(zz, 0.f) * LOG2E - lg2(1.0f + ex2(-LOG2E * fabsf(zz)))) * INV_TAU; } } } while (0)
    G_PF_G(row0); G_PF_K(row0); G_PF_V(row0);
    G_Z(); G_PF_G(NST > 1 ? row0 + STEP : row0);
    for (int c = 0; c < NST; ++c) {
        const size_t t0 = row0 + (size_t)c * STEP;
        const size_t tn = (c + 1 < NST) ? t0 + STEP : t0;
        __syncthreads();
#pragma unroll
        for (int hf = 0; hf < 2; ++hf)
#pragma unroll
            for (int reg = 0; reg < 16; ++reg) { const int row = 64 * hf + 32 * (wave >> 2) + (reg & 3) + 8 * (reg >> 2) + 4 * (lane >> 5);
                LG[row * 128 + 32 * (wave & 3) + (lane & 31)] = lgr[hf][reg]; }
        __syncthreads();
        float sf0[RW], sf1[RW]; float cum0 = 0.f, cum1 = 0.f;
#pragma unroll
        for (int i = RW - 1; i >= 0; --i) { const f32x2 lgv = *(const LAS f32x2*)(LG + (RW * wave + i) * 128 + d0); sf0[i] = cum0; sf1[i] = cum1; cum0 += lgv[0]; cum1 += lgv[1]; }
        *(LAS f32x2*)(TOT + wave * 128 + d0) = (f32x2){cum0, cum1};
        __syncthreads();
        {
            float off0 = 0.f, off1 = 0.f, bl0 = 0.f, bl1 = 0.f;
#pragma unroll
            for (int g = 0; g < 8; ++g) { const f32x2 tv = *(const LAS f32x2*)(TOT + g * 128 + d0);
                if (g > wave) { off0 += tv[0]; off1 += tv[1]; } bl0 += tv[0]; bl1 += tv[1]; }
#pragma unroll
            for (int i = 0; i < RW; ++i) *(LAS unsigned*)(KT + (RW * wave + i) * KST + 4 * dp) = pk2(bf_lo(nk[i]) * ex2(sf0[i] + off0), bf_hi(nk[i]) * ex2(sf1[i] + off1));
            if (wave == 0) { *(LAS f32x2*)(FAC + d0) = (f32x2){ex2(bl0), ex2(bl1)}; dsum0 += bl0; dsum1 += bl1; }
        }
        G_PF_K(tn);
#pragma unroll
        for (int j = 0; j < STEP / 16; ++j) *(LAS u32x4*)(VR + (tid / 32 + 16 * j) * VST + 16 * (tid % 32)) = vn[j];
        G_PF_V(tn);
        __syncthreads();
        {
#pragma unroll
            for (int db = 0; db < 4; ++db)
#pragma unroll
                for (int g4 = 0; g4 < 4; ++g4) { const f32x4 fv = *(const LAS f32x4*)(FAC + 32 * db + 8 * g4 + 4 * hh);
#pragma unroll
                    for (int e = 0; e < 4; ++e) S[db][4 * g4 + e] *= fv[e]; }
#pragma unroll
            for (int k4 = 0; k4 < STEP / 64; ++k4) {
                bf16x8 vf[4];
#pragma unroll
                for (int q = 0; q < 4; ++q) vf[q] = tr_frag(VR, trv, VST, wave, 4 * k4 + q);
#pragma unroll
                for (int db = 0; db < 4; ++db) {
                    asm volatile("" ::: "memory");
#pragma unroll
                    for (int q = 0; q < 4; ++q) { const bf16x8 kf = tr_frag(KT, trk, KST, db, 4 * k4 + q); S[db] = MFMA32(kf, vf[q], S[db]); } }
            }
            asm volatile("" ::: "memory");
        }
        if (c + 1 < NST) { G_Z(); G_PF_G((c + 2 < NST) ? t0 + 2 * STEP : t0); }
    }
    if (wave == 0) { __hip_atomic_store(Dbase + (size_t)item * 128 + d0, ex2(dsum0), __ATOMIC_RELAXED, __HIP_MEMORY_SCOPE_AGENT); __hip_atomic_store(Dbase + (size_t)item * 128 + d0 + 1, ex2(dsum1), __ATOMIC_RELAXED, __HIP_MEMORY_SCOPE_AGENT); }
    {
        const __amdgpu_buffer_rsrc_t rs_lw = __builtin_amdgcn_make_buffer_rsrc((void*)Lbase, 0, 16 * NSEG * LSZ * 2, 0x00020000);
#pragma unroll
        for (int db = 0; db < 4; ++db)
#pragma unroll
            for (int g2 = 0; g2 < 2; ++g2) { u32x4 ov;
                ov.x = pk2(S[db][8 * g2 + 0], S[db][8 * g2 + 1]); ov.y = pk2(S[db][8 * g2 + 2], S[db][8 * g2 + 3]); ov.z = pk2(S[db][8 * g2 + 4], S[db][8 * g2 + 5]); ov.w = pk2(S[db][8 * g2 + 6], S[db][8 * g2 + 7]);
                bstore128_wt(ov, rs_lw, (unsigned)lane * 16u, (unsigned)(item * (LSZ * 2) + ((wave * 4 + db) * 2 + g2) * 1024)); }
    }
    asm volatile("s_waitcnt vmcnt(0)" ::: "memory");
    __syncthreads();
    if (tid == 0) __hip_atomic_fetch_add((unsigned*)(F.ws + WS_CTL) + CW_SEQ + 64 * (b * 4 + h), 1u, __ATOMIC_RELAXED, __HIP_MEMORY_SCOPE_AGENT);
    {
        LAS unsigned* ST = (LAS unsigned*)(lds + L_KS);
        const u32x4 a = __builtin_bit_cast(u32x4, wbh), c2 = __builtin_bit_cast(u32x4, wbl);
        ST[0 * NTHREADS + tid] = a.x; ST[1 * NTHREADS + tid] = a.y; ST[2 * NTHREADS + tid] = a.z; ST[3 * NTHREADS + tid] = a.w;
        ST[4 * NTHREADS + tid] = c2.x; ST[5 * NTHREADS + tid] = c2.y; ST[6 * NTHREADS + tid] = c2.z; ST[7 * NTHREADS + tid] = c2.w; ST[8 * NTHREADS + tid] = __float_as_uint(bub);
    }
#undef G_PF_K
#undef G_PF_V
#undef G_PF_G
#undef G_Z
#undef PJB
}

__device__ __forceinline__ int scan_vit(int bid) {
    const int x = bid & 7, r = bid >> 3;
    if (r < 14) return x * 14 + r;
    if (r < 26) return 112 + x * 12 + (r - 14);
    if (r < 28) return 208 + x * 2 + (r - 26);
    return 224 + x * 4 + (r - 28);
}
__device__ __forceinline__ void p2a_scan(Frame& F) {
    constexpr int NG = 16 * (NSEG_G - 1), NH = 32 * (NSEG_H - 1);
    static_assert(NG + NH <= 256, "pass A items");
    const int it = scan_vit(F.bid);
    if (it < NG) { const int bh = it / (NSEG_G - 1), seg = it % (NSEG_G - 1); gla_passA_steps(F, bh >> 2, bh & 3, seg); }
    else if (it < NG + NH) { const int j = it - NG, bh = j / (NSEG_H - 1), seg = j % (NSEG_H - 1); hgrn_passA_steps(F, bh >> 3, bh & 7, seg); }
}
__device__ __forceinline__ void p2b_scan(Frame& F) {
    constexpr int NG = 16 * NSEG_G, NH = 32 * NSEG_H;
    static_assert(NG + NH <= 256, "pass B items");
    constexpr int NGA = 16 * (NSEG_G - 1), NHA = 32 * (NSEG_H - 1);
    const int it = scan_vit(F.bid);
    if (it < NGA) { const int bh = it / (NSEG_G - 1), seg = it % (NSEG_G - 1) + 1; scan_item<1, 1>(F, bh >> 2, bh & 3, seg); }
    else if (it < NGA + NHA) { const int j = it - NGA, bh = j / (NSEG_H - 1), seg = j % (NSEG_H - 1) + 1; scan_item<0, 1>(F, bh >> 3, bh & 7, seg); }
    else if (it < NGA + NHA + 16) { const int bh = it - NGA - NHA; scan_item<1, 1>(F, bh >> 2, bh & 3, 0); }
    else if (it < NGA + NHA + 48) { const int bh = it - NGA - NHA - 16; scan_item<0, 1>(F, bh >> 3, bh & 7, 0); }
#if MK_ONE_LAUNCH
    if (it >= NGA + NHA) {
        LAS float* scr = (LAS float*)(F.lds + F.wave * 16384);
        constexpr int KB = DM / 64, I_OUT = KB * (DM / 32);
        for (int r = (it - NGA - NHA) * NWAVES + F.wave; r < I_OUT; r += 48 * NWAVES) { const int kb = r / (DM / 32), nb = r % (DM / 32);
            p0_transpose_item(F.w_out, DM, 32 * nb, F.WoutT, DM, 32 * nb, kb, scr, F.lane); }
    }
#endif
}

struct Args { const float* in[10]; float* out; unsigned char* ws; int ph_lo, ph_hi; };
__global__ void __launch_bounds__(NTHREADS, 2) mk_fwd(Args args) {
    extern __shared__ __attribute__((aligned(16))) unsigned char lds_raw[];
    Frame F;
    F.lds = (LAS unsigned char*)lds_raw;
    F.tid = threadIdx.x; F.lane = F.tid & 63; F.wave = __builtin_amdgcn_readfirstlane(F.tid >> 6);
    F.G = gridDim.x; F.bid = blockIdx.x;
    F.x = args.in[0]; F.norm_w = args.in[1]; F.w_in = args.in[2]; F.gla_w_up = args.in[3]; F.gla_b_up = args.in[4]; F.gla_norm_w = args.in[5];
    F.hgrn_lb = args.in[6]; F.hgrn_norm_w = args.in[7]; F.w_out = args.in[8]; F.final_w = args.in[9]; F.out = args.out;
    unsigned char* ws = args.ws; F.ws = ws;
    F.WinT = (bf16*)(ws + WS_WINT); F.WoutT = (bf16*)(ws + WS_WOUTT); F.HN = (bf16*)(ws + WS_HN); F.MIX = (bf16*)(ws + WS_MIX); F.PJ = (bf16*)(ws + WS_PJ);
    F.GLR = (float*)(ws + WS_GLR);
    const int lo = args.ph_lo, hi = args.ph_hi;
#if MK_ONE_LAUNCH
    if (F.tid < 32) ((LAS unsigned*)(F.lds + MISC_OFF))[F.tid] = 0u;
    __syncthreads();
    const XcdBarrier xbar = xcd_barrier_post((unsigned*)(ws + WS_CTL) + CW_BAR, (volatile LAS unsigned*)(F.lds + MISC_OFF));
#endif
#define IN(k) (lo <= (k) && (k) < hi)
#define BOTH(k) (IN(k) && IN((k) + 1))
#if MK_ONE_LAUNCH
#define GRID_BAR() do { xcd_barrier(xbar); } while (0)
#else
#define GRID_BAR() do { } while (0)
#endif
    if (IN(0)) { p0_prologue(F); if (BOTH(0)) GRID_BAR(); }
    if (IN(1)) {
        pg8::Gemm g{F.HN, F.WinT, M, NPJ, DM}; pg8::StaticOrder S; S.init(M, NPJ, F.G, F.bid);
        pg8::EpiPJ E{F.PJ, NPJ / 256};
#ifdef MK_SKEW_TICKS
        if ((F.bid >> 3) & 1) { const unsigned long long t0 = __builtin_amdgcn_s_memrealtime(); while (__builtin_amdgcn_s_memrealtime() - t0 < MK_SKEW_TICKS) __builtin_amdgcn_s_sleep(8); }
#endif
        pg8::gemm_phase<pg8::EpiPJ, pg8::StaticOrder, PG8_ALIGN, PG8_SP2>(F.lds, g, S, E);
        if (BOTH(1)) GRID_BAR();
    }
    if (IN(2)) { p2a_scan(F); }
    if (IN(3)) { p2b_scan(F); if (BOTH(3)) GRID_BAR(); }
    if (IN(4)) {
        pg8::Gemm g{F.MIX, F.WoutT, M, DM, DM}; pg8::PanelOrder S{F.bid};
        pg8::EpiFinal E{F.x, F.out, F.final_w, (float*)(ws + WS_XCH), (unsigned*)(ws + WS_CTL) + CW_PANEL, F.lds + 131072};
        pg8::gemm_phase<pg8::EpiFinal, pg8::PanelOrder, true, PG8_SP2>(F.lds, g, S, E);
    }
#undef IN
#undef BOTH
}

extern "C" void kernel_launch(void* const* d_in, const int* in_sizes, int n_in, void* d_out, int out_size, void* d_ws, size_t ws_size, hipStream_t stream) {
    static int grid = 0;
    if (grid == 0) {
        if (n_in != 10 || in_sizes[0] != M * DM || out_size != M * DM || ws_size < WS_END) { fprintf(stderr, "kernel_launch: unexpected shapes (n_in %d, in0 %d, out %d, ws %zu)\n", n_in, n_in > 0 ? in_sizes[0] : -1, out_size, ws_size); grid = -1; return; }
        int dev = 0, cus = 0, per_cu = 0;
        if (hipGetDevice(&dev) != hipSuccess || hipDeviceGetAttribute(&cus, hipDeviceAttributeMultiprocessorCount, dev) != hipSuccess) { grid = -1; return; }
        if (hipFuncSetAttribute((const void*)mk_fwd, hipFuncAttributeMaxDynamicSharedMemorySize, LDS_BYTES) != hipSuccess) { fprintf(stderr, "kernel_launch: hipFuncSetAttribute failed\n"); grid = -1; return; }
        if (hipOccupancyMaxActiveBlocksPerMultiprocessor(&per_cu, (const void*)mk_fwd, NTHREADS, LDS_BYTES) != hipSuccess || per_cu < 1) { fprintf(stderr, "kernel_launch: occupancy query says %d blocks per CU\n", per_cu); grid = -1; return; }
        (void)hipGetLastError();
        grid = cus;
        if (grid < 256) { fprintf(stderr, "kernel_launch: %d CUs; the scan phases need 256 workgroups\n", grid); grid = -1; return; }
        grid = 256;
    }
    if (grid < 0) return;
    (void)hipMemsetAsync((char*)d_ws + WS_CTL, 0, CTL_ZERO_BYTES, stream);
    Args a{};
    for (int i = 0; i < 10; ++i) a.in[i] = (const float*)d_in[i];
    a.out = (float*)d_out; a.ws = (unsigned char*)d_ws;
#if MK_ONE_LAUNCH
    a.ph_lo = 0; a.ph_hi = 5;
    void* kargs[] = {&a};
    hipError_t e = hipLaunchCooperativeKernel((const void*)mk_fwd, dim3(grid), dim3(NTHREADS), kargs, LDS_BYTES, stream);
    if (e != hipSuccess) fprintf(stderr, "kernel_launch: cooperative launch failed: %s (grid %d)\n", hipGetErrorString(e), grid);
#else
    for (int p = 0; p < 5; ++p) { a.ph_lo = p; a.ph_hi = p + 1; hipLaunchKernelGGL(mk_fwd, dim3(grid), dim3(NTHREADS), LDS_BYTES, stream, a); }
#endif
}
```

```cpp
#include <hip/hip_runtime.h>
#include <cstdio>
#include <cstdint>
#ifndef MK_ONE_LAUNCH
#define MK_ONE_LAUNCH 1
#ifndef MK_ASTEP
#define MK_ASTEP 256
#endif
#endif
namespace pg8 {
#define PG8_LAS __attribute__((address_space(3)))
typedef unsigned short bf16_t;
typedef short bf16x8 __attribute__((ext_vector_type(8)));
typedef float f32x4 __attribute__((ext_vector_type(4)));
typedef unsigned u32x4 __attribute__((ext_vector_type(4)));
constexpr int BM = 256, BK = 64, HALF = 128, HTB = HALF * BK * 2  , STAGE_BYTES = 8 * HTB, NXCD = 8, WGM = 8;

__host__ __device__ __forceinline__ int lds_byte(int r, int c) { const int st = (r >> 4) * 2 + (c >> 5), rr = r & 15, cc = c & 31, ob = rr * 64 + cc * 2; return st * 1024 + (ob ^ (((ob >> 9) & 1) << 5)); }
__host__ __device__ __forceinline__ void stage_rc(int b, int& R, int& C) { const int st = b / 1024, sb = b % 1024, swz = sb ^ (((sb >> 9) & 1) << 5); R = (st >> 1) * 16 + swz / 64; C = (st & 1) * 32 + (swz % 64) / 2; }
__host__ __device__ __forceinline__ int perm32(int rho) { const int n = rho >> 4, i = rho & 15; return 8 * (i >> 2) + 4 * n + (i & 3); }

struct Unit { int pm, pn; };
struct Gemm { const bf16_t* A; const bf16_t* Bt; int M, N, K; };

struct StaticOrder {
    int nM, nN, nwg, G, c;
    __host__ __device__ void init(int M, int N, int G_, int c_) { nM = M / BM; nN = N / BM; nwg = nM * nN; G = G_; c = c_; }
    __host__ __device__ bool next(int i, Unit& u) const {
        const long L = (long)i * G + c; if (L >= nwg) return false;
        int wgid = (int)L; { const int q = nwg / NXCD, r = nwg % NXCD, xcd = wgid % NXCD, off = wgid / NXCD; wgid = (xcd < r ? xcd * (q + 1) : r * (q + 1) + (xcd - r) * q) + off; }
        const int nig = WGM * nN, gid = wgid / nig, fm = gid * WGM, gsz = (nM - fm) < WGM ? (nM - fm) : WGM;
        u.pm = fm + ((wgid % nig) % gsz); u.pn = (wgid % nig) / gsz;
        if (nN == 28) u.pn = (int)((0x1540362u >> (4 * (u.pn >> 2))) & 15u) * 4 + (u.pn & 3);
        return true;
    }
    __device__ __forceinline__ void a_ready(const Unit&) const {}
    __device__ __forceinline__ void done(const Unit&) const {}
};

__device__ __forceinline__ unsigned cvt_pk_bf16(float lo, float hi) { unsigned r; asm volatile("v_cvt_pk_bf16_f32 %0, %1, %2" : "=v"(r) : "v"(lo), "v"(hi)); return r; }
typedef float f32x2 __attribute__((ext_vector_type(2)));
struct EpiPJ {
    static constexpr bool PERM = true, AFTER_DRAIN = false;
    bf16_t* O; int ntn;
    __device__ __forceinline__ void operator()(const f32x4 (&acc)[2][2][4][2], const Unit& u, int wr, int wc, int fr, int fq) const {
        bf16_t* base = O + ((size_t)(u.pm * ntn + u.pn) << 16) + (wr * 64 + fr) * 256 + wc * 32 + 8 * fq;
#pragma unroll
        for (int ai = 0; ai < 2; ++ai)
#pragma unroll
            for (int m = 0; m < 4; ++m) { bf16_t* rowp = base + (ai * HALF + m * 16) * 256;
#pragma unroll
                for (int bj = 0; bj < 2; ++bj) { const f32x4 v0 = acc[ai][bj][m][0], v1 = acc[ai][bj][m][1];
                    u32x4 w; w.x = cvt_pk_bf16(v0[0], v0[1]); w.y = cvt_pk_bf16(v0[2], v0[3]); w.z = cvt_pk_bf16(v1[0], v1[1]); w.w = cvt_pk_bf16(v1[2], v1[3]);
                    *(u32x4*)(rowp + bj * HALF) = w; } }
    }
};
struct PanelOrder {
    int c;
    __device__ __forceinline__ bool next(int i, Unit& u) const { if (i >= 2) return false; const int x = c & 7, k = c >> 3; u.pm = 32 * i + 4 * x + (k & 3); u.pn = k >> 2; return true; }
    __device__ __forceinline__ void a_ready(const Unit&) const {}
    __device__ __forceinline__ void done(const Unit&) const {}
};
struct EpiFinal {
    static constexpr bool PERM = false, AFTER_DRAIN = false;
    const float* base; float* out; const float* fw; float* xch; unsigned* cnt; PG8_LAS unsigned char* lds;
    __device__ __forceinline__ void operator()(f32x4 (&acc)[2][2][4][2], const Unit& u, int wr, int wc, int fr, int fq) const {
        const int tid = threadIdx.x, wid = __builtin_amdgcn_readfirstlane(tid >> 6), lane = tid & 63;
        PG8_LAS float* P = (PG8_LAS float*)lds; PG8_LAS float* R = (PG8_LAS float*)(lds + 4096);
        const int row0 = u.pm * BM + wr * 64 + fr, col0 = u.pn * BM + wc * 32 + 4 * fq;
#pragma unroll
        for (int ai = 0; ai < 2; ++ai)
#pragma unroll
            for (int m = 0; m < 4; ++m) { const size_t off = (size_t)(row0 + ai * HALF + m * 16) * 2048 + col0; float s = 0.f;
#pragma unroll
                for (int bj = 0; bj < 2; ++bj)
#pragma unroll
                    for (int n = 0; n < 2; ++n) { const f32x4 v = *(const f32x4*)(base + off + bj * HALF + n * 16) + acc[ai][bj][m][n]; acc[ai][bj][m][n] = v; s += (v[0] * v[0] + v[1] * v[1]) + (v[2] * v[2] + v[3] * v[3]); }
                s += __shfl_xor(s, 16); s += __shfl_xor(s, 32);
                if (fq == 0) P[(ai * HALF + wr * 64 + m * 16 + fr) * 4 + wc] = s;
                asm volatile("" ::: "memory"); }
        asm volatile("s_waitcnt lgkmcnt(0)" ::: "memory"); __builtin_amdgcn_s_barrier(); asm volatile("" ::: "memory");
        if (wid < 4) {
            const f32x4 p = *(const PG8_LAS f32x4*)(P + tid * 4);
            __hip_atomic_store(xch + (size_t)(u.pm * 8 + u.pn) * 256 + tid, (p[0] + p[1]) + (p[2] + p[3]), __ATOMIC_RELAXED, __HIP_MEMORY_SCOPE_AGENT);
            asm volatile("s_waitcnt vmcnt(0)" ::: "memory");
            if (lane == 0) __hip_atomic_fetch_add(cnt + 64 * u.pm, 1u, __ATOMIC_RELAXED, __HIP_MEMORY_SCOPE_AGENT);
        }
        if (wid == 0) {
            unsigned sp = 0;
            while ((unsigned)__builtin_amdgcn_readfirstlane(__hip_atomic_load(cnt + 64 * u.pm, __ATOMIC_RELAXED, __HIP_MEMORY_SCOPE_AGENT)) < 32u) { __builtin_amdgcn_s_sleep(1); if (++sp > (1u << 22)) break; }
            __builtin_amdgcn_fence(__ATOMIC_ACQUIRE, "agent");
        }
        asm volatile("s_waitcnt vmcnt(0) lgkmcnt(0)" ::: "memory"); __builtin_amdgcn_s_barrier(); asm volatile("" ::: "memory");
        if (wid < 4) { float t = 0.f;
#pragma unroll
            for (int q = 0; q < 8; ++q) t += __hip_atomic_load(xch + (size_t)(u.pm * 8 + q) * 256 + tid, __ATOMIC_RELAXED, __HIP_MEMORY_SCOPE_AGENT);
            R[tid] = __builtin_amdgcn_rsqf(t * (1.0f / 2048.0f) + 1e-6f); }
        asm volatile("s_waitcnt lgkmcnt(0)" ::: "memory"); __builtin_amdgcn_s_barrier(); asm volatile("" ::: "memory");
        f32x4 wv[2][2];
#pragma unroll
        for (int bj = 0; bj < 2; ++bj)
#pragma unroll
            for (int n = 0; n < 2; ++n) wv[bj][n] = *(const f32x4*)(fw + col0 + bj * HALF + n * 16);
#pragma unroll
        for (int ai = 0; ai < 2; ++ai)
#pragma unroll
            for (int m = 0; m < 4; ++m) { const float rs = R[ai * HALF + wr * 64 + m * 16 + fr]; const size_t off = (size_t)(row0 + ai * HALF + m * 16) * 2048 + col0;
#pragma unroll
                for (int bj = 0; bj < 2; ++bj)
#pragma unroll
                    for (int n = 0; n < 2; ++n) *(f32x4*)(out + off + bj * HALF + n * 16) = acc[ai][bj][m][n] * rs * wv[bj][n]; }
    }
};
template <class Epi, class Sched, bool ALIGN_EPI = false, bool SP2 = false>
__device__ __forceinline__ void gemm_phase(PG8_LAS unsigned char* lds, const Gemm g, const Sched& S, const Epi& E) {
    const int tid = threadIdx.x, wid = __builtin_amdgcn_readfirstlane(tid >> 6), lane = tid & 63, wr = wid >> 2, wc = wid & 3, fr = lane & 15, fq = lane >> 4;
    const int K = g.K, nt = K / BK;
    unsigned voffA[2], voffB[2];
#pragma unroll
    for (int i = 0; i < 2; ++i) { int R, C; stage_rc(tid * 16 + i * 8192, R, C); const int Rb = Epi::PERM ? ((R & ~31) + perm32(R & 31)) : R;
        voffA[i] = (unsigned)(R * K + C) * 2u; voffB[i] = (unsigned)(Rb * K + C) * 2u; }
    const size_t kstep = (size_t)(BK * 2);
    const size_t hstep = (size_t)HALF * K * 2;
    const size_t tstep = 2 * hstep;
    const unsigned ldsw = (unsigned)wid * 1024u;
    const int aoff = lds_byte(wr * 64 + fr, fq * 8), boff = lds_byte(wc * 32 + fr, fq * 8);
#define PG8_SA(b, h) (((b) * 2 + (h)) * HTB)
#define PG8_SB(b, h) ((4 + (b) * 2 + (h)) * HTB)
#define PG8_STAGE(bufoff, gbase, voff) do { _Pragma("unroll") for (int _i = 0; _i < 2; ++_i) \
        __builtin_amdgcn_global_load_lds((const unsigned*)((const char*)(gbase) + (voff)[_i]), (PG8_LAS unsigned*)(lds + (bufoff) + ldsw + _i * 8192), 16, 0, 0); } while (0)
#define PG8_LDA(dst, b, h) do { _Pragma("unroll") for (int m = 0; m < 4; ++m) _Pragma("unroll") for (int k = 0; k < 2; ++k) dst[m][k] = *(const PG8_LAS bf16x8*)(lds + PG8_SA(b, h) + aoff + m * 2048 + k * 1024); } while (0)
#define PG8_LDB(dst, b, h) do { _Pragma("unroll") for (int n = 0; n < 2; ++n) _Pragma("unroll") for (int k = 0; k < 2; ++k) dst[n][k] = *(const PG8_LAS bf16x8*)(lds + PG8_SB(b, h) + boff + n * 2048 + k * 1024); } while (0)
#define PG8_MMA(ai, bj, At, Bt) do { __builtin_amdgcn_s_setprio(1); _Pragma("unroll") for (int m = 0; m < 4; ++m) _Pragma("unroll") for (int n = 0; n < 2; ++n) _Pragma("unroll") for (int k = 0; k < 2; ++k) \
        acc[ai][bj][m][n] = __builtin_amdgcn_mfma_f32_16x16x32_bf16(Bt[n][k], At[m][k], acc[ai][bj][m][n], 0, 0, 0); __builtin_amdgcn_s_setprio(0); } while (0)
#define PG8_WAIT_V(n) asm volatile("s_waitcnt vmcnt(" #n ")" ::: "memory")
#define PG8_WAIT_L(n) asm volatile("s_waitcnt lgkmcnt(" #n ")" ::: "memory")
#define PG8_BAR __builtin_amdgcn_s_barrier()
#define PG8_SCHED __builtin_amdgcn_sched_barrier(0)
    Unit cur, nxt; int ui = 0;
    if (!S.next(0, cur)) return;
    f32x4 acc[2][2][4][2];
#pragma unroll
    for (int a = 0; a < 2; ++a)
#pragma unroll
        for (int b = 0; b < 2; ++b)
#pragma unroll
            for (int m = 0; m < 4; ++m)
#pragma unroll
                for (int n = 0; n < 2; ++n) acc[a][b][m][n] = (f32x4){0.f, 0.f, 0.f, 0.f};
    bf16x8 At[4][2], B0[2][2], B1[2][2];
    const char* cA = (const char*)g.A + (size_t)cur.pm * tstep; const char* cB = (const char*)g.Bt + (size_t)cur.pn * tstep;
    S.a_ready(cur);
    if constexpr (SP2) {
        PG8_STAGE(PG8_SB(0, 0), cB, voffB); PG8_STAGE(PG8_SB(0, 1), cB + hstep, voffB); PG8_STAGE(PG8_SA(0, 0), cA, voffA); PG8_STAGE(PG8_SA(0, 1), cA + hstep, voffA);
        if (wr == 1) PG8_BAR;
        PG8_WAIT_V(2); PG8_BAR;
        PG8_STAGE(PG8_SB(1, 0), cB + kstep, voffB); PG8_STAGE(PG8_SA(1, 0), cA + kstep, voffA); PG8_STAGE(PG8_SB(1, 1), cB + hstep + kstep, voffB);
        PG8_WAIT_V(6); PG8_BAR;
    } else {
        PG8_STAGE(PG8_SB(0, 0), cB, voffB); PG8_STAGE(PG8_SA(0, 0), cA, voffA); PG8_STAGE(PG8_SB(0, 1), cB + hstep, voffB); PG8_STAGE(PG8_SA(0, 1), cA + hstep, voffA);
        if (wr == 1) PG8_BAR;
        PG8_WAIT_V(4); PG8_BAR;
        PG8_STAGE(PG8_SB(1, 0), cB + kstep, voffB); PG8_STAGE(PG8_SA(1, 0), cA + kstep, voffA); PG8_STAGE(PG8_SB(1, 1), cB + hstep + kstep, voffB);
        PG8_WAIT_V(6); PG8_BAR;
    }
    for (;;) {
        const bool has_next = S.next(ui + 1, nxt);
        const char* nA = has_next ? (const char*)g.A + (size_t)nxt.pm * tstep : cA; const char* nB = has_next ? (const char*)g.Bt + (size_t)nxt.pn * tstep : cB;
        for (int t = 0; t < nt; t += 2) {
            const bool last = (t == nt - 2);
            const char* a1 = cA + (size_t)(t + 1) * kstep;
            const char* a2 = last ? nA : cA + (size_t)(t + 2) * kstep; const char* b2 = last ? nB : cB + (size_t)(t + 2) * kstep;
            const char* a3 = a2 + kstep; const char* b3 = b2 + kstep;
            if (last && has_next) S.a_ready(nxt);
            if constexpr (SP2) {
            PG8_LDB(B0, 0, 0); PG8_LDB(B1, 0, 1); PG8_SCHED; PG8_LDA(At, 0, 0); PG8_STAGE(PG8_SA(1, 1), a1 + hstep, voffA);
            PG8_WAIT_V(8); PG8_WAIT_L(0); PG8_BAR; PG8_MMA(0, 0, At, B0); PG8_MMA(0, 1, At, B1); PG8_BAR; PG8_SCHED;
            PG8_LDA(At, 0, 1); PG8_STAGE(PG8_SB(0, 0), b2, voffB); PG8_STAGE(PG8_SB(0, 1), b2 + hstep, voffB); PG8_STAGE(PG8_SA(0, 0), a2, voffA);
            PG8_WAIT_V(8); PG8_WAIT_L(0); PG8_BAR; PG8_MMA(1, 0, At, B0); PG8_MMA(1, 1, At, B1); PG8_BAR; PG8_SCHED;
            PG8_LDB(B0, 1, 0); PG8_LDB(B1, 1, 1); PG8_SCHED; PG8_LDA(At, 1, 0); PG8_STAGE(PG8_SA(0, 1), a2 + hstep, voffA);
            PG8_WAIT_V(8); PG8_WAIT_L(0); PG8_BAR; PG8_MMA(0, 0, At, B0); PG8_MMA(0, 1, At, B1); PG8_BAR; PG8_SCHED;
            PG8_LDA(At, 1, 1); PG8_STAGE(PG8_SB(1, 0), b3, voffB); PG8_STAGE(PG8_SB(1, 1), b3 + hstep, voffB); PG8_STAGE(PG8_SA(1, 0), a3, voffA);
            PG8_WAIT_V(8); PG8_WAIT_L(0); PG8_BAR; PG8_MMA(1, 0, At, B0); PG8_MMA(1, 1, At, B1); PG8_BAR; PG8_SCHED;
            } else {
            PG8_LDB(B0, 0, 0); PG8_SCHED; PG8_LDA(At, 0, 0); PG8_STAGE(PG8_SA(1, 1), a1 + hstep, voffA);
            PG8_WAIT_L(8); PG8_BAR; PG8_WAIT_L(0); PG8_MMA(0, 0, At, B0); PG8_BAR; PG8_SCHED;
            PG8_LDB(B1, 0, 1); PG8_STAGE(PG8_SB(0, 0), b2, voffB);
            PG8_BAR; PG8_WAIT_L(0); PG8_MMA(0, 1, At, B1); PG8_BAR;
            PG8_LDA(At, 0, 1); PG8_STAGE(PG8_SA(0, 0), a2, voffA);
            PG8_BAR; PG8_WAIT_L(0); PG8_MMA(1, 0, At, B0); PG8_BAR; PG8_SCHED;
            PG8_STAGE(PG8_SB(0, 1), b2 + hstep, voffB);
            PG8_WAIT_V(6); PG8_BAR; PG8_MMA(1, 1, At, B1); PG8_BAR;
            PG8_LDB(B0, 1, 0); PG8_SCHED; PG8_LDA(At, 1, 0); PG8_STAGE(PG8_SA(0, 1), a2 + hstep, voffA);
            PG8_WAIT_L(8); PG8_BAR; PG8_WAIT_L(0); PG8_MMA(0, 0, At, B0); PG8_BAR; PG8_SCHED;
            PG8_LDB(B1, 1, 1); PG8_STAGE(PG8_SB(1, 0), b3, voffB);
            PG8_BAR; PG8_WAIT_L(0); PG8_MMA(0, 1, At, B1); PG8_BAR;
            PG8_LDA(At, 1, 1); PG8_STAGE(PG8_SA(1, 0), a3, voffA);
            PG8_BAR; PG8_WAIT_L(0); PG8_MMA(1, 0, At, B0); PG8_BAR; PG8_SCHED;
            PG8_STAGE(PG8_SB(1, 1), b3 + hstep, voffB);
            PG8_WAIT_V(6); PG8_BAR; PG8_MMA(1, 1, At, B1); PG8_BAR;
            }
        }
        if constexpr (ALIGN_EPI) { if (wr == 0) PG8_BAR; }
        if constexpr (!Epi::AFTER_DRAIN) { E(acc, cur, wr, wc, fr, fq); S.done(cur); }
        if (!has_next) break;
#pragma unroll
        for (int a = 0; a < 2; ++a)
#pragma unroll
            for (int b = 0; b < 2; ++b)
#pragma unroll
                for (int m = 0; m < 4; ++m)
#pragma unroll
                    for (int n = 0; n < 2; ++n) acc[a][b][m][n] = (f32x4){0.f, 0.f, 0.f, 0.f};
        cur = nxt; cA = nA; cB = nB; ++ui;
        if constexpr (ALIGN_EPI) { if (wr == 1) PG8_BAR; }
    }
    PG8_WAIT_V(0);
    if constexpr (!ALIGN_EPI) { if (wr == 0) PG8_BAR; }
    PG8_BAR;
    if constexpr (Epi::AFTER_DRAIN) { E.fused(acc, cur, wr, wc, fr, fq, lds, wid, lane); S.done(cur); }
#undef PG8_SA
#undef PG8_SB
#undef PG8_STAGE
#undef PG8_LDA
#undef PG8_LDB
#undef PG8_MMA
#undef PG8_WAIT_V
#undef PG8_WAIT_L
#undef PG8_BAR
#undef PG8_SCHED
}
}
#ifndef PG8_SP2
#define PG8_SP2 true
#endif
#ifndef PG8_ALIGN
#define PG8_ALIGN true
#endif

constexpr int NWAVES = 8, NTHREADS = NWAVES * 64;
constexpr int DM = 2048, NBATCH = 4, SEQ = 4096, M = NBATCH * SEQ;
constexpr int NPROJ_IN = 7184;
constexpr int NPJ = 7168;
constexpr int C_GQ = 0, C_GK = 512, C_GV = 1024, C_GG = 2048, C_HQ = 3072, C_HF = 4096, C_HI = 5120, C_HG = 6144;
constexpr int SRC_GLR = 3072;
constexpr float EPS = 1e-6f, QSCALE = 0.08838834764831845f, INV_TAU = 1.0f / 16.0f;
constexpr int CHUNK = 64, NCHUNK = SEQ / CHUNK;

constexpr size_t MiB = 1u << 20;
constexpr size_t WS_CTL = 0, CTL_ZERO_BYTES = 128 * 1024;
constexpr size_t WS_WINT = 2 * MiB;
constexpr size_t WS_WOUTT = 30 * MiB;
constexpr size_t WS_XCH = 40 * MiB;
constexpr size_t WS_GLR = 39 * MiB;
constexpr size_t WS_HN = 64 * MiB;
constexpr size_t WS_MIX = 128 * MiB;
constexpr size_t WS_PJ = 192 * MiB;
constexpr size_t WS_END = 416 * MiB;

constexpr int LDS_BYTES = 163840;
constexpr int QK_STRIDE = 272, KT_STRIDE = 320, L_QT = 0, L_KT = 64 * QK_STRIDE, L_VR = L_KT + 64 * KT_STRIDE, L_AM = L_VR + 64 * 576;
constexpr int L_TOT = L_AM + 64 * 144, L_FAC = L_TOT + 8 * 128 * 4, L_SS = L_FAC + 128 * 4, L_RS = L_SS + 8 * 64 * 4, L_LG = L_RS + 64 * 4, L_KS = L_LG + 64 * 128 * 4, L_SCAN_END = L_KS + 64 * 128 * 4;
static_assert(L_SCAN_END <= LDS_BYTES - 128, "scan LDS map");

#define LAS __attribute__((address_space(3)))
typedef unsigned short bf16;
typedef float f32x4 __attribute__((ext_vector_type(4)));
typedef float f32x2 __attribute__((ext_vector_type(2)));
typedef float f32x16 __attribute__((ext_vector_type(16)));
typedef short bf16x8 __attribute__((ext_vector_type(8)));
typedef short s16x4 __attribute__((ext_vector_type(4)));
typedef unsigned u32x4 __attribute__((ext_vector_type(4)));
typedef unsigned u32x2 __attribute__((ext_vector_type(2)));
typedef __bf16 bf16x2_t __attribute__((ext_vector_type(2)));
#define MFMA32(a, b, c) __builtin_amdgcn_mfma_f32_32x32x16_bf16((a), (b), (c), 0, 0, 0)

__device__ __forceinline__ unsigned pk2(float lo, float hi) { const bf16x2_t v = __builtin_convertvector((f32x2){lo, hi}, bf16x2_t); return __builtin_bit_cast(unsigned, v); }
__device__ __forceinline__ float bf_lo(unsigned u) { return __uint_as_float(u << 16); }
__device__ __forceinline__ float bf_hi(unsigned u) { return __uint_as_float(u & 0xffff0000u); }
__device__ __forceinline__ float wave_sum(float v) {
#pragma unroll
    for (int o = 1; o < 64; o <<= 1) v += __shfl_xor(v, o);
    return v;
}
constexpr float LOG2E = 1.4426950408889634f, LOG2_QSCALE = -3.5f;
__device__ __forceinline__ void split_bf16(const float (&x)[8], bf16x8& hi, bf16x8& lo) {
    u32x4 h, l;
#pragma unroll
    for (int p = 0; p < 4; ++p) { const unsigned hp = pk2(x[2 * p], x[2 * p + 1]); h[p] = hp; l[p] = pk2(x[2 * p] - bf_lo(hp), x[2 * p + 1] - bf_hi(hp)); }
    hi = __builtin_bit_cast(bf16x8, h); lo = __builtin_bit_cast(bf16x8, l);
}
__device__ __forceinline__ float row16_allsum(float x) {
    x += __builtin_bit_cast(float, __builtin_amdgcn_update_dpp(0, __builtin_bit_cast(int, x), 0x121, 0xf, 0xf, false));
    x += __builtin_bit_cast(float, __builtin_amdgcn_update_dpp(0, __builtin_bit_cast(int, x), 0x122, 0xf, 0xf, false));
    x += __builtin_bit_cast(float, __builtin_amdgcn_update_dpp(0, __builtin_bit_cast(int, x), 0x124, 0xf, 0xf, false));
    x += __builtin_bit_cast(float, __builtin_amdgcn_update_dpp(0, __builtin_bit_cast(int, x), 0x128, 0xf, 0xf, false));
    return x;
}
__device__ __forceinline__ void bstore128_wt(u32x4 w, __amdgpu_buffer_rsrc_t rs, unsigned voff, unsigned soff) {
    __builtin_amdgcn_raw_buffer_store_b128(w, rs, voff, soff, 16);
    asm volatile("s_nop 1" :: "v"(w));
}
__device__ __forceinline__ void bstore128(u32x4 w, __amdgpu_buffer_rsrc_t rs, unsigned voff, unsigned soff) {
    __builtin_amdgcn_raw_buffer_store_b128(w, rs, voff, soff, 0);
    asm volatile("s_nop 1" :: "v"(w));
}
__device__ __forceinline__ float ex2(float x) { return __builtin_amdgcn_exp2f(x); }
__device__ __forceinline__ float lg2(float x) { return __builtin_amdgcn_logf(x); }
__device__ __forceinline__ float fsig(float x) { return __builtin_amdgcn_rcpf(1.0f + ex2(-LOG2E * x)); }

#define XB_TMO      128
#define XB_XCNT(j)  (256  + 64 * (j))
#define XB_XSUB(j)  (1280 + 64 * (j))
#define XB_XGEN(j)  (2304 + 64 * (j))
#define XB_TOP      3328
#define XB_TOPGEN   3392
#define XCD_BAR_WORDS 3456
#define XB_SPIN_CAP (1u << 18)

__device__ __forceinline__ unsigned xb_ld(unsigned* p)              { return __hip_atomic_load(p, __ATOMIC_RELAXED, __HIP_MEMORY_SCOPE_AGENT); }
__device__ __forceinline__ unsigned xb_add(unsigned* p, unsigned v) { return __hip_atomic_fetch_add(p, v, __ATOMIC_RELAXED, __HIP_MEMORY_SCOPE_AGENT); }
__device__ __forceinline__ unsigned xb_xcc_id() { return (unsigned)__builtin_amdgcn_s_getreg((3 << 11) | 20) & 0xFu; }
#define XB_SPIN(cond, bar) do { unsigned _sp = 0; while (cond) { __builtin_amdgcn_s_sleep(1); \
    if ((++_sp & 255u) == 0u) { if (xb_ld(&(bar)[XB_TMO])) break; if (_sp > XB_SPIN_CAP) { atomicAdd(&(bar)[XB_TMO], 1u); break; } } } } while (0)

struct XcdBarrier {
    unsigned* bar; unsigned x;
    volatile LAS unsigned* st;
};

__device__ __forceinline__ XcdBarrier xcd_barrier_post(unsigned* bar, volatile LAS unsigned* st) {
    XcdBarrier b; b.bar = bar; b.x = xb_xcc_id(); b.st = st;
    if (threadIdx.x == 0) (void)xb_add(&bar[XB_XCNT(b.x)], 1u);
    return b;
}
__device__ __forceinline__ void xcd_barrier_complete(unsigned* bar, unsigned x, unsigned& nloc, unsigned& nx) {
    const unsigned G = gridDim.x * gridDim.y * gridDim.z;
    unsigned sum, cnt, mine, sp = 0u;
    for (;;) {
        sum = 0u; cnt = 0u; mine = 0u;
#pragma unroll
        for (unsigned j = 0; j < 16; ++j) { const unsigned c = xb_ld(&bar[XB_XCNT(j)]); sum += c; cnt += (c > 0u) ? 1u : 0u; mine = (j == x) ? c : mine; }
        if (sum == G) break;
        __builtin_amdgcn_s_sleep(1);
        if ((++sp & 255u) == 0u) { if (xb_ld(&bar[XB_TMO])) break; if (sp > XB_SPIN_CAP) { atomicAdd(&bar[XB_TMO], 1u); break; } }
    }
    nloc = mine > 0u ? mine : 1u; nx = cnt > 0u ? cnt : 1u;
}

__device__ __forceinline__ void xcd_barrier(const XcdBarrier& b) {
    asm volatile("s_waitcnt vmcnt(0)" ::: "memory");
    __syncthreads();
    if (threadIdx.x == 0) {
        unsigned* bar = b.bar;
        __builtin_amdgcn_s_waitcnt(0);
        unsigned nloc = b.st[0], nx = b.st[1];
        if (nloc == 0u) { xcd_barrier_complete(bar, b.x, nloc, nx); b.st[0] = nloc; b.st[1] = nx; }
        const unsigned old = xb_add(&bar[XB_XSUB(b.x)], 1u);
        const unsigned gen = old / nloc;
        if (old + 1u == (gen + 1u) * nloc) {
            __builtin_amdgcn_fence(__ATOMIC_RELEASE, "agent");
            asm volatile("s_waitcnt vmcnt(0)" ::: "memory");
            const unsigned og = xb_add(&bar[XB_TOP], 1u);
            const unsigned tg = og / nx;
            if (og + 1u == (tg + 1u) * nx) xb_add(&bar[XB_TOPGEN], 1u);
            else XB_SPIN(xb_ld(&bar[XB_TOPGEN]) == tg, bar);
            __builtin_amdgcn_fence(__ATOMIC_ACQUIRE, "agent");
            xb_add(&bar[XB_XGEN(b.x)], 1u);
            asm volatile("s_waitcnt vmcnt(0)" ::: "memory");
        } else {
            XB_SPIN(xb_ld(&bar[XB_XGEN(b.x)]) == gen, bar);
            __builtin_amdgcn_fence(__ATOMIC_ACQUIRE, "agent");
            asm volatile("s_waitcnt vmcnt(0)" ::: "memory");
        }
    }
    __syncthreads();
}

constexpr int CW_PANEL = 16384;
constexpr int CW_SEQ = 24576;
constexpr int CW_BAR = 4096;
constexpr int MISC_OFF = LDS_BYTES - 128;

struct Frame {
    LAS unsigned char* lds;
    int tid, lane, wave, G, bid;
    const float *x, *norm_w, *w_in, *gla_w_up, *gla_b_up, *gla_norm_w, *hgrn_lb, *hgrn_norm_w, *w_out, *final_w;
    float* out;
    bf16 *WinT, *WoutT, *HN, *MIX, *PJ;
    float* GLR;
    unsigned char* ws;
};

__device__ __forceinline__ void p0_transpose_item(const float* W, int ldw, int src_col, bf16* WT, int K, int dst_row, int kb, LAS float* scr, int lane) {
    const int k0 = 64 * kb;
#pragma unroll 8
    for (int i = 0; i < 32; ++i) { const int kk = 2 * i + (lane >> 5); scr[kk * 33 + (lane & 31)] = W[(size_t)(k0 + kk) * ldw + src_col + (lane & 31)]; }
    asm volatile("s_waitcnt lgkmcnt(0)" ::: "memory");
    const int c = lane & 7;
#pragma unroll
    for (int j = 0; j < 4; ++j) { const int n = (lane >> 3) + 8 * j; const LAS float* s = scr + (8 * c) * 33 + n;
        u32x4 o; o.x = pk2(s[0 * 33], s[1 * 33]); o.y = pk2(s[2 * 33], s[3 * 33]); o.z = pk2(s[4 * 33], s[5 * 33]); o.w = pk2(s[6 * 33], s[7 * 33]);
        *(u32x4*)(WT + (size_t)(dst_row + n) * K + k0 + 8 * c) = o; }
    asm volatile("s_waitcnt lgkmcnt(0)" ::: "memory");
}

__device__ __forceinline__ void p0_prologue(Frame& F) {
    const int gw = F.bid * NWAVES + F.wave, NGW = F.G * NWAVES;
    LAS float* Wt = (LAS float*)F.lds;
    for (int k = F.tid; k < DM; k += NTHREADS) {
        const f32x4* src = (const f32x4*)(F.w_in + (size_t)k * NPROJ_IN + SRC_GLR);
#pragma unroll
        for (int q = 0; q < 4; ++q) { const f32x4 v = src[q]; Wt[(4 * q + 0) * DM + k] = v[0]; Wt[(4 * q + 1) * DM + k] = v[1]; Wt[(4 * q + 2) * DM + k] = v[2]; Wt[(4 * q + 3) * DM + k] = v[3]; }
    }
    __syncthreads();
    f32x4 nw[8];
#pragma unroll
    for (int j = 0; j < 8; ++j) nw[j] = ((const f32x4*)F.norm_w)[64 * j + F.lane];
    const LAS f32x4* Wt4 = (const LAS f32x4*)Wt;
    for (int m = gw; m < M; m += NGW) {
        const f32x4* xr = (const f32x4*)(F.x + (size_t)m * DM) + F.lane;
        f32x4 v[8]; float s = 0.f;
#pragma unroll
        for (int j = 0; j < 8; ++j) { v[j] = xr[64 * j]; s += (v[j][0] * v[j][0] + v[j][1] * v[j][1]) + (v[j][2] * v[j][2] + v[j][3] * v[j][3]); }
        const float rstd = 1.0f / sqrtf(wave_sum(s) * (1.0f / DM) + EPS);
        float a[16];
#pragma unroll
        for (int c = 0; c < 16; ++c) a[c] = 0.f;
        u32x2* o8 = (u32x2*)(F.HN + (size_t)m * DM) + F.lane;
#pragma unroll
        for (int j = 0; j < 8; ++j) {
            v[j] = v[j] * rstd * nw[j];
            u32x2 w; w.x = pk2(v[j][0], v[j][1]); w.y = pk2(v[j][2], v[j][3]); o8[64 * j] = w;
            asm volatile("" ::: "memory");
#pragma unroll
            for (int c = 0; c < 16; ++c) { const f32x4 wv = Wt4[c * (DM / 4) + 64 * j + F.lane]; a[c] += (v[j][0] * wv[0] + v[j][1] * wv[1]) + (v[j][2] * wv[2] + v[j][3] * wv[3]); }
        }
        float mine = 0.f;
#pragma unroll
        for (int c = 0; c < 16; ++c) { const float t = wave_sum(a[c]); mine = (F.lane == c) ? t : mine; }
        if (F.lane < 16) F.GLR[(size_t)m * 16 + F.lane] = mine;
    }
    __syncthreads();
    {
        LAS float* scr = (LAS float*)(F.lds + F.wave * 16384);
        constexpr int KB = DM / 64;
        constexpr int I_IN = KB * (NPJ / 32), I_OUT = KB * (DM / 32);
        for (int it = gw; it < I_IN + (MK_ONE_LAUNCH ? 0 : I_OUT); it += NGW) {
            if (it < I_IN) { const int kb = it / (NPJ / 32), nb = it % (NPJ / 32), n0 = 32 * nb; const int src = n0 < SRC_GLR ? n0 : n0 + 16;
                p0_transpose_item(F.w_in, NPROJ_IN, src, F.WinT, DM, n0, kb, scr, F.lane); }
            else { const int r = it - I_IN, kb = r / (DM / 32), nb = r % (DM / 32);
                p0_transpose_item(F.w_out, DM, 32 * nb, F.WoutT, DM, 32 * nb, kb, scr, F.lane); }
        }
    }
    __syncthreads();
}

constexpr int NSEG_G = 8, NSEG_H = 4;
constexpr size_t WS_LG = WS_HN, WS_LH = WS_HN + 16 * MiB, WS_DG = WS_HN + 48 * MiB, WS_DH = WS_HN + 49 * MiB;
static_assert(16 * NSEG_G * 131072 <= 16 * MiB && 32 * NSEG_H * 65536 <= 32 * MiB, "L buffers");

__device__ __forceinline__ bf16x8 tr_frag(LAS unsigned char* img, unsigned lanebase, unsigned stride, unsigned c, unsigned ks) {
    const unsigned a0 = lanebase + (16 * ks) * stride + 64 * c;
    const s16x4 lo = __builtin_amdgcn_ds_read_tr16_b64_v4i16((LAS s16x4*)(img + a0));
    const s16x4 hi = __builtin_amdgcn_ds_read_tr16_b64_v4i16((LAS s16x4*)(img + a0 + 4 * stride));
    return __builtin_shufflevector(lo, hi, 0, 1, 2, 3, 4, 5, 6, 7);
}

template <int GLA, int PASSB>
__device__ __forceinline__ void scan_item(Frame& F, const int b, const int h, const int seg) {
    constexpr int dv = GLA ? 256 : 128, nmw = dv / 32, NSEG = GLA ? NSEG_G : NSEG_H, NC = NCHUNK / NSEG;
    constexpr unsigned vstride = 2 * dv + 64;
    constexpr int NVL = 64 * (dv / 8) / NTHREADS;
    constexpr int CPR = dv / 8, RPP = NTHREADS / CPR;
    constexpr int OS = dv * 4;
    const int tid = F.tid, lane = F.lane, wave = F.wave;
    LAS unsigned char* lds = F.lds;
    LAS unsigned char* QT = lds + L_QT; LAS unsigned char* KT = lds + L_KT; LAS unsigned char* VR = lds + L_VR; LAS unsigned char* AM = lds + L_AM;
    LAS float* TOT = (LAS float*)(lds + L_TOT); LAS float* FAC = (LAS float*)(lds + L_FAC); LAS float* NW = (LAS float*)(lds + L_SS);
    LAS float* LG = (LAS float*)(lds + L_LG); LAS float* KS = (LAS float*)(lds + L_KS);
    LAS unsigned char* O32 = lds + (GLA ? L_LG : L_KS);
    const int qcol = GLA ? C_GQ + h * 128 : C_HQ + h * 128, kcol = GLA ? C_GK + h * 128 : C_HF + h * 128;
    const int vcol = GLA ? C_GV + h * 256 : C_HI + h * 128, gcol = GLA ? C_GG + h * 256 : C_HG + h * 128;
    const int mcol = GLA ? h * 256 : 1024 + h * 128;
    const float* normw = GLA ? F.gla_norm_w + h * 256 : F.hgrn_norm_w + h * 128;
    const int dp = tid & 63, d0 = 2 * dp;
    const int item = GLA ? (b * 4 + h) * NSEG + seg : (b * 8 + h) * NSEG + seg;
    float* Lbase = (float*)(F.ws + (GLA ? WS_LG : WS_LH)); float* Dbase = (float*)(F.ws + (GLA ? WS_DG : WS_DH));
    constexpr int LSZ = 128 * dv;
    float lb0 = 0.f, lb1 = 0.f;
    if (!GLA) {
        const f32x2 l0 = *(const f32x2*)(F.hgrn_lb + h * 128 + d0), l1 = *(const f32x2*)(F.hgrn_lb + 1024 + h * 128 + d0);
        lb0 = 1.0f / (1.0f + __expf(l1[0] - l0[0])); lb1 = 1.0f / (1.0f + __expf(l1[1] - l0[1]));
    }
    unsigned warm = 0u;
    if (PASSB && seg > 0) {
        const unsigned t_row0 = (unsigned)(b * SEQ + seg * NC * CHUNK);
        const __amdgpu_buffer_rsrc_t rs_w = __builtin_amdgcn_make_buffer_rsrc((void*)F.PJ, 0, (int)((size_t)M * NPJ * 2), 0x00020000);
#define WPJB(T, COL) ((((((unsigned)(T)) >> 8) * (unsigned)(NPJ / 256) + (((unsigned)(COL)) >> 8)) << 17) + ((((unsigned)(T)) & 255u) << 9) + ((((unsigned)(COL)) & 255u) << 1))
        const unsigned wr_ = (unsigned)(tid & 63), wp = (unsigned)(tid >> 6);
        if (GLA) {
            const unsigned c1 = wp < 2 ? (unsigned)qcol : wp < 4 ? (unsigned)kcol : (unsigned)vcol, l1 = wp < 4 ? (wp & 1u) : wp - 4u;
            warm += __builtin_amdgcn_raw_buffer_load_b32(rs_w, wr_ * 512u + l1 * 128u, WPJB(t_row0, c1), 0);
            if (wp < 4) warm += __builtin_amdgcn_raw_buffer_load_b32(rs_w, wr_ * 512u + wp * 128u, WPJB(t_row0, gcol), 0);
            else if (wp == 4) warm += __float_as_uint(F.GLR[(size_t)(t_row0 + wr_) * 16]);
        } else {
            const unsigned c1 = wp < 2 ? (unsigned)qcol : wp < 4 ? (unsigned)kcol : wp < 6 ? (unsigned)vcol : (unsigned)gcol;
            warm += __builtin_amdgcn_raw_buffer_load_b32(rs_w, wr_ * 512u + (wp & 1u) * 128u, WPJB(t_row0, c1), 0);
        }
#undef WPJB
    }
    if (PASSB && seg > 0) {
        if (tid == 0) { unsigned* flag = (unsigned*)(F.ws + WS_CTL) + CW_SEQ + 64 * (GLA ? b * 4 + h : 16 + b * 8 + h); unsigned sp = 0;
            while (__hip_atomic_load(flag, __ATOMIC_RELAXED, __HIP_MEMORY_SCOPE_AGENT) < (unsigned)(NSEG - 1)) { __builtin_amdgcn_s_sleep(2); if (++sp > (1u << 21)) break; }
            __builtin_amdgcn_fence(__ATOMIC_ACQUIRE, "agent");
            asm volatile("s_waitcnt vmcnt(0)" ::: "memory"); }
        __syncthreads();
    }
    if (PASSB && tid < dv) NW[tid] = normw[tid];
    float elp0 = 1.f, elp1 = 1.f, dsum0 = GLA ? 0.f : 1.f, dsum1 = dsum0;
    const unsigned r = lane & 31, hh = lane >> 5;
    const unsigned tq = (lane & 15) >> 2, tp = lane & 3, tblk = (lane >> 4) & 1;
    const unsigned trk = (8 * hh + tq) * KT_STRIDE + 32 * tblk + 8 * tp, trv = (8 * hh + tq) * vstride + 32 * tblk + 8 * tp;
    const size_t row0 = (size_t)b * SEQ + (size_t)seg * NC * CHUNK;

    f32x16 S[4];
#pragma unroll
    for (int i = 0; i < 4; ++i)
#pragma unroll
        for (int j = 0; j < 16; ++j) S[i][j] = 0.f;
    if (PASSB) {
        constexpr int NS = NSEG - 1, BS = 3;
        LAS float* DS = (LAS float*)AM;
        const __amdgpu_buffer_rsrc_t rs_l = __builtin_amdgcn_make_buffer_rsrc((void*)Lbase, 0, (GLA ? 16 : 32) * NSEG * LSZ * 2, 0x00020000);
        u32x4 lv[BS][8];
#define FOLD_LD(SP0) do { _Pragma("unroll") for (int jj = 0; jj < BS; ++jj) { const int sp = (SP0) + jj; const bool ok = sp < seg; \
            const unsigned vo = (unsigned)lane * 16u + (ok ? 0u : 0x40000000u); const unsigned so = (unsigned)((item - seg + (ok ? sp : 0)) * (LSZ * 2) + wave * 8 * 1024); \
            _Pragma("unroll") for (int q = 0; q < 8; ++q) lv[jj][q] = __builtin_amdgcn_raw_buffer_load_b128(rs_l, vo, so + q * 1024, 0); } } while (0)
#define FOLD_FMA(SP0) do { _Pragma("unroll") for (int jj = 0; jj < BS; ++jj) { const int j = ((SP0) + jj < NS) ? (SP0) + jj : NS; \
            _Pragma("unroll") for (int db = 0; db < 4; ++db) _Pragma("unroll") for (int g2 = 0; g2 < 2; ++g2) { const u32x4 l = lv[jj][db * 2 + g2]; \
                const f32x4 da = *(const LAS f32x4*)(DS + j * 128 + 32 * db + 16 * g2 + 4 * hh), dbv = *(const LAS f32x4*)(DS + j * 128 + 32 * db + 16 * g2 + 8 + 4 * hh); \
                const float lf[8] = {bf_lo(l.x), bf_hi(l.x), bf_lo(l.y), bf_hi(l.y), bf_lo(l.z), bf_hi(l.z), bf_lo(l.w), bf_hi(l.w)}; \
                _Pragma("unroll") for (int e = 0; e < 4; ++e) { S[db][8 * g2 + e] = S[db][8 * g2 + e] * da[e] + lf[e]; S[db][8 * g2 + 4 + e] = S[db][8 * g2 + 4 + e] * dbv[e] + lf[4 + e]; } } } } while (0)
        float dreg[2];
#pragma unroll
        for (int q = 0; q < 2; ++q) { const int i = tid + q * NTHREADS, sp = i >> 7; dreg[q] = (sp < seg) ? Dbase[(size_t)(item - seg + sp) * 128 + (i & 127)] : 1.0f; }
        if (wave < nmw && seg > 0) FOLD_LD(0);
#pragma unroll
        for (int q = 0; q < 2; ++q) { const int i = tid + q * NTHREADS; if (i < (NS + 1) * 128) DS[i] = dreg[q]; }
        __syncthreads();
        if (wave < nmw && seg > 0) {
            FOLD_FMA(0);
            for (int sp0 = BS; sp0 < seg; sp0 += BS) { FOLD_LD(sp0); FOLD_FMA(sp0); }
        }
#undef FOLD_LD
#undef FOLD_FMA
    }
    asm volatile("" :: "v"(warm));
    bf16x8 wbh = {0, 0, 0, 0, 0, 0, 0, 0}, wbl = {0, 0, 0, 0, 0, 0, 0, 0}; float bub = 0.f;
    if (GLA) {
        if (PASSB && MK_ONE_LAUNCH && seg > 0) {
            const LAS unsigned* ST = (const LAS unsigned*)(lds + L_KS);
            u32x4 a, c2; a.x = ST[0 * NTHREADS + tid]; a.y = ST[1 * NTHREADS + tid]; a.z = ST[2 * NTHREADS + tid]; a.w = ST[3 * NTHREADS + tid];
            c2.x = ST[4 * NTHREADS + tid]; c2.y = ST[5 * NTHREADS + tid]; c2.z = ST[6 * NTHREADS + tid]; c2.w = ST[7 * NTHREADS + tid];
            wbh = __builtin_bit_cast(bf16x8, a); wbl = __builtin_bit_cast(bf16x8, c2); bub = __uint_as_float(ST[8 * NTHREADS + tid]);
        } else {
            const int col = h * 128 + 32 * (wave & 3) + (lane & 31);
            float wv[8];
#pragma unroll
            for (int j = 0; j < 8; ++j) wv[j] = F.gla_w_up[(size_t)(8 * (lane >> 5) + j) * 512 + col];
            split_bf16(wv, wbh, wbl);
            bub = F.gla_b_up[col];
        }
    }
    const __amdgpu_buffer_rsrc_t rs_pj = __builtin_amdgcn_make_buffer_rsrc((void*)F.PJ, 0, (int)((size_t)M * NPJ * 2), 0x00020000);
    const __amdgpu_buffer_rsrc_t rs_glr = __builtin_amdgcn_make_buffer_rsrc((void*)F.GLR, 0, M * 16 * 4, 0x00020000);
    const __amdgpu_buffer_rsrc_t rs_mix = __builtin_amdgcn_make_buffer_rsrc((void*)F.MIX, 0, (int)((size_t)M * DM * 2), 0x00020000);
    const unsigned vo_qk = 4 * dp, vo_g = ((lane & 31) * 16 + 8 * (lane >> 5)) * 4, vo_v = (tid / CPR) * 512 + (tid % CPR) * 16, vo_m = (tid / CPR) * (DM * 2) + (tid % CPR) * 16;
#define PJB(T, COL) ((((((unsigned)(T)) >> 8) * (unsigned)(NPJ / 256) + (((unsigned)(COL)) >> 8)) << 17) + ((((unsigned)(T)) & 255u) << 9) + ((((unsigned)(COL)) & 255u) << 1))
    unsigned nq[8], nk[8]; u32x4 ng[2]; u32x4 vn[NVL], gt[NVL], gn[NVL];
#define PF_K(T0) do { const unsigned _sk = PJB(T0, kcol) + 8 * wave * 512; _Pragma("unroll") for (int i = 0; i < 8; ++i) nk[i] = __builtin_amdgcn_raw_buffer_load_b32(rs_pj, vo_qk, _sk + i * 512, 0); } while (0)
#define PF_Q(T0) do { const unsigned _sq = PJB(T0, qcol) + 8 * wave * 512; _Pragma("unroll") for (int i = 0; i < 8; ++i) nq[i] = __builtin_amdgcn_raw_buffer_load_b32(rs_pj, vo_qk, _sq + i * 512, 0); } while (0)
#define PF_G(T0) do { const unsigned _sg = ((unsigned)(T0) + 32 * (wave >> 2)) * 64; ng[0] = __builtin_amdgcn_raw_buffer_load_b128(rs_glr, vo_g, _sg, 0); ng[1] = __builtin_amdgcn_raw_buffer_load_b128(rs_glr, vo_g, _sg + 16, 0); } while (0)
#define PF_V(T0) do { const unsigned _sv = PJB(T0, vcol); _Pragma("unroll") for (int j = 0; j < NVL; ++j) vn[j] = __builtin_amdgcn_raw_buffer_load_b128(rs_pj, vo_v, _sv + j * (RPP * 512), 0); } while (0)
#pragma unroll
    for (int i = 0; i < 8; ++i) nq[i] = 0u;
    ng[0] = (u32x4){0u, 0u, 0u, 0u}; ng[1] = ng[0];
    if (GLA) PF_G(row0); PF_K(row0); if (PASSB) PF_Q(row0); PF_V(row0);
    if (PASSB) { const unsigned _sv = PJB(row0, gcol);
#pragma unroll
        for (int j = 0; j < NVL; ++j) gt[j] = __builtin_amdgcn_raw_buffer_load_b128(rs_pj, vo_v, _sv + j * (RPP * 512), 0); }
    float lgr[16];
#pragma unroll
    for (int j = 0; j < 16; ++j) lgr[j] = 0.f;
#define GLA_Z() do { f32x16 z; _Pragma("unroll") for (int j = 0; j < 16; ++j) z[j] = 0.f; \
        { const float gv[8] = {__uint_as_float(ng[0].x), __uint_as_float(ng[0].y), __uint_as_float(ng[0].z), __uint_as_float(ng[0].w), __uint_as_float(ng[1].x), __uint_as_float(ng[1].y), __uint_as_float(ng[1].z), __uint_as_float(ng[1].w)}; \
          bf16x8 ah, al; split_bf16(gv, ah, al); \
          z = MFMA32(al, wbh, z); z = MFMA32(ah, wbl, z); z = MFMA32(ah, wbh, z); }     \
        _Pragma("unroll") for (int reg = 0; reg < 16; ++reg) { const float zz = z[reg] + bub; lgr[reg] = (fminf(zz, 0.f) * LOG2E - lg2(1.0f + ex2(-LOG2E * fabsf(zz)))) * INV_TAU; } } while (0)
    if (GLA) { GLA_Z(); PF_G(NC > 1 ? row0 + CHUNK : row0); }
    float fa0[8], fa1[8];
#pragma unroll
    for (int i = 0; i < 8; ++i) { fa0[i] = 0.f; fa1[i] = 0.f; }
#define HG_F() do { _Pragma("unroll") for (int i = 0; i < 8; ++i) { const unsigned kv = nk[i]; fa0[i] = lb0 + (1.0f - lb0) * fsig(bf_lo(kv)); fa1[i] = lb1 + (1.0f - lb1) * fsig(bf_hi(kv)); } } while (0)
    if (!GLA && PASSB) { HG_F(); PF_K(NC > 1 ? row0 + CHUNK : row0); }

    for (int c = 0; c < NC; ++c) {
        const size_t t0 = row0 + (size_t)c * CHUNK;
        const size_t tn = (c + 1 < NC) ? t0 + CHUNK : t0;
        if (PASSB) { const unsigned _sv = PJB(tn, gcol);
#pragma unroll
            for (int j = 0; j < NVL; ++j) gn[j] = __builtin_amdgcn_raw_buffer_load_b128(rs_pj, vo_v, _sv + j * (RPP * 512), 0); }
        float hk0[8], hk1[8], hc0[8], hc1[8];
        if (GLA) {
#pragma unroll
            for (int reg = 0; reg < 16; ++reg) { const int row = 32 * (wave >> 2) + (reg & 3) + 8 * (reg >> 2) + 4 * (lane >> 5);
                LG[row * 128 + 32 * (wave & 3) + (lane & 31)] = lgr[reg]; }
            __syncthreads();
        }
        {
            if (PASSB) {
#pragma unroll
                for (int j = 0; j < NVL; ++j) { const u32x4 g = gt[j]; u32x4 w;
                    w.x = pk2(bf_lo(g.x) * fsig(bf_lo(g.x)), bf_hi(g.x) * fsig(bf_hi(g.x))); w.y = pk2(bf_lo(g.y) * fsig(bf_lo(g.y)), bf_hi(g.y) * fsig(bf_hi(g.y)));
                    w.z = pk2(bf_lo(g.z) * fsig(bf_lo(g.z)), bf_hi(g.z) * fsig(bf_hi(g.z))); w.w = pk2(bf_lo(g.w) * fsig(bf_lo(g.w)), bf_hi(g.w) * fsig(bf_hi(g.w)));
                    gt[j] = w; asm volatile("" : "+v"(gt[j])); }
            }
            float cum0 = GLA ? 0.f : 1.f, cum1 = cum0;
#pragma unroll
            for (int i = 0; i < 8; ++i) {
                LAS f32x2* lgp = (LAS f32x2*)(LG + (8 * wave + i) * 128 + d0);
                if (GLA) { const f32x2 lgv = *lgp; cum0 += lgv[0]; cum1 += lgv[1]; *lgp = (f32x2){cum0, cum1}; }
                else if (PASSB) {
                    const float f0 = fa0[i], f1 = fa1[i];
                    cum0 *= f0; cum1 *= f1;
                    hk0[i] = 1.0f - f0; hk1[i] = 1.0f - f1; hc0[i] = cum0; hc1[i] = cum1;
                }
            }
            if (!GLA && !PASSB) {
#pragma unroll
                for (int i = 7; i >= 0; --i) {
                    const unsigned kv = nk[i];
                    const float s0 = fsig(bf_lo(kv)), s1 = fsig(bf_hi(kv));
                    const float f0 = lb0 + (1.0f - lb0) * s0, f1 = lb1 + (1.0f - lb1) * s1;
                    *(LAS f32x2*)(KS + (8 * wave + i) * 128 + d0) = (f32x2){(1.0f - f0) * cum0, (1.0f - f1) * cum1};
                    cum0 *= f0; cum1 *= f1;
                }
            }
            *(LAS f32x2*)(TOT + wave * 128 + d0) = (f32x2){cum0, cum1};
        }
        if (!GLA && !PASSB) PF_K(tn);
        __syncthreads();
        if (!GLA && !PASSB) {
            float off0 = 1.f, off1 = 1.f, bl0 = 1.f, bl1 = 1.f;
#pragma unroll
            for (int g = 0; g < 8; ++g) { const f32x2 tv = *(const LAS f32x2*)(TOT + g * 128 + d0);
                if (g > wave) { off0 *= tv[0]; off1 *= tv[1]; } bl0 *= tv[0]; bl1 *= tv[1]; }
#pragma unroll
            for (int i = 0; i < 8; ++i) { const f32x2 kv = *(const LAS f32x2*)(KS + (8 * wave + i) * 128 + d0);
                *(LAS unsigned*)(KT + (8 * wave + i) * KT_STRIDE + 4 * dp) = pk2(kv[0] * off0, kv[1] * off1); }
            if (wave == 0) { *(LAS f32x2*)(FAC + d0) = (f32x2){bl0, bl1}; dsum0 *= bl0; dsum1 *= bl1; }
        } else if (!GLA) {
            float off0 = 1.f, off1 = 1.f, r0 = 1.f, r1 = 1.f, bl0 = 1.f, bl1 = 1.f;
#pragma unroll
            for (int g = 0; g < 8; ++g) { const f32x2 tv = *(const LAS f32x2*)(TOT + g * 128 + d0);
                if (g < wave) { off0 *= tv[0]; off1 *= tv[1]; } if (g < 4) { r0 *= tv[0]; r1 *= tv[1]; } bl0 *= tv[0]; bl1 *= tv[1]; }
            const float ir0 = __builtin_amdgcn_rcpf(r0), ir1 = __builtin_amdgcn_rcpf(r1);
            off0 *= ir0; off1 *= ir1;
#pragma unroll
            for (int i = 0; i < 8; ++i) {
                const float p0 = off0 * hc0[i], p1 = off1 * hc1[i];
                const unsigned o = (8 * wave + i) * QK_STRIDE + 4 * dp, ok = (8 * wave + i) * KT_STRIDE + 4 * dp;
                if (PASSB) *(LAS unsigned*)(QT + o) = pk2(bf_lo(nq[i]) * (QSCALE * p0), bf_hi(nq[i]) * (QSCALE * p1));
                *(LAS unsigned*)(KT + ok) = pk2(hk0[i] * __builtin_amdgcn_rcpf(p0), hk1[i] * __builtin_amdgcn_rcpf(p1));
            }
            if (wave == 0) { *(LAS f32x2*)(FAC + d0) = (f32x2){r0 * elp0, r1 * elp1}; elp0 = bl0 * ir0; elp1 = bl1 * ir1; dsum0 *= bl0; dsum1 *= bl1; }
        } else {
            float off0 = 0.f, off1 = 0.f, r0 = 0.f, r1 = 0.f, bl0 = 0.f, bl1 = 0.f;
#pragma unroll
            for (int g = 0; g < 8; ++g) { const f32x2 tv = *(const LAS f32x2*)(TOT + g * 128 + d0);
                if (g < wave) { off0 += tv[0]; off1 += tv[1]; } if (g < 4) { r0 += tv[0]; r1 += tv[1]; } bl0 += tv[0]; bl1 += tv[1]; }
            off0 -= r0; off1 -= r1;
#pragma unroll
            for (int i = 0; i < 8; ++i) {
                const f32x2 cv = *(const LAS f32x2*)(LG + (8 * wave + i) * 128 + d0);
                const float e0 = ex2(off0 + cv[0] + LOG2_QSCALE), e1 = ex2(off1 + cv[1] + LOG2_QSCALE);
                const unsigned o = (8 * wave + i) * QK_STRIDE + 4 * dp, ok = (8 * wave + i) * KT_STRIDE + 4 * dp;
                if (PASSB) *(LAS unsigned*)(QT + o) = pk2(bf_lo(nq[i]) * e0, bf_hi(nq[i]) * e1);
                float kk0, kk1;
                if (GLA) { kk0 = bf_lo(nk[i]); kk1 = bf_hi(nk[i]); } else { const f32x2 kv = *(const LAS f32x2*)(KS + (8 * wave + i) * 128 + d0); kk0 = kv[0]; kk1 = kv[1]; }
                *(LAS unsigned*)(KT + ok) = pk2(kk0 * ex2(-(off0 + cv[0])), kk1 * ex2(-(off1 + cv[1])));
            }
            if (wave == 0) { *(LAS f32x2*)(FAC + d0) = (f32x2){ex2(r0) * elp0, ex2(r1) * elp1}; elp0 = ex2(bl0 - r0); elp1 = ex2(bl1 - r1); dsum0 += bl0; dsum1 += bl1; }
        }
#pragma unroll
        for (int j = 0; j < NVL; ++j) *(LAS u32x4*)(VR + (tid / CPR + RPP * j) * vstride + 16 * (tid % CPR)) = vn[j];
        { if (GLA) PF_K(tn); if (PASSB) PF_Q(tn); PF_V(tn); }
        __syncthreads();
        f32x16 o[2];
        if (PASSB) {
            const int aw = GLA ? wave : wave - 4;
            if (aw >= 0 && aw < 3) {
                const int it = aw > 0, jt = aw > 1;
                f32x16 a;
#pragma unroll
                for (int j = 0; j < 16; ++j) a[j] = 0.f;
#pragma unroll
                for (int s = 0; s < 8; ++s) { const bf16x8 qa = *(const LAS bf16x8*)(QT + (32 * it + r) * QK_STRIDE + 32 * s + 16 * hh); const bf16x8 kb = *(const LAS bf16x8*)(KT + (32 * jt + r) * KT_STRIDE + 32 * s + 16 * hh); a = MFMA32(kb, qa, a); }
                const int ii = 32 * it + r;
#pragma unroll
                for (int g4 = 0; g4 < 4; ++g4) { const int j0 = 32 * jt + 8 * g4 + 4 * hh; float v[4];
#pragma unroll
                    for (int e = 0; e < 4; ++e) v[e] = (j0 + e <= ii) ? a[4 * g4 + e] : 0.f;
                    *(LAS u32x2*)(AM + ii * 144 + j0 * 2) = (u32x2){pk2(v[0], v[1]), pk2(v[2], v[3])}; }
            }
        }
        if (wave < nmw) {
#pragma unroll
            for (int i = 0; i < 2; ++i)
#pragma unroll
                for (int j = 0; j < 16; ++j) o[i][j] = 0.f;
#pragma unroll
            for (int db = 0; db < 4; ++db) {
                asm volatile("" ::: "memory");
#pragma unroll
                for (int g4 = 0; g4 < 4; ++g4) { const f32x4 fv = *(const LAS f32x4*)(FAC + 32 * db + 8 * g4 + 4 * hh);
#pragma unroll
                    for (int e = 0; e < 4; ++e) S[db][4 * g4 + e] *= fv[e]; }
                if (PASSB) {
#pragma unroll
                    for (int s = 0; s < 2; ++s) {
                        u32x4 pb; pb.x = pk2(S[db][8 * s + 0], S[db][8 * s + 1]); pb.y = pk2(S[db][8 * s + 2], S[db][8 * s + 3]); pb.z = pk2(S[db][8 * s + 4], S[db][8 * s + 5]); pb.w = pk2(S[db][8 * s + 6], S[db][8 * s + 7]);
                        const bf16x8 bs = __builtin_bit_cast(bf16x8, pb);
#pragma unroll
                        for (int it = 0; it < 2; ++it) {
                            const LAS unsigned char* qp = QT + (32 * it + r) * QK_STRIDE + 64 * db + 32 * s + 8 * hh; const s16x4 lo = *(const LAS s16x4*)qp, hi = *(const LAS s16x4*)(qp + 16);
                            o[it] = MFMA32(__builtin_shufflevector(lo, hi, 0, 1, 2, 3, 4, 5, 6, 7), bs, o[it]);
                        }
                    }
                }
            }
        }
        if (PASSB) __syncthreads();
        if (wave < nmw) {
            bf16x8 vf[4];
#pragma unroll
            for (int ks = 0; ks < 4; ++ks) vf[ks] = tr_frag(VR, trv, vstride, wave, ks);
            if (PASSB) {
#pragma unroll
                for (int it = 0; it < 2; ++it)
#pragma unroll
                    for (int ks = 0; ks < 4; ++ks) { if (it == 0 && ks >= 2) continue;
                        const bf16x8 af = *(const LAS bf16x8*)(AM + (32 * it + r) * 144 + (16 * ks + 8 * hh) * 2); o[it] = MFMA32(af, vf[ks], o[it]); }
#pragma unroll
                for (int it = 0; it < 2; ++it)
#pragma unroll
                    for (int reg = 0; reg < 16; ++reg) *(LAS float*)(O32 + (32 * it + (reg & 3) + 8 * (reg >> 2) + 4 * hh) * OS + (32 * wave + r) * 4) = o[it][reg];
            }
#pragma unroll
            for (int db = 0; db < 4; ++db) {
                asm volatile("" ::: "memory");
#pragma unroll
                for (int ks = 0; ks < 4; ++ks) { const bf16x8 kf = tr_frag(KT, trk, KT_STRIDE, db, ks); S[db] = MFMA32(kf, vf[ks], S[db]); } }
            asm volatile("" ::: "memory");
        }
        if (PASSB) {
            __syncthreads();
#pragma unroll
            for (int j = 0; j < NVL; ++j) {
                const int row = tid / CPR + RPP * j, ch = tid % CPR;
                const f32x4 oa = *(const LAS f32x4*)(O32 + row * OS + ch * 32), ob = *(const LAS f32x4*)(O32 + row * OS + ch * 32 + 16);
                float sq = (oa[0] * oa[0] + oa[1] * oa[1]) + (oa[2] * oa[2] + oa[3] * oa[3]) + (ob[0] * ob[0] + ob[1] * ob[1]) + (ob[2] * ob[2] + ob[3] * ob[3]);
                sq = row16_allsum(sq); if (CPR == 32) sq += __builtin_bit_cast(float, __builtin_amdgcn_ds_swizzle(__builtin_bit_cast(int, sq), 0x401F));
                const float rstd = __builtin_amdgcn_rsqf(sq * (1.0f / dv) + EPS);
                const f32x4 wa = *(const LAS f32x4*)(NW + 8 * ch), wb = *(const LAS f32x4*)(NW + 8 * ch + 4);
                const u32x4 g = gt[j]; float res[8];
                const float gv[8] = {bf_lo(g.x), bf_hi(g.x), bf_lo(g.y), bf_hi(g.y), bf_lo(g.z), bf_hi(g.z), bf_lo(g.w), bf_hi(g.w)};
#pragma unroll
                for (int e = 0; e < 4; ++e) { res[e] = oa[e] * rstd * wa[e] * gv[e]; res[4 + e] = ob[e] * rstd * wb[e] * gv[4 + e]; }
                u32x4 w; w.x = pk2(res[0], res[1]); w.y = pk2(res[2], res[3]); w.z = pk2(res[4], res[5]); w.w = pk2(res[6], res[7]);
                bstore128(w, rs_mix, vo_m, ((unsigned)t0 + RPP * j) * (DM * 2) + mcol * 2);
            }
            if (!GLA) { HG_F(); PF_K((c + 2 < NC) ? t0 + 2 * CHUNK : t0); }
            if (GLA) { GLA_Z(); PF_G((c + 2 < NC) ? t0 + 2 * CHUNK : t0); }
            if (GLA) __syncthreads();
#pragma unroll
            for (int j = 0; j < NVL; ++j) gt[j] = gn[j];
        }
    }
    if (!PASSB) {
        __syncthreads();
        if (wave == 0) { *(LAS f32x2*)(FAC + d0) = (f32x2){elp0, elp1};
            const f32x2 dv2 = GLA ? (f32x2){ex2(dsum0), ex2(dsum1)} : (f32x2){dsum0, dsum1};
            __hip_atomic_store(Dbase + (size_t)item * 128 + d0, dv2[0], __ATOMIC_RELAXED, __HIP_MEMORY_SCOPE_AGENT); __hip_atomic_store(Dbase + (size_t)item * 128 + d0 + 1, dv2[1], __ATOMIC_RELAXED, __HIP_MEMORY_SCOPE_AGENT); }
        __syncthreads();
        if (wave < nmw) {
            const __amdgpu_buffer_rsrc_t rs_lw = __builtin_amdgcn_make_buffer_rsrc((void*)Lbase, 0, (GLA ? 16 : 32) * NSEG * LSZ * 2, 0x00020000);
#pragma unroll
            for (int db = 0; db < 4; ++db)
#pragma unroll
                for (int g2 = 0; g2 < 2; ++g2) { const f32x4 fa = *(const LAS f32x4*)(FAC + 32 * db + 16 * g2 + 4 * hh), fb = *(const LAS f32x4*)(FAC + 32 * db + 16 * g2 + 8 + 4 * hh); u32x4 ov;
                    ov.x = pk2(S[db][8 * g2 + 0] * fa[0], S[db][8 * g2 + 1] * fa[1]); ov.y = pk2(S[db][8 * g2 + 2] * fa[2], S[db][8 * g2 + 3] * fa[3]);
                    ov.z = pk2(S[db][8 * g2 + 4] * fb[0], S[db][8 * g2 + 5] * fb[1]); ov.w = pk2(S[db][8 * g2 + 6] * fb[2], S[db][8 * g2 + 7] * fb[3]);
                    bstore128_wt(ov, rs_lw, (unsigned)lane * 16u, (unsigned)(item * (LSZ * 2) + ((wave * 4 + db) * 2 + g2) * 1024)); }
        }
    }
    if (!PASSB) asm volatile("s_waitcnt vmcnt(0)" ::: "memory");
    __syncthreads();
    if (!PASSB && tid == 0) __hip_atomic_fetch_add((unsigned*)(F.ws + WS_CTL) + CW_SEQ + 64 * (GLA ? b * 4 + h : 16 + b * 8 + h), 1u, __ATOMIC_RELAXED, __HIP_MEMORY_SCOPE_AGENT);
#undef PF_K
#undef PF_Q
#undef PF_G
#undef GLA_Z
#undef HG_F
#undef PF_V
#undef PJB
}


__device__ __forceinline__ void hgrn_passA_steps(Frame& F, const int b, const int h, const int seg) {
    constexpr int STEP = MK_ASTEP, RW = STEP / 8, NSEG = NSEG_H, NST = (NCHUNK / NSEG) * CHUNK / STEP, KST = STEP == 256 ? 288 : 320, VST = KST, LSZ = 128 * 128;
    constexpr int A_KT = 0, A_VR = A_KT + STEP * KST, A_TOT = A_VR + STEP * VST, A_FAC = A_TOT + 8 * 128 * 4;
    static_assert(A_FAC + 512 <= LDS_BYTES - 128, "pass A LDS map");
    const int tid = F.tid, lane = F.lane, wave = F.wave;
    LAS unsigned char* lds = F.lds;
    LAS unsigned char* KT = lds + A_KT; LAS unsigned char* VR = lds + A_VR;
    LAS float* TOT = (LAS float*)(lds + A_TOT); LAS float* FAC = (LAS float*)(lds + A_FAC);
    const int kcol = C_HF + h * 128, vcol = C_HI + h * 128;
    const int dp = tid & 63, d0 = 2 * dp;
    const int item = (b * 8 + h) * NSEG + seg;
    float* Lbase = (float*)(F.ws + WS_LH); float* Dbase = (float*)(F.ws + WS_DH);
    const f32x2 l0 = *(const f32x2*)(F.hgrn_lb + h * 128 + d0), l1 = *(const f32x2*)(F.hgrn_lb + 1024 + h * 128 + d0);
    const float lb0 = 1.0f / (1.0f + __expf(l1[0] - l0[0])), lb1 = 1.0f / (1.0f + __expf(l1[1] - l0[1]));
    const unsigned hh = lane >> 5;
    const unsigned tq = (lane & 15) >> 2, tp = lane & 3, tblk = (lane >> 4) & 1;
    const unsigned trk = (8 * hh + tq) * KST + 32 * tblk + 8 * tp, trv = (8 * hh + tq) * VST + 32 * tblk + 8 * tp;
    const size_t row0 = (size_t)b * SEQ + (size_t)seg * (NCHUNK / NSEG) * CHUNK;
    float dprod0 = 1.f, dprod1 = 1.f;
    f32x16 S[4];
#pragma unroll
    for (int i = 0; i < 4; ++i)
#pragma unroll
        for (int j = 0; j < 16; ++j) S[i][j] = 0.f;
    const __amdgpu_buffer_rsrc_t rs_pj = __builtin_amdgcn_make_buffer_rsrc((void*)F.PJ, 0, (int)((size_t)M * NPJ * 2), 0x00020000);
    const unsigned vo_k = 4 * dp, vo_v = (tid / 16) * 512 + (tid % 16) * 16;
#define PJB(T, COL) ((((((unsigned)(T)) >> 8) * (unsigned)(NPJ / 256) + (((unsigned)(COL)) >> 8)) << 17) + ((((unsigned)(T)) & 255u) << 9) + ((((unsigned)(COL)) & 255u) << 1))
    unsigned nk[RW]; u32x4 vn[STEP / 32];
#define A_PF_K(T0) do { const unsigned _sk = PJB(T0, kcol) + RW * wave * 512; _Pragma("unroll") for (int i = 0; i < RW; ++i) nk[i] = __builtin_amdgcn_raw_buffer_load_b32(rs_pj, vo_k, _sk + i * 512, 0); } while (0)
#define A_PF_V(T0) do { const unsigned _sv = PJB(T0, vcol); _Pragma("unroll") for (int j = 0; j < STEP / 32; ++j) vn[j] = __builtin_amdgcn_raw_buffer_load_b128(rs_pj, vo_v, _sv + j * (32 * 512), 0); } while (0)
    A_PF_K(row0); A_PF_V(row0);
    for (int c = 0; c < NST; ++c) {
        const size_t t0 = row0 + (size_t)c * STEP;
        const size_t tn = (c + 1 < NST) ? t0 + STEP : t0;
        float kk0[RW], kk1[RW]; float cum0 = 1.f, cum1 = 1.f;
#pragma unroll
        for (int i = RW - 1; i >= 0; --i) {
            const unsigned kv = nk[i];
            const float s0 = fsig(bf_lo(kv)), s1 = fsig(bf_hi(kv));
            const float f0 = lb0 + (1.0f - lb0) * s0, f1 = lb1 + (1.0f - lb1) * s1;
            kk0[i] = (1.0f - f0) * cum0; kk1[i] = (1.0f - f1) * cum1;
            cum0 *= f0; cum1 *= f1;
        }
        *(LAS f32x2*)(TOT + wave * 128 + d0) = (f32x2){cum0, cum1};
        A_PF_K(tn);
        __syncthreads();
        {
            float off0 = 1.f, off1 = 1.f, bl0 = 1.f, bl1 = 1.f;
#pragma unroll
            for (int g = 0; g < 8; ++g) { const f32x2 tv = *(const LAS f32x2*)(TOT + g * 128 + d0);
                if (g > wave) { off0 *= tv[0]; off1 *= tv[1]; } bl0 *= tv[0]; bl1 *= tv[1]; }
#pragma unroll
            for (int i = 0; i < RW; ++i) *(LAS unsigned*)(KT + (RW * wave + i) * KST + 4 * dp) = pk2(kk0[i] * off0, kk1[i] * off1);
            if (wave == 0) { *(LAS f32x2*)(FAC + d0) = (f32x2){bl0, bl1}; dprod0 *= bl0; dprod1 *= bl1; }
        }
#pragma unroll
        for (int j = 0; j < STEP / 32; ++j) *(LAS u32x4*)(VR + (tid / 16 + 32 * j) * VST + 16 * (tid % 16)) = vn[j];
        A_PF_V(tn);
        __syncthreads();
        if (wave < 4) {
#pragma unroll
            for (int db = 0; db < 4; ++db)
#pragma unroll
                for (int g4 = 0; g4 < 4; ++g4) { const f32x4 fv = *(const LAS f32x4*)(FAC + 32 * db + 8 * g4 + 4 * hh);
#pragma unroll
                    for (int e = 0; e < 4; ++e) S[db][4 * g4 + e] *= fv[e]; }
#pragma unroll
            for (int k4 = 0; k4 < STEP / 64; ++k4) {
                bf16x8 vf[4];
#pragma unroll
                for (int q = 0; q < 4; ++q) vf[q] = tr_frag(VR, trv, VST, wave, 4 * k4 + q);
#pragma unroll
                for (int db = 0; db < 4; ++db) {
                    asm volatile("" ::: "memory");
#pragma unroll
                    for (int q = 0; q < 4; ++q) { const bf16x8 kf = tr_frag(KT, trk, KST, db, 4 * k4 + q); S[db] = MFMA32(kf, vf[q], S[db]); } }
            }
            asm volatile("" ::: "memory");
        }
    }
    if (wave == 0) { __hip_atomic_store(Dbase + (size_t)item * 128 + d0, dprod0, __ATOMIC_RELAXED, __HIP_MEMORY_SCOPE_AGENT); __hip_atomic_store(Dbase + (size_t)item * 128 + d0 + 1, dprod1, __ATOMIC_RELAXED, __HIP_MEMORY_SCOPE_AGENT); }
    if (wave < 4) {
        const __amdgpu_buffer_rsrc_t rs_lw = __builtin_amdgcn_make_buffer_rsrc((void*)Lbase, 0, 32 * NSEG * LSZ * 2, 0x00020000);
#pragma unroll
        for (int db = 0; db < 4; ++db)
#pragma unroll
            for (int g2 = 0; g2 < 2; ++g2) { u32x4 ov;
                ov.x = pk2(S[db][8 * g2 + 0], S[db][8 * g2 + 1]); ov.y = pk2(S[db][8 * g2 + 2], S[db][8 * g2 + 3]); ov.z = pk2(S[db][8 * g2 + 4], S[db][8 * g2 + 5]); ov.w = pk2(S[db][8 * g2 + 6], S[db][8 * g2 + 7]);
                bstore128_wt(ov, rs_lw, (unsigned)lane * 16u, (unsigned)(item * (LSZ * 2) + ((wave * 4 + db) * 2 + g2) * 1024)); }
    }
    asm volatile("s_waitcnt vmcnt(0)" ::: "memory");
    __syncthreads();
    if (tid == 0) __hip_atomic_fetch_add((unsigned*)(F.ws + WS_CTL) + CW_SEQ + 64 * (16 + b * 8 + h), 1u, __ATOMIC_RELAXED, __HIP_MEMORY_SCOPE_AGENT);
#undef A_PF_K
#undef A_PF_V
#undef PJB
}

__device__ __forceinline__ void gla_passA_steps(Frame& F, const int b, const int h, const int seg) {
    constexpr int STEP = 128, RW = STEP / 8, NSEG = NSEG_G, NST = (NCHUNK / NSEG) * CHUNK / STEP, KST = 320, VST = 576, LSZ = 128 * 256;
    constexpr int A_KT = 0, A_VR = A_KT + STEP * KST, A_TOT = A_VR + STEP * VST, A_FAC = A_TOT + 8 * 128 * 4;
    static_assert(A_FAC + 512 <= LDS_BYTES - 128 && STEP * 128 * 4 <= STEP * VST, "GLA pass A LDS map");
    const int tid = F.tid, lane = F.lane, wave = F.wave;
    LAS unsigned char* lds = F.lds;
    LAS unsigned char* KT = lds + A_KT; LAS unsigned char* VR = lds + A_VR; LAS float* LG = (LAS float*)(lds + A_VR);
    LAS float* TOT = (LAS float*)(lds + A_TOT); LAS float* FAC = (LAS float*)(lds + A_FAC);
    const int kcol = C_GK + h * 128, vcol = C_GV + h * 256;
    const int dp = tid & 63, d0 = 2 * dp;
    const int item = (b * 4 + h) * NSEG + seg;
    float* Lbase = (float*)(F.ws + WS_LG); float* Dbase = (float*)(F.ws + WS_DG);
    bf16x8 wbh, wbl; float bub;
    { const int col = h * 128 + 32 * (wave & 3) + (lane & 31); float wv[8];
#pragma unroll
      for (int j = 0; j < 8; ++j) wv[j] = F.gla_w_up[(size_t)(8 * (lane >> 5) + j) * 512 + col];
      split_bf16(wv, wbh, wbl); bub = F.gla_b_up[col]; }
    const unsigned hh = lane >> 5;
    const unsigned tq = (lane & 15) >> 2, tp = lane & 3, tblk = (lane >> 4) & 1;
    const unsigned trk = (8 * hh + tq) * KST + 32 * tblk + 8 * tp, trv = (8 * hh + tq) * VST + 32 * tblk + 8 * tp;
    const size_t row0 = (size_t)b * SEQ + (size_t)seg * (NCHUNK / NSEG) * CHUNK;
    float dsum0 = 0.f, dsum1 = 0.f;
    f32x16 S[4];
#pragma unroll
    for (int i = 0; i < 4; ++i)
#pragma unroll
        for (int j = 0; j < 16; ++j) S[i][j] = 0.f;
    const __amdgpu_buffer_rsrc_t rs_pj = __builtin_amdgcn_make_buffer_rsrc((void*)F.PJ, 0, (int)((size_t)M * NPJ * 2), 0x00020000);
    const __amdgpu_buffer_rsrc_t rs_glr = __builtin_amdgcn_make_buffer_rsrc((void*)F.GLR, 0, M * 16 * 4, 0x00020000);
    const unsigned vo_k = 4 * dp, vo_g = ((lane & 31) * 16 + 8 * (lane >> 5)) * 4, vo_v = (tid / 32) * 512 + (tid % 32) * 16;
#define PJB(T, COL) ((((((unsigned)(T)) >> 8) * (unsigned)(NPJ / 256) + (((unsigned)(COL)) >> 8)) << 17) + ((((unsigned)(T)) & 255u) << 9) + ((((unsigned)(COL)) & 255u) << 1))
    unsigned nk[RW]; u32x4 vn[STEP / 16]; u32x4 ng[2][2];
#define G_PF_K(T0) do { const unsigned _sk = PJB(T0, kcol) + RW * wave * 512; _Pragma("unroll") for (int i = 0; i < RW; ++i) nk[i] = __builtin_amdgcn_raw_buffer_load_b32(rs_pj, vo_k, _sk + i * 512, 0); } while (0)
#define G_PF_V(T0) do { const unsigned _sv = PJB(T0, vcol); _Pragma("unroll") for (int j = 0; j < STEP / 16; ++j) vn[j] = __builtin_amdgcn_raw_buffer_load_b128(rs_pj, vo_v, _sv + j * (16 * 512), 0); } while (0)
#define G_PF_G(T0) do { _Pragma("unroll") for (int hf = 0; hf < 2; ++hf) { const unsigned _sg = ((unsigned)(T0) + 64 * hf + 32 * (wave >> 2)) * 64; ng[hf][0] = __builtin_amdgcn_raw_buffer_load_b128(rs_glr, vo_g, _sg, 0); ng[hf][1] = __builtin_amdgcn_raw_buffer_load_b128(rs_glr, vo_g, _sg + 16, 0); } } while (0)
    float lgr[2][16];
#define G_Z() do { _Pragma("unroll") for (int hf = 0; hf < 2; ++hf) { f32x16 z; _Pragma("unroll") for (int j = 0; j < 16; ++j) z[j] = 0.f; \
        { const float gv[8] = {__uint_as_float(ng[hf][0].x), __uint_as_float(ng[hf][0].y), __uint_as_float(ng[hf][0].z), __uint_as_float(ng[hf][0].w), __uint_as_float(ng[hf][1].x), __uint_as_float(ng[hf][1].y), __uint_as_float(ng[hf][1].z), __uint_as_float(ng[hf][1].w)}; \
          bf16x8 ah, al; split_bf16(gv, ah, al); \
          z = MFMA32(al, wbh, z); z = MFMA32(ah, wbl, z); z = MFMA32(ah, wbh, z); } \
        _Pragma("unroll") for (int reg = 0; reg < 16; ++reg) { const float zz = z[reg] + bub; lgr[hf][reg] = (fminf(zz, 0.f) * LOG2E - lg2(1.0f + ex2(-LOG2E * fabsf(zz)))) * INV_TAU; } } } while (0)
    G_PF_G(row0); G_PF_K(row0); G_PF_V(row0);
    G_Z(); G_PF_G(NST > 1 ? row0 + STEP : row0);
    for (int c = 0; c < NST; ++c) {
        const size_t t0 = row0 + (size_t)c * STEP;
        const size_t tn = (c + 1 < NST) ? t0 + STEP : t0;
        __syncthreads();
#pragma unroll
        for (int hf = 0; hf < 2; ++hf)
#pragma unroll
            for (int reg = 0; reg < 16; ++reg) { const int row = 64 * hf + 32 * (wave >> 2) + (reg & 3) + 8 * (reg >> 2) + 4 * (lane >> 5);
                LG[row * 128 + 32 * (wave & 3) + (lane & 31)] = lgr[hf][reg]; }
        __syncthreads();
        float sf0[RW], sf1[RW]; float cum0 = 0.f, cum1 = 0.f;
#pragma unroll
        for (int i = RW - 1; i >= 0; --i) { const f32x2 lgv = *(const LAS f32x2*)(LG + (RW * wave + i) * 128 + d0); sf0[i] = cum0; sf1[i] = cum1; cum0 += lgv[0]; cum1 += lgv[1]; }
        *(LAS f32x2*)(TOT + wave * 128 + d0) = (f32x2){cum0, cum1};
        __syncthreads();
        {
            float off0 = 0.f, off1 = 0.f, bl0 = 0.f, bl1 = 0.f;
#pragma unroll
            for (int g = 0; g < 8; ++g) { const f32x2 tv = *(const LAS f32x2*)(TOT + g * 128 + d0);
                if (g > wave) { off0 += tv[0]; off1 += tv[1]; } bl0 += tv[0]; bl1 += tv[1]; }
#pragma unroll
            for (int i = 0; i < RW; ++i) *(LAS unsigned*)(KT + (RW * wave + i) * KST + 4 * dp) = pk2(bf_lo(nk[i]) * ex2(sf0[i] + off0), bf_hi(nk[i]) * ex2(sf1[i] + off1));
            if (wave == 0) { *(LAS f32x2*)(FAC + d0) = (f32x2){ex2(bl0), ex2(bl1)}; dsum0 += bl0; dsum1 += bl1; }
        }
        G_PF_K(tn);
#pragma unroll
        for (int j = 0; j < STEP / 16; ++j) *(LAS u32x4*)(VR + (tid / 32 + 16 * j) * VST + 16 * (tid % 32)) = vn[j];
        G_PF_V(tn);
        __syncthreads();
        {
#pragma unroll
            for (int db = 0; db < 4; ++db)
#pragma unroll
                for (int g4 = 0; g4 < 4; ++g4) { const f32x4 fv = *(const LAS f32x4*)(FAC + 32 * db + 8 * g4 + 4 * hh);
#pragma unroll
                    for (int e = 0; e < 4; ++e) S[db][4 * g4 + e] *= fv[e]; }
#pragma unroll
            for (int k4 = 0; k4 < STEP / 64; ++k4) {
                bf16x8 vf[4];
#pragma unroll
                for (int q = 0; q < 4; ++q) vf[q] = tr_frag(VR, trv, VST, wave, 4 * k4 + q);
#pragma unroll
                for (int db = 0; db < 4; ++db) {
                    asm volatile("" ::: "memory");
#pragma unroll
                    for (int q = 0; q < 4; ++q) { const bf16x8 kf = tr_frag(KT, trk, KST, db, 4 * k4 + q); S[db] = MFMA32(kf, vf[q], S[db]); } }
            }
            asm volatile("" ::: "memory");
        }
        if (c + 1 < NST) { G_Z(); G_PF_G((c + 2 < NST) ? t0 + 2 * STEP : t0); }
    }
    if (wave == 0) { __hip_atomic_store(Dbase + (size_t)item * 128 + d0, ex2(dsum0), __ATOMIC_RELAXED, __HIP_MEMORY_SCOPE_AGENT); __hip_atomic_store(Dbase + (size_t)item * 128 + d0 + 1, ex2(dsum1), __ATOMIC_RELAXED, __HIP_MEMORY_SCOPE_AGENT); }
    {
        const __amdgpu_buffer_rsrc_t rs_lw = __builtin_amdgcn_make_buffer_rsrc((void*)Lbase, 0, 16 * NSEG * LSZ * 2, 0x00020000);
#pragma unroll
        for (int db = 0; db < 4; ++db)
#pragma unroll
            for (int g2 = 0; g2 < 2; ++g2) { u32x4 ov;
                ov.x = pk2(S[db][8 * g2 + 0], S[db][8 * g2 + 1]); ov.y = pk2(S[db][8 * g2 + 2], S[db][8 * g2 + 3]); ov.z = pk2(S[db][8 * g2 + 4], S[db][8 * g2 + 5]); ov.w = pk2(S[db][8 * g2 + 6], S[db][8 * g2 + 7]);
                bstore128_wt(ov, rs_lw, (unsigned)lane * 16u, (unsigned)(item * (LSZ * 2) + ((wave * 4 + db) * 2 + g2) * 1024)); }
    }
    asm volatile("s_waitcnt vmcnt(0)" ::: "memory");
    __syncthreads();
    if (tid == 0) __hip_atomic_fetch_add((unsigned*)(F.ws + WS_CTL) + CW_SEQ + 64 * (b * 4 + h), 1u, __ATOMIC_RELAXED, __HIP_MEMORY_SCOPE_AGENT);
    {
        LAS unsigned* ST = (LAS unsigned*)(lds + L_KS);
        const u32x4 a = __builtin_bit_cast(u32x4, wbh), c2 = __builtin_bit_cast(u32x4, wbl);
        ST[0 * NTHREADS + tid] = a.x; ST[1 * NTHREADS + tid] = a.y; ST[2 * NTHREADS + tid] = a.z; ST[3 * NTHREADS + tid] = a.w;
        ST[4 * NTHREADS + tid] = c2.x; ST[5 * NTHREADS + tid] = c2.y; ST[6 * NTHREADS + tid] = c2.z; ST[7 * NTHREADS + tid] = c2.w; ST[8 * NTHREADS + tid] = __float_as_uint(bub);
    }
#undef G_PF_K
#undef G_PF_V
#undef G_PF_G
#undef G_Z
#undef PJB
}

__device__ __forceinline__ int scan_vit(int bid) {
    const int x = bid & 7, r = bid >> 3;
    if (r < 14) return x * 14 + r;
    if (r < 26) return 112 + x * 12 + (r - 14);
    if (r < 28) return 208 + x * 2 + (r - 26);
    return 224 + x * 4 + (r - 28);
}
__device__ __forceinline__ void p2a_scan(Frame& F) {
    constexpr int NG = 16 * (NSEG_G - 1), NH = 32 * (NSEG_H - 1);
    static_assert(NG + NH <= 256, "pass A items");
    const int it = scan_vit(F.bid);
    if (it < NG) { const int bh = it / (NSEG_G - 1), seg = it % (NSEG_G - 1); gla_passA_steps(F, bh >> 2, bh & 3, seg); }
    else if (it < NG + NH) { const int j = it - NG, bh = j / (NSEG_H - 1), seg = j % (NSEG_H - 1); hgrn_passA_steps(F, bh >> 3, bh & 7, seg); }
}
__device__ __forceinline__ void p2b_scan(Frame& F) {
    constexpr int NG = 16 * NSEG_G, NH = 32 * NSEG_H;
    static_assert(NG + NH <= 256, "pass B items");
    constexpr int NGA = 16 * (NSEG_G - 1), NHA = 32 * (NSEG_H - 1);
    const int it = scan_vit(F.bid);
    if (it < NGA) { const int bh = it / (NSEG_G - 1), seg = it % (NSEG_G - 1) + 1; scan_item<1, 1>(F, bh >> 2, bh & 3, seg); }
    else if (it < NGA + NHA) { const int j = it - NGA, bh = j / (NSEG_H - 1), seg = j % (NSEG_H - 1) + 1; scan_item<0, 1>(F, bh >> 3, bh & 7, seg); }
    else if (it < NGA + NHA + 16) { const int bh = it - NGA - NHA; scan_item<1, 1>(F, bh >> 2, bh & 3, 0); }
    else if (it < NGA + NHA + 48) { const int bh = it - NGA - NHA - 16; scan_item<0, 1>(F, bh >> 3, bh & 7, 0); }
#if MK_ONE_LAUNCH
    if (it >= NGA + NHA) {
        LAS float* scr = (LAS float*)(F.lds + F.wave * 16384);
        constexpr int KB = DM / 64, I_OUT = KB * (DM / 32);
        for (int r = (it - NGA - NHA) * NWAVES + F.wave; r < I_OUT; r += 48 * NWAVES) { const int kb = r / (DM / 32), nb = r % (DM / 32);
            p0_transpose_item(F.w_out, DM, 32 * nb, F.WoutT, DM, 32 * nb, kb, scr, F.lane); }
    }
#endif
}

struct Args { const float* in[10]; float* out; unsigned char* ws; int ph_lo, ph_hi; };
__global__ void __launch_bounds__(NTHREADS, 2) mk_fwd(Args args) {
    extern __shared__ __attribute__((aligned(16))) unsigned char lds_raw[];
    Frame F;
    F.lds = (LAS unsigned char*)lds_raw;
    F.tid = threadIdx.x; F.lane = F.tid & 63; F.wave = __builtin_amdgcn_readfirstlane(F.tid >> 6);
    F.G = gridDim.x; F.bid = blockIdx.x;
    F.x = args.in[0]; F.norm_w = args.in[1]; F.w_in = args.in[2]; F.gla_w_up = args.in[3]; F.gla_b_up = args.in[4]; F.gla_norm_w = args.in[5];
    F.hgrn_lb = args.in[6]; F.hgrn_norm_w = args.in[7]; F.w_out = args.in[8]; F.final_w = args.in[9]; F.out = args.out;
    unsigned char* ws = args.ws; F.ws = ws;
    F.WinT = (bf16*)(ws + WS_WINT); F.WoutT = (bf16*)(ws + WS_WOUTT); F.HN = (bf16*)(ws + WS_HN); F.MIX = (bf16*)(ws + WS_MIX); F.PJ = (bf16*)(ws + WS_PJ);
    F.GLR = (float*)(ws + WS_GLR);
    const int lo = args.ph_lo, hi = args.ph_hi;
#if MK_ONE_LAUNCH
    if (F.tid < 32) ((LAS unsigned*)(F.lds + MISC_OFF))[F.tid] = 0u;
    __syncthreads();
    const XcdBarrier xbar = xcd_barrier_post((unsigned*)(ws + WS_CTL) + CW_BAR, (volatile LAS unsigned*)(F.lds + MISC_OFF));
#endif
#define IN(k) (lo <= (k) && (k) < hi)
#define BOTH(k) (IN(k) && IN((k) + 1))
#if MK_ONE_LAUNCH
#define GRID_BAR() do { xcd_barrier(xbar); } while (0)
#else
#define GRID_BAR() do { } while (0)
#endif
    if (IN(0)) { p0_prologue(F); if (BOTH(0)) GRID_BAR(); }
    if (IN(1)) {
        pg8::Gemm g{F.HN, F.WinT, M, NPJ, DM}; pg8::StaticOrder S; S.init(M, NPJ, F.G, F.bid);
        pg8::EpiPJ E{F.PJ, NPJ / 256};
#ifdef MK_SKEW_TICKS
        if ((F.bid >> 3) & 1) { const unsigned long long t0 = __builtin_amdgcn_s_memrealtime(); while (__builtin_amdgcn_s_memrealtime() - t0 < MK_SKEW_TICKS) __builtin_amdgcn_s_sleep(8); }
#endif
        pg8::gemm_phase<pg8::EpiPJ, pg8::StaticOrder, PG8_ALIGN, PG8_SP2>(F.lds, g, S, E);
        if (BOTH(1)) GRID_BAR();
    }
    if (IN(2)) { p2a_scan(F); }
    if (IN(3)) { p2b_scan(F); if (BOTH(3)) GRID_BAR(); }
    if (IN(4)) {
        pg8::Gemm g{F.MIX, F.WoutT, M, DM, DM}; pg8::PanelOrder S{F.bid};
        pg8::EpiFinal E{F.x, F.out, F.final_w, (float*)(ws + WS_XCH), (unsigned*)(ws + WS_CTL) + CW_PANEL, F.lds + 131072};
        pg8::gemm_phase<pg8::EpiFinal, pg8::PanelOrder, true, PG8_SP2>(F.lds, g, S, E);
    }
#undef IN
#undef BOTH
}

extern "C" void kernel_launch(void* const* d_in, const int* in_sizes, int n_in, void* d_out, int out_size, void* d_ws, size_t ws_size, hipStream_t stream) {
    static int grid = 0;
    if (grid == 0) {
        if (n_in != 10 || in_sizes[0] != M * DM || out_size != M * DM || ws_size < WS_END) { fprintf(stderr, "kernel_launch: unexpected shapes (n_in %d, in0 %d, out %d, ws %zu)\n", n_in, n_in > 0 ? in_sizes[0] : -1, out_size, ws_size); grid = -1; return; }
        int dev = 0, cus = 0, per_cu = 0;
        if (hipGetDevice(&dev) != hipSuccess || hipDeviceGetAttribute(&cus, hipDeviceAttributeMultiprocessorCount, dev) != hipSuccess) { grid = -1; return; }
        if (hipFuncSetAttribute((const void*)mk_fwd, hipFuncAttributeMaxDynamicSharedMemorySize, LDS_BYTES) != hipSuccess) { fprintf(stderr, "kernel_launch: hipFuncSetAttribute failed\n"); grid = -1; return; }
        if (hipOccupancyMaxActiveBlocksPerMultiprocessor(&per_cu, (const void*)mk_fwd, NTHREADS, LDS_BYTES) != hipSuccess || per_cu < 1) { fprintf(stderr, "kernel_launch: occupancy query says %d blocks per CU\n", per_cu); grid = -1; return; }
        (void)hipGetLastError();
        grid = cus;
        if (grid < 256) { fprintf(stderr, "kernel_launch: %d CUs; the scan phases need 256 workgroups\n", grid); grid = -1; return; }
        grid = 256;
    }
    if (grid < 0) return;
    (void)hipMemsetAsync((char*)d_ws + WS_CTL, 0, CTL_ZERO_BYTES, stream);
    Args a{};
    for (int i = 0; i < 10; ++i) a.in[i] = (const float*)d_in[i];
    a.out = (float*)d_out; a.ws = (unsigned char*)d_ws;
#if MK_ONE_LAUNCH
    a.ph_lo = 0; a.ph_hi = 5;
    void* kargs[] = {&a};
    hipError_t e = hipLaunchCooperativeKernel((const void*)mk_fwd, dim3(grid), dim3(NTHREADS), kargs, LDS_BYTES, stream);
    if (e != hipSuccess) fprintf(stderr, "kernel_launch: cooperative launch failed: %s (grid %d)\n", hipGetErrorString(e), grid);
#else
    for (int p = 0; p < 5; ++p) { a.ph_lo = p; a.ph_hi = p + 1; hipLaunchKernelGGL(mk_fwd, dim3(grid), dim3(NTHREADS), LDS_BYTES, stream, a); }
#endif
}
```
